# Optimizing an MI355X kernel written in HIP

```python
import math
import jax, jax.numpy as jnp
from jax import lax
import numpy as np

D_MODEL = 1024
BATCH = 8
SEQ = 8192
DEPTH = 2

GRID_W = 64
CTX_LEN = 256
HEAD_DIM = 64
Q_BLOCK = 128
ROPE_THETA = 10000.0
EPS = 1e-6
N_MOD = 6

POOL_GROUPS = 4
POOL_WINDOWS = (2, 4, 8, 16)
POOL_GROUP_DIM = 64
POOL_WIDTH = POOL_GROUPS * POOL_GROUP_DIM
DIFF_HEADS = 6
DIFF_V_DIM = 2 * HEAD_DIM
DIFF_QK_WIDTH = DIFF_HEADS * 2 * HEAD_DIM
DIFF_WIDTH = DIFF_HEADS * DIFF_V_DIM
EVEN_IN_SIZES = (POOL_WIDTH, DIFF_QK_WIDTH, DIFF_QK_WIDTH, DIFF_WIDTH)
EVEN_OUT = POOL_WIDTH + DIFF_WIDTH
GQA_HEADS = 8
GQA_KV_HEADS = 2
GQA_REP = GQA_HEADS // GQA_KV_HEADS
NA_HEADS = 8
NA_WIN_ROWS = 8
NA_WIN_COLS = 16
ODD_IN_SIZES = (GQA_HEADS * HEAD_DIM, GQA_KV_HEADS * HEAD_DIM, GQA_KV_HEADS * HEAD_DIM,
                NA_HEADS * HEAD_DIM, NA_HEADS * HEAD_DIM, NA_HEADS * HEAD_DIM)
ODD_OUT = (GQA_HEADS + NA_HEADS) * HEAD_DIM
PEER_HEADS = 8
PEER_N_KEYS = 128
PEER_N_EXPERTS = PEER_N_KEYS * PEER_N_KEYS
PEER_KEY_DIM = 128
PEER_TOPK = 16
PEER_BLOCK = 128

kernel_name = "hybrid_pool_diff_gqa_na_peer_dit"


def rms_norm(x, g):
    xf = x.astype(jnp.float32)
    y = xf * lax.rsqrt(jnp.mean(xf * xf, axis=-1, keepdims=True) + EPS)
    return (y * g.astype(jnp.float32)).astype(x.dtype)


def split_cols(p, sizes):
    return jnp.split(p, [int(s) for s in np.cumsum(sizes)[:-1]], axis=-1)


def to_heads(p, n_heads):
    B, L, _ = p.shape
    return p.reshape(B, L, n_heads, -1).transpose(0, 2, 1, 3)


def merge_heads(o):
    B, H, L, d = o.shape
    return o.transpose(0, 2, 1, 3).reshape(B, L, H * d)


def modulation(cvec, ada_w, ada_b):
    return jnp.split(jax.nn.silu(cvec) @ ada_w + ada_b, N_MOD, axis=-1)


def modulate(x, g, shift, scale):
    return rms_norm(x, g) * (1.0 + scale[:, None]) + shift[:, None]


def axial_rope_tables(T):
    t = jnp.arange(T, dtype=jnp.int32)
    pos = jnp.stack([t // GRID_W, t % GRID_W], axis=-1).astype(jnp.float32)
    n_freq = HEAD_DIM // 4
    inv_freq = ROPE_THETA ** (-jnp.arange(n_freq, dtype=jnp.float32) / n_freq)
    ang = pos[:, :, None] * inv_freq
    return jnp.cos(ang), jnp.sin(ang)


def apply_axial_rope(x, cos, sin):
    shp = x.shape
    x4 = x.astype(jnp.float32).reshape(shp[:-1] + (2, 2, HEAD_DIM // 4))
    x1, x2 = x4[..., 0, :], x4[..., 1, :]
    out = jnp.stack([x1 * cos - x2 * sin, x2 * cos + x1 * sin], axis=-2)
    return out.reshape(shp).astype(x.dtype)


def sweep_query_blocks(fn, q):
    T = q.shape[-2]
    nb = T // Q_BLOCK
    qb = jnp.moveaxis(q.reshape(q.shape[:-2] + (nb, Q_BLOCK, q.shape[-1])), -3, 0)
    out = jnp.moveaxis(lax.map(fn, qb), 0, -3)
    return out.reshape(out.shape[:-3] + (T, out.shape[-1]))


def diff_attend(q, k, v, lam):
    s = jnp.einsum("bhiqd,bhind->bhiqn", q, k, preferred_element_type=jnp.float32) * (HEAD_DIM ** -0.5)
    a = jax.nn.softmax(s, axis=-1)
    w = a[:, :, 0] - lam * a[:, :, 1]
    return jnp.einsum("bhqn,bhnv->bhqv", w.astype(v.dtype), v)


def gqa_attend(q, k, v):
    s = jnp.einsum("bgrqd,bgnd->bgrqn", q, k, preferred_element_type=jnp.float32) * (HEAD_DIM ** -0.5)
    a = jax.nn.softmax(s, axis=-1)
    return jnp.einsum("bgrqn,bgnd->bgrqd", a.astype(v.dtype), v)


def multiscale_pool(u, w, scale):
    B, L, _ = u.shape
    uf = u.astype(jnp.float32)
    cs = jnp.concatenate([jnp.zeros((B, 1, POOL_WIDTH), jnp.float32), jnp.cumsum(uf, axis=1)], axis=1)
    t = jnp.arange(L, dtype=jnp.int32)
    outs = []
    for g, win in enumerate(POOL_WINDOWS):
        lo = jnp.clip(t - win // 2, 0, L)
        hi = jnp.clip(t + win // 2, 0, L)
        sl = slice(g * POOL_GROUP_DIM, (g + 1) * POOL_GROUP_DIM)
        csg = cs[:, :, sl]
        mean = (csg[:, hi] - csg[:, lo]) / (hi - lo).astype(jnp.float32)[:, None]
        outs.append(mean - uf[:, :, sl])
    p = jnp.stack(outs, axis=2).astype(u.dtype)
    y = jnp.einsum("blgc,gcd->blgd", p, w).reshape(B, L, POOL_WIDTH)
    return y * scale


def neighbourhood_attend(q, k, v, k_ctx, v_ctx, rpb):
    B, H, T, d = q.shape
    rows = T // GRID_W
    kr = min(NA_WIN_ROWS, rows)
    kc = NA_WIN_COLS
    kg = k.reshape(B, H, rows, GRID_W, d)
    vg = v.reshape(B, H, rows, GRID_W, d)
    cols = jnp.arange(GRID_W, dtype=jnp.int32)
    col_idx = jnp.clip(cols - kc // 2, 0, GRID_W - kc)[:, None] + jnp.arange(kc, dtype=jnp.int32)[None]
    dc = col_idx - cols[:, None] + (NA_WIN_COLS - 1)
    q_rows = jnp.moveaxis(q.reshape(B, H, rows, GRID_W, d), 2, 0)
    scale = d ** -0.5

    def one_row(args):
        q_r, r = args
        r0 = jnp.clip(r - kr // 2, 0, rows - kr)
        k_nb = lax.dynamic_slice_in_dim(kg, r0, kr, axis=2)[:, :, :, col_idx]
        v_nb = lax.dynamic_slice_in_dim(vg, r0, kr, axis=2)[:, :, :, col_idx]
        dr = r0 + jnp.arange(kr, dtype=jnp.int32) - r + (NA_WIN_ROWS - 1)
        bias = rpb[:, dr[:, None, None], dc[None]].astype(jnp.float32)
        s_nb = jnp.einsum("bhcd,bhrckd->bhcrk", q_r, k_nb, preferred_element_type=jnp.float32) * scale
        s_nb = s_nb + jnp.transpose(bias, (0, 2, 1, 3))[None]
        s_ctx = jnp.einsum("bhcd,bhnd->bhcn", q_r, k_ctx, preferred_element_type=jnp.float32) * scale
        s = jnp.concatenate([s_nb.reshape(B, H, GRID_W, kr * kc), s_ctx], axis=-1)
        a = jax.nn.softmax(s, axis=-1).astype(v.dtype)
        a_nb = a[..., :kr * kc].reshape(B, H, GRID_W, kr, kc)
        return (jnp.einsum("bhcrk,bhrckd->bhcd", a_nb, v_nb)
                + jnp.einsum("bhcn,bhnd->bhcd", a[..., kr * kc:], v_ctx))

    out = lax.map(one_row, (q_rows, jnp.arange(rows, dtype=jnp.int32)))
    return jnp.moveaxis(out, 0, 2).reshape(B, H, T, d)


def mixer_pool_diff(p_lat, p_ctx, cos, sin, lam_init, pool_w, pool_scale, qn, kn,
                    lq1, lk1, lq2, lk2, subln, need_ctx):
    u_l, q_l, k_l, v_l = split_cols(p_lat, EVEN_IN_SIZES)
    u_c, q_c, k_c, v_c = split_cols(p_ctx, EVEN_IN_SIZES)

    def qk_heads(p, g):
        B, L, _ = p.shape
        return rms_norm(p.reshape(B, L, DIFF_HEADS, 2, HEAD_DIM).transpose(0, 2, 3, 1, 4), g)

    q_l = apply_axial_rope(qk_heads(q_l, qn), cos, sin)
    k_l = apply_axial_rope(qk_heads(k_l, kn), cos, sin)
    k_c = qk_heads(k_c, kn)
    v_c = to_heads(v_c, DIFF_HEADS)
    k_all = jnp.concatenate([k_c, k_l], axis=3)
    v_all = jnp.concatenate([v_c, to_heads(v_l, DIFF_HEADS)], axis=2)
    f32 = jnp.float32
    lam = (jnp.exp(jnp.sum(lq1.astype(f32) * lk1.astype(f32)))
           - jnp.exp(jnp.sum(lq2.astype(f32) * lk2.astype(f32))) + lam_init)

    def post(o):
        return merge_heads(rms_norm(o, subln) * (1.0 - lam_init))

    o_l = sweep_query_blocks(lambda qb: diff_attend(qb, k_all, v_all, lam), q_l)
    y_lat = jnp.concatenate([multiscale_pool(u_l, pool_w, pool_scale), post(o_l)], axis=-1)
    if not need_ctx:
        return y_lat, None
    o_c = diff_attend(qk_heads(q_c, qn), k_c, v_c, lam)
    y_ctx = jnp.concatenate([multiscale_pool(u_c, pool_w, pool_scale), post(o_c)], axis=-1)
    return y_lat, y_ctx


def mixer_gqa_na(p_lat, p_ctx, cos, sin, gqa_qn, gqa_kn, na_qn, na_kn, rpb, need_ctx):
    cq_l, ck_l, cv_l, nq_l, nk_l, nv_l = split_cols(p_lat, ODD_IN_SIZES)
    cq_c, ck_c, cv_c, nq_c, nk_c, nv_c = split_cols(p_ctx, ODD_IN_SIZES)
    B, T, _ = p_lat.shape
    C = p_ctx.shape[1]
    q = apply_axial_rope(rms_norm(to_heads(cq_l, GQA_HEADS), gqa_qn), cos, sin)
    q = q.reshape(B, GQA_KV_HEADS, GQA_REP, T, HEAD_DIM)
    kc = rms_norm(to_heads(ck_c, GQA_KV_HEADS), gqa_kn)
    vc = to_heads(cv_c, GQA_KV_HEADS)
    kl = apply_axial_rope(rms_norm(to_heads(ck_l, GQA_KV_HEADS), gqa_kn), cos, sin)
    k_all = jnp.concatenate([kc, kl], axis=2)
    v_all = jnp.concatenate([vc, to_heads(cv_l, GQA_KV_HEADS)], axis=2)
    o_gqa = sweep_query_blocks(lambda qb: gqa_attend(qb, k_all, v_all), q).reshape(B, GQA_HEADS, T, HEAD_DIM)
    nkc = rms_norm(to_heads(nk_c, NA_HEADS), na_kn)
    nvc = to_heads(nv_c, NA_HEADS)
    o_na = neighbourhood_attend(rms_norm(to_heads(nq_l, NA_HEADS), na_qn),
                                rms_norm(to_heads(nk_l, NA_HEADS), na_kn),
                                to_heads(nv_l, NA_HEADS), nkc, nvc, rpb)
    y_lat = jnp.concatenate([merge_heads(o_gqa), merge_heads(o_na)], axis=-1)
    if not need_ctx:
        return y_lat, None
    qcc = rms_norm(to_heads(cq_c, GQA_HEADS), gqa_qn).reshape(B, GQA_KV_HEADS, GQA_REP, C, HEAD_DIM)
    o_gqa_c = gqa_attend(qcc, kc, vc).reshape(B, GQA_HEADS, C, HEAD_DIM)
    o_na_c = gqa_attend(rms_norm(to_heads(nq_c, NA_HEADS), na_qn)[:, :, None], nkc, nvc)[:, :, 0]
    y_ctx = jnp.concatenate([merge_heads(o_gqa_c), merge_heads(o_na_c)], axis=-1)
    return y_lat, y_ctx


def peer_ffn(h, wq, sub_keys, u, v):
    B, L, D = h.shape
    nb = L // PEER_BLOCK
    hb = jnp.moveaxis(h.reshape(B, nb, PEER_BLOCK, D), 1, 0)

    def block(x):
        q = (x @ wq).reshape(B, PEER_BLOCK, PEER_HEADS, 2, PEER_KEY_DIM)
        s = jnp.einsum("bthpd,hpnd->bthpn", q, sub_keys, preferred_element_type=jnp.float32)
        sv, si = lax.top_k(s, PEER_TOPK)
        cand_s = (sv[..., 0, :, None] + sv[..., 1, None, :]).reshape(B, PEER_BLOCK, PEER_HEADS, PEER_TOPK * PEER_TOPK)
        cand_i = (si[..., 0, :, None] * PEER_N_KEYS + si[..., 1, None, :]).reshape(B, PEER_BLOCK, PEER_HEADS, PEER_TOPK * PEER_TOPK)
        top_s, pos = lax.top_k(cand_s, PEER_TOPK)
        idx = jnp.take_along_axis(cand_i, pos, axis=-1)
        g = jax.nn.softmax(top_s, axis=-1).astype(x.dtype)
        act = jax.nn.gelu(jnp.einsum("bthkd,btd->bthk", u[idx], x), approximate=False)
        return jnp.einsum("bthk,bthkd->btd", g * act, v[idx])

    out = lax.map(block, hb)
    return jnp.moveaxis(out, 0, 1).reshape(B, L, D)


def setup_inputs(seed: int = 0) -> dict:
    key = jax.random.key(seed)
    keys = iter(jax.random.split(key, 64))

    def nrm(shape, scale):
        return jax.random.normal(next(keys), shape, jnp.float32) * scale

    def gain(n):
        return 1.0 + nrm((n,), 0.1)

    D = D_MODEL
    inp = {}
    inp["x"] = nrm((BATCH, SEQ, D), 1.0)
    inp["c"] = nrm((BATCH, D), 1.0)
    inp["ctx"] = nrm((BATCH, CTX_LEN, D), 1.0)
    inp["c_ctx"] = nrm((D,), 1.0)
    inp["l0_ada_w"] = nrm((D, N_MOD * D), D ** -0.5)
    inp["l0_ada_b"] = nrm((N_MOD * D,), 0.02)
    inp["l0_norm1"] = gain(D)
    inp["l0_norm2"] = gain(D)
    inp["l0_w_in"] = nrm((D, sum(EVEN_IN_SIZES)), D ** -0.5)
    inp["l0_w_out"] = nrm((EVEN_OUT, D), EVEN_OUT ** -0.5)
    inp["l0_pool_w"] = nrm((POOL_GROUPS, POOL_GROUP_DIM, POOL_GROUP_DIM), POOL_GROUP_DIM ** -0.5)
    inp["l0_pool_scale"] = gain(POOL_WIDTH)
    inp["l0_diff_qnorm"] = gain(HEAD_DIM)
    inp["l0_diff_knorm"] = gain(HEAD_DIM)
    inp["l0_lambda_q1"] = nrm((HEAD_DIM,), 0.1)
    inp["l0_lambda_k1"] = nrm((HEAD_DIM,), 0.1)
    inp["l0_lambda_q2"] = nrm((HEAD_DIM,), 0.1)
    inp["l0_lambda_k2"] = nrm((HEAD_DIM,), 0.1)
    inp["l0_diff_subln"] = gain(DIFF_V_DIM)
    inp["l0_peer_wq"] = nrm((D, PEER_HEADS * 2 * PEER_KEY_DIM), D ** -0.5)
    inp["l0_peer_keys"] = nrm((PEER_HEADS, 2, PEER_N_KEYS, PEER_KEY_DIM), PEER_KEY_DIM ** -0.5)
    inp["l0_peer_u"] = nrm((PEER_N_EXPERTS, D), D ** -0.5)
    inp["l0_peer_v"] = nrm((PEER_N_EXPERTS, D), 0.5)
    inp["l1_ada_w"] = nrm((D, N_MOD * D), D ** -0.5)
    inp["l1_ada_b"] = nrm((N_MOD * D,), 0.02)
    inp["l1_norm1"] = gain(D)
    inp["l1_norm2"] = gain(D)
    inp["l1_w_in"] = nrm((D, sum(ODD_IN_SIZES)), D ** -0.5)
    inp["l1_w_out"] = nrm((ODD_OUT, D), ODD_OUT ** -0.5)
    inp["l1_gqa_qnorm"] = gain(HEAD_DIM)
    inp["l1_gqa_knorm"] = gain(HEAD_DIM)
    inp["l1_na_qnorm"] = gain(HEAD_DIM)
    inp["l1_na_knorm"] = gain(HEAD_DIM)
    inp["l1_na_rpb"] = nrm((NA_HEADS, 2 * NA_WIN_ROWS - 1, 2 * NA_WIN_COLS - 1), 0.1)
    inp["l1_peer_wq"] = nrm((D, PEER_HEADS * 2 * PEER_KEY_DIM), D ** -0.5)
    inp["l1_peer_keys"] = nrm((PEER_HEADS, 2, PEER_N_KEYS, PEER_KEY_DIM), PEER_KEY_DIM ** -0.5)
    inp["l1_peer_u"] = nrm((PEER_N_EXPERTS, D), D ** -0.5)
    inp["l1_peer_v"] = nrm((PEER_N_EXPERTS, D), 0.5)
    return inp


def reference(x, c, ctx, c_ctx,
              l0_ada_w, l0_ada_b, l0_norm1, l0_norm2, l0_w_in, l0_w_out, l0_pool_w, l0_pool_scale,
              l0_diff_qnorm, l0_diff_knorm, l0_lambda_q1, l0_lambda_k1, l0_lambda_q2, l0_lambda_k2,
              l0_diff_subln, l0_peer_wq, l0_peer_keys, l0_peer_u, l0_peer_v,
              l1_ada_w, l1_ada_b, l1_norm1, l1_norm2, l1_w_in, l1_w_out, l1_gqa_qnorm, l1_gqa_knorm,
              l1_na_qnorm, l1_na_knorm, l1_na_rpb, l1_peer_wq, l1_peer_keys, l1_peer_u, l1_peer_v):
    T = x.shape[1]
    cos, sin = axial_rope_tables(T)
    layers = [
        dict(ada_w=l0_ada_w, ada_b=l0_ada_b, norm1=l0_norm1, norm2=l0_norm2, w_in=l0_w_in, w_out=l0_w_out,
             mix=(l0_pool_w, l0_pool_scale, l0_diff_qnorm, l0_diff_knorm, l0_lambda_q1, l0_lambda_k1,
                  l0_lambda_q2, l0_lambda_k2, l0_diff_subln),
             peer=(l0_peer_wq, l0_peer_keys, l0_peer_u, l0_peer_v)),
        dict(ada_w=l1_ada_w, ada_b=l1_ada_b, norm1=l1_norm1, norm2=l1_norm2, w_in=l1_w_in, w_out=l1_w_out,
             mix=(l1_gqa_qnorm, l1_gqa_knorm, l1_na_qnorm, l1_na_knorm, l1_na_rpb),
             peer=(l1_peer_wq, l1_peer_keys, l1_peer_u, l1_peer_v)),
    ]
    xc = ctx
    for i in range(DEPTH):
        lp = layers[i]
        need_ctx = i < DEPTH - 1
        sh1, sc1, g1, sh2, sc2, g2 = modulation(c, lp["ada_w"], lp["ada_b"])
        csh1, csc1, cg1, csh2, csc2, cg2 = modulation(c_ctx[None], lp["ada_w"], lp["ada_b"])
        p_lat = modulate(x, lp["norm1"], sh1, sc1) @ lp["w_in"]
        p_ctx = modulate(xc, lp["norm1"], csh1, csc1) @ lp["w_in"]
        if i % 2 == 0:
            y, yc = mixer_pool_diff(p_lat, p_ctx, cos, sin, 0.8 - 0.6 * math.exp(-0.3 * i), *lp["mix"], need_ctx)
        else:
            y, yc = mixer_gqa_na(p_lat, p_ctx, cos, sin, *lp["mix"], need_ctx)
        x = x + g1[:, None] * (y @ lp["w_out"])
        x = x + g2[:, None] * peer_ffn(modulate(x, lp["norm2"], sh2, sc2), *lp["peer"])
        if need_ctx:
            xc = xc + cg1[:, None] * (yc @ lp["w_out"])
            xc = xc + cg2[:, None] * peer_ffn(modulate(xc, lp["norm2"], csh2, csc2), *lp["peer"])
    return x
```

```cpp
#include <hip/hip_runtime.h>
#include <hip/hip_bf16.h>
#include <cstdio>
#include <cstdint>
#include <cmath>
namespace pg8 {
#define PG8_LAS __attribute__((address_space(3)))
typedef unsigned short bf16_t;
typedef short bf16x8 __attribute__((ext_vector_type(8)));
typedef float f32x4 __attribute__((ext_vector_type(4)));
typedef unsigned u32x4 __attribute__((ext_vector_type(4)));
constexpr int BM = 256, BK = 64, HALF = 128, HTB = HALF * BK * 2  , STAGE_BYTES = 8 * HTB, NXCD = 8, WGM = 8;

__host__ __device__ __forceinline__ int lds_byte(int r, int c) { const int st = (r >> 4) * 2 + (c >> 5), rr = r & 15, cc = c & 31, ob = rr * 64 + cc * 2; return st * 1024 + (ob ^ (((ob >> 9) & 1) << 5)); }
__host__ __device__ __forceinline__ void stage_rc(int b, int& R, int& C) { const int st = b / 1024, sb = b % 1024, swz = sb ^ (((sb >> 9) & 1) << 5); R = (st >> 1) * 16 + swz / 64; C = (st & 1) * 32 + (swz % 64) / 2; }
__host__ __device__ __forceinline__ int perm32(int rho) { const int n = rho >> 4, i = rho & 15; return 8 * (i >> 2) + 4 * n + (i & 3); }

struct Unit { int pm, pn; };
struct Gemm { const bf16_t* A; const bf16_t* Bt; int M, N, K; };

struct StaticOrder {
    int nM, nN, nwg, G, c;
    __host__ __device__ void init(int M, int N, int G_, int c_) { nM = M / BM; nN = N / BM; nwg = nM * nN; G = G_; c = c_; }
    __host__ __device__ bool next(int i, Unit& u) const {
        const long L = (long)i * G + c; if (L >= nwg) return false;
        int wgid = (int)L; { const int q = nwg / NXCD, r = nwg % NXCD, xcd = wgid % NXCD, off = wgid / NXCD; wgid = (xcd < r ? xcd * (q + 1) : r * (q + 1) + (xcd - r) * q) + off; }
        const int nig = WGM * nN, gid = wgid / nig, fm = gid * WGM, gsz = (nM - fm) < WGM ? (nM - fm) : WGM;
        u.pm = fm + ((wgid % nig) % gsz); u.pn = (wgid % nig) / gsz; return true;
    }
    __device__ __forceinline__ void a_ready(const Unit&) const {}
    __device__ __forceinline__ void done(const Unit&) const {}
};

__device__ __forceinline__ unsigned cvt_pk_bf16(float lo, float hi) { unsigned r; asm volatile("v_cvt_pk_bf16_f32 %0, %1, %2" : "=v"(r) : "v"(lo), "v"(hi)); return r; }
typedef float f32x2 __attribute__((ext_vector_type(2)));
__device__ __forceinline__ f32x2 gelu_pk(f32x2 v) {
    const f32x2 av = __builtin_elementwise_abs(v), d = av * 0.2316418882f + 1.0f;
    f32x2 t; t.x = __builtin_amdgcn_rcpf(d.x); t.y = __builtin_amdgcn_rcpf(d.y);
    f32x2 q = t * 0.5307027145f + (-0.7265760135f); q = q * t + 0.7107068705f; q = q * t + (-0.142248368f); q = q * t + 0.127414796f; q = q * t;
    const f32x2 s = (v * v) * (-0.72134752044f);
    f32x2 e; e.x = __builtin_amdgcn_exp2f(s.x); e.y = __builtin_amdgcn_exp2f(s.y);
    const f32x2 m = v * (q * e), r = v - m;
    f32x2 o; o.x = v.x < 0.f ? m.x : r.x; o.y = v.y < 0.f ? m.y : r.y; return o;
}

template <int ACT  > struct EpiBf16 {
    static constexpr bool PERM = true, AFTER_DRAIN = false; static_assert(ACT == 0 || ACT == 1, "EpiBf16: ACT is 0 (none) or 1 (gelu_pk)");
    bf16_t* O; int ldc; const float* bias; int split_cols; size_t split_stride; float scale0;
    __device__ __forceinline__ void operator()(const f32x4 (&acc)[2][2][4][2], const Unit& u, int wr, int wc, int fr, int fq) const {
        const int row0 = u.pm * BM + wr * 64 + fr; int colt = u.pn * BM; bf16_t* base = O;
        float sc = 1.f; if (split_cols) { const int t = colt / split_cols; base += (size_t)t * split_stride; colt -= t * split_cols; if (t == 0) sc = scale0; }
        const int col0 = colt + wc * 32 + 8 * fq, bcol0 = u.pn * BM + wc * 32 + 8 * fq;
        f32x4 bv[2][2];
#pragma unroll
        for (int bj = 0; bj < 2; ++bj)
#pragma unroll
            for (int n = 0; n < 2; ++n) bv[bj][n] = bias ? *(const f32x4*)(bias + bcol0 + bj * HALF + 4 * n) : (f32x4){0.f, 0.f, 0.f, 0.f};
#pragma unroll
        for (int ai = 0; ai < 2; ++ai)
#pragma unroll
            for (int m = 0; m < 4; ++m) { bf16_t* rowp = base + (size_t)(row0 + ai * HALF + m * 16) * ldc + col0;
#pragma unroll
                for (int bj = 0; bj < 2; ++bj) { f32x4 v0 = acc[ai][bj][m][0] + bv[bj][0], v1 = acc[ai][bj][m][1] + bv[bj][1];
                    if (ACT == 1) { f32x2 a = gelu_pk((f32x2){v0[0], v0[1]}), b = gelu_pk((f32x2){v0[2], v0[3]}), c = gelu_pk((f32x2){v1[0], v1[1]}), d = gelu_pk((f32x2){v1[2], v1[3]});
                        v0 = (f32x4){a.x, a.y, b.x, b.y}; v1 = (f32x4){c.x, c.y, d.x, d.y}; }
                    v0 = v0 * sc; v1 = v1 * sc; u32x4 w; w.x = cvt_pk_bf16(v0[0], v0[1]); w.y = cvt_pk_bf16(v0[2], v0[3]); w.z = cvt_pk_bf16(v1[0], v1[1]); w.w = cvt_pk_bf16(v1[2], v1[3]);
                    *(u32x4*)(rowp + bj * HALF) = w; } }
    }
};

struct EpiRes {
    static constexpr bool PERM = true, AFTER_DRAIN = false;
    bf16_t* out; const float* xlat; const float* xctx; const float* g1; int from_input;
    __device__ __forceinline__ void operator()(const f32x4 (&acc)[2][2][4][2], const Unit& u, int wr, int wc, int fr, int fq) const {
        const int b = u.pm / 33, seg = u.pm % 33, mr = seg == 0 ? 8 : b;
        const int rt0 = wr * 64 + fr, col0 = u.pn * BM + wc * 32 + 8 * fq;
        const float* gp = g1 + (size_t)mr * 6144 + col0;
        const float* xbase = seg == 0 ? xctx + (size_t)b * 256 * 1024 : xlat + ((size_t)b * 8192 + (size_t)(seg - 1) * 256) * 1024;
        bf16_t* obase = out + (size_t)u.pm * BM * 1024;
#pragma unroll
        for (int bj = 0; bj < 2; ++bj) { const f32x4 g0 = *(const f32x4*)(gp + bj * HALF), g1v = *(const f32x4*)(gp + bj * HALF + 4);
#pragma unroll
            for (int ai = 0; ai < 2; ++ai)
#pragma unroll
                for (int m = 0; m < 4; ++m) { const unsigned ro = (unsigned)(rt0 * 1024 + col0) + (unsigned)((ai * HALF + m * 16) * 1024 + bj * HALF);
                    f32x4 x0, x1;
                    if (from_input) { x0 = *(const f32x4*)(xbase + ro); x1 = *(const f32x4*)(xbase + ro + 4); }
                    else { const u32x4 w = *(const u32x4*)(obase + ro);
                        x0 = (f32x4){__builtin_bit_cast(float, w.x << 16), __builtin_bit_cast(float, w.x & 0xffff0000u), __builtin_bit_cast(float, w.y << 16), __builtin_bit_cast(float, w.y & 0xffff0000u)};
                        x1 = (f32x4){__builtin_bit_cast(float, w.z << 16), __builtin_bit_cast(float, w.z & 0xffff0000u), __builtin_bit_cast(float, w.w << 16), __builtin_bit_cast(float, w.w & 0xffff0000u)}; }
                    const f32x4 v0 = x0 + g0 * acc[ai][bj][m][0], v1 = x1 + g1v * acc[ai][bj][m][1];
                    u32x4 o; o.x = cvt_pk_bf16(v0[0], v0[1]); o.y = cvt_pk_bf16(v0[2], v0[3]); o.z = cvt_pk_bf16(v1[0], v1[1]); o.w = cvt_pk_bf16(v1[2], v1[3]);
                    *(u32x4*)(obase + ro) = o; }
            asm volatile("" ::: "memory"); }
    }
};

template <int LAYER> struct EpiHeadNorm {
    static constexpr bool PERM = true, AFTER_DRAIN = false;
    bf16_t* O; int ldc; const float* gains; const float* RT; PG8_LAS float* xch; float qscale;
    __device__ __forceinline__ static int kind_of(int pn, int hh) {
        if (LAYER == 0) return (pn >= 1 && pn <= 3) ? 1 : (pn >= 4 && pn <= 6) ? 2 : 0;
        return pn <= 1 ? 1 : pn == 2 ? (hh < 2 ? 2 : 0) : pn <= 4 ? 1 : pn <= 6 ? 2 : 0;
    }
    __device__ __forceinline__ void operator()(const f32x4 (&acc)[2][2][4][2], const Unit& u, int wr, int wc, int fr, int fq) const {
        asm volatile("" : "+v"(fr), "+v"(fq));
        const int pn = u.pn, wid = wr * 4 + wc;
        const int row0 = u.pm * BM + wr * 64 + fr, col0 = pn * BM + wc * 32 + 8 * fq;
        const bool any = LAYER == 0 ? (pn >= 1 && pn <= 6) : (pn <= 6);
        if (any) {
#pragma unroll
            for (int ai = 0; ai < 2; ++ai)
#pragma unroll
                for (int m = 0; m < 4; ++m)
#pragma unroll
                    for (int bj = 0; bj < 2; ++bj) { const f32x4 a = acc[ai][bj][m][0], b = acc[ai][bj][m][1];
                        float s = (a[0] * a[0] + a[1] * a[1]) + (a[2] * a[2] + a[3] * a[3]) + (b[0] * b[0] + b[1] * b[1]) + (b[2] * b[2] + b[3] * b[3]);
                        s += __shfl_xor(s, 16); s += __shfl_xor(s, 32);
                        if (fq == 0) xch[wid * 256 + ((ai * 4 + m) * 2 + bj) * 16 + fr] = s; }
            asm volatile("s_waitcnt lgkmcnt(0)" ::: "memory");
            __builtin_amdgcn_s_barrier();
        }
        const int seg = u.pm % 33; const bool lat = seg != 0;
#pragma unroll
        for (int ai = 0; ai < 2; ++ai)
#pragma unroll
            for (int m = 0; m < 4; ++m) { const int rt = wr * 64 + fr + ai * HALF + m * 16; bf16_t* rowp = O + (size_t)(u.pm * BM + rt) * ldc + col0;
                const int t = (seg - 1) * 256 + rt;
#pragma unroll
                for (int bj = 0; bj < 2; ++bj) {
                    const int hh = 2 * bj + (wc >> 1); const int kind = kind_of(pn, hh);
                    float rs = 1.f; const bool rope = kind != 0 && lat && (LAYER == 0 || pn <= 2);
                    if (kind != 0) {
                        const float tot = xch[wid * 256 + ((ai * 4 + m) * 2 + bj) * 16 + fr] + xch[(wid ^ 1) * 256 + ((ai * 4 + m) * 2 + bj) * 16 + fr];
                        rs = __builtin_amdgcn_rsqf(tot * (1.f / 64) + 1e-6f) * (kind == 1 ? qscale : 1.f); }
                    const bool fam2 = LAYER == 1 && pn >= 3;
                    const float* gp = gains + ((kind == 1 ? 0 : 1) + (fam2 ? 2 : 0)) * 64 + 32 * (wc & 1) + 8 * fq;
                    const int pos = (wc & 1) == 0 ? (t >> 6) : (t & 63);
                    const float* cp = RT + pos * 16 + 8 * (fq & 1);
                    unsigned wv[4];
#pragma unroll
                    for (int n = 0; n < 2; ++n) { f32x4 v = acc[ai][bj][m][n];
                        if (kind != 0) { v = v * rs * *(const f32x4*)(gp + 4 * n);
                            if (rope) { const f32x4 c = *(const f32x4*)(cp + 4 * n), sn = *(const f32x4*)(cp + 2048 + 4 * n); f32x4 p;
#pragma unroll
                                for (int e = 0; e < 4; ++e) p[e] = __shfl_xor(v[e], 32);
                                v = ((fq >> 1) == 0) ? v * c - p * sn : v * c + p * sn; } }
                        wv[2 * n] = cvt_pk_bf16(v[0], v[1]); wv[2 * n + 1] = cvt_pk_bf16(v[2], v[3]); }
                    u32x4 w; w.x = wv[0]; w.y = wv[1]; w.z = wv[2]; w.w = wv[3];
                    *(u32x4*)(rowp + bj * HALF) = w; }
                asm volatile("" ::: "memory"); }
    }
};
struct LatOrder {
    StaticOrder S;
    __host__ __device__ void init(int N, int G_, int c_) { S.init(65536, N, G_, c_); }
    __host__ __device__ bool next(int i, Unit& u) const { if (!S.next(i, u)) return false; u.pm = u.pm + u.pm / 32 + 1; return true; }
    __device__ __forceinline__ void a_ready(const Unit&) const {}
    __device__ __forceinline__ void done(const Unit&) const {}
};
template <class Epi, class Sched, bool ALIGN_EPI = false, bool SP2 = false>
__device__ __forceinline__ void gemm_phase(PG8_LAS unsigned char* lds, const Gemm g, const Sched& S, const Epi& E) {
    const int tid = threadIdx.x, wid = __builtin_amdgcn_readfirstlane(tid >> 6), lane = tid & 63, wr = wid >> 2, wc = wid & 3, fr = lane & 15, fq = lane >> 4;
    const int K = g.K, nt = K / BK;
    unsigned voffA[2], voffB[2];
#pragma unroll
    for (int i = 0; i < 2; ++i) { int R, C; stage_rc(tid * 16 + i * 8192, R, C); const int Rb = Epi::PERM ? ((R & ~31) + perm32(R & 31)) : R;
        voffA[i] = (unsigned)(R * K + C) * 2u; voffB[i] = (unsigned)(Rb * K + C) * 2u; }
    const size_t kstep = (size_t)(BK * 2);
    const size_t hstep = (size_t)HALF * K * 2;
    const size_t tstep = 2 * hstep;
    const unsigned ldsw = (unsigned)wid * 1024u;
    const int aoff = lds_byte(wr * 64 + fr, fq * 8), boff = lds_byte(wc * 32 + fr, fq * 8);
#define PG8_SA(b, h) (((b) * 2 + (h)) * HTB)
#define PG8_SB(b, h) ((4 + (b) * 2 + (h)) * HTB)
#define PG8_STAGE(bufoff, gbase, voff) do { _Pragma("unroll") for (int _i = 0; _i < 2; ++_i) \
        __builtin_amdgcn_global_load_lds((const unsigned*)((const char*)(gbase) + (voff)[_i]), (PG8_LAS unsigned*)(lds + (bufoff) + ldsw + _i * 8192), 16, 0, 0); } while (0)
#define PG8_LDA(dst, b, h) do { _Pragma("unroll") for (int m = 0; m < 4; ++m) _Pragma("unroll") for (int k = 0; k < 2; ++k) dst[m][k] = *(const PG8_LAS bf16x8*)(lds + PG8_SA(b, h) + aoff + m * 2048 + k * 1024); } while (0)
#define PG8_LDB(dst, b, h) do { _Pragma("unroll") for (int n = 0; n < 2; ++n) _Pragma("unroll") for (int k = 0; k < 2; ++k) dst[n][k] = *(const PG8_LAS bf16x8*)(lds + PG8_SB(b, h) + boff + n * 2048 + k * 1024); } while (0)
#define PG8_MMA(ai, bj, At, Bt) do { __builtin_amdgcn_s_setprio(1); _Pragma("unroll") for (int m = 0; m < 4; ++m) _Pragma("unroll") for (int n = 0; n < 2; ++n) _Pragma("unroll") for (int k = 0; k < 2; ++k) \
        acc[ai][bj][m][n] = __builtin_amdgcn_mfma_f32_16x16x32_bf16(Bt[n][k], At[m][k], acc[ai][bj][m][n], 0, 0, 0); __builtin_amdgcn_s_setprio(0); } while (0)
#define PG8_WAIT_V(n) asm volatile("s_waitcnt vmcnt(" #n ")" ::: "memory")
#define PG8_WAIT_L(n) asm volatile("s_waitcnt lgkmcnt(" #n ")" ::: "memory")
#define PG8_BAR __builtin_amdgcn_s_barrier()
#define PG8_SCHED __builtin_amdgcn_sched_barrier(0)
    Unit cur, nxt; int ui = 0;
    if (!S.next(0, cur)) return;
    f32x4 acc[2][2][4][2];
#pragma unroll
    for (int a = 0; a < 2; ++a)
#pragma unroll
        for (int b = 0; b < 2; ++b)
#pragma unroll
            for (int m = 0; m < 4; ++m)
#pragma unroll
                for (int n = 0; n < 2; ++n) acc[a][b][m][n] = (f32x4){0.f, 0.f, 0.f, 0.f};
    bf16x8 At[4][2], B0[2][2], B1[2][2];
    const char* cA = (const char*)g.A + (size_t)cur.pm * tstep; const char* cB = (const char*)g.Bt + (size_t)cur.pn * tstep;
    S.a_ready(cur);
    if constexpr (SP2) {
        PG8_STAGE(PG8_SB(0, 0), cB, voffB); PG8_STAGE(PG8_SB(0, 1), cB + hstep, voffB); PG8_STAGE(PG8_SA(0, 0), cA, voffA); PG8_STAGE(PG8_SA(0, 1), cA + hstep, voffA);
        if (wr == 1) PG8_BAR;
        PG8_WAIT_V(2); PG8_BAR;
        PG8_STAGE(PG8_SB(1, 0), cB + kstep, voffB); PG8_STAGE(PG8_SA(1, 0), cA + kstep, voffA); PG8_STAGE(PG8_SB(1, 1), cB + hstep + kstep, voffB);
        PG8_WAIT_V(6); PG8_BAR;
    } else {
        PG8_STAGE(PG8_SB(0, 0), cB, voffB); PG8_STAGE(PG8_SA(0, 0), cA, voffA); PG8_STAGE(PG8_SB(0, 1), cB + hstep, voffB); PG8_STAGE(PG8_SA(0, 1), cA + hstep, voffA);
        if (wr == 1) PG8_BAR;
        PG8_WAIT_V(4); PG8_BAR;
        PG8_STAGE(PG8_SB(1, 0), cB + kstep, voffB); PG8_STAGE(PG8_SA(1, 0), cA + kstep, voffA); PG8_STAGE(PG8_SB(1, 1), cB + hstep + kstep, voffB);
        PG8_WAIT_V(6); PG8_BAR;
    }
    for (;;) {
        const bool has_next = S.next(ui + 1, nxt);
        const char* nA = has_next ? (const char*)g.A + (size_t)nxt.pm * tstep : cA; const char* nB = has_next ? (const char*)g.Bt + (size_t)nxt.pn * tstep : cB;
        for (int t = 0; t < nt; t += 2) {
            const bool last = (t == nt - 2);
            const char* a1 = cA + (size_t)(t + 1) * kstep;
            const char* a2 = last ? nA : cA + (size_t)(t + 2) * kstep; const char* b2 = last ? nB : cB + (size_t)(t + 2) * kstep;
            const char* a3 = a2 + kstep; const char* b3 = b2 + kstep;
            if (last && has_next) S.a_ready(nxt);
            if constexpr (SP2) {
            PG8_LDB(B0, 0, 0); PG8_LDB(B1, 0, 1); PG8_SCHED; PG8_LDA(At, 0, 0); PG8_STAGE(PG8_SA(1, 1), a1 + hstep, voffA);
            PG8_WAIT_V(8); PG8_WAIT_L(0); PG8_BAR; PG8_MMA(0, 0, At, B0); PG8_MMA(0, 1, At, B1); PG8_BAR; PG8_SCHED;
            PG8_LDA(At, 0, 1); PG8_STAGE(PG8_SB(0, 0), b2, voffB); PG8_STAGE(PG8_SB(0, 1), b2 + hstep, voffB); PG8_STAGE(PG8_SA(0, 0), a2, voffA);
            PG8_WAIT_V(8); PG8_WAIT_L(0); PG8_BAR; PG8_MMA(1, 0, At, B0); PG8_MMA(1, 1, At, B1); PG8_BAR; PG8_SCHED;
            PG8_LDB(B0, 1, 0); PG8_LDB(B1, 1, 1); PG8_SCHED; PG8_LDA(At, 1, 0); PG8_STAGE(PG8_SA(0, 1), a2 + hstep, voffA);
            PG8_WAIT_V(8); PG8_WAIT_L(0); PG8_BAR; PG8_MMA(0, 0, At, B0); PG8_MMA(0, 1, At, B1); PG8_BAR; PG8_SCHED;
            PG8_LDA(At, 1, 1); PG8_STAGE(PG8_SB(1, 0), b3, voffB); PG8_STAGE(PG8_SB(1, 1), b3 + hstep, voffB); PG8_STAGE(PG8_SA(1, 0), a3, voffA);
            PG8_WAIT_V(8); PG8_WAIT_L(0); PG8_BAR; PG8_MMA(1, 0, At, B0); PG8_MMA(1, 1, At, B1); PG8_BAR; PG8_SCHED;
            } else {
            PG8_LDB(B0, 0, 0); PG8_SCHED; PG8_LDA(At, 0, 0); PG8_STAGE(PG8_SA(1, 1), a1 + hstep, voffA);
            PG8_WAIT_L(8); PG8_BAR; PG8_WAIT_L(0); PG8_MMA(0, 0, At, B0); PG8_BAR; PG8_SCHED;
            PG8_LDB(B1, 0, 1); PG8_STAGE(PG8_SB(0, 0), b2, voffB);
            PG8_BAR; PG8_WAIT_L(0); PG8_MMA(0, 1, At, B1); PG8_BAR;
            PG8_LDA(At, 0, 1); PG8_STAGE(PG8_SA(0, 0), a2, voffA);
            PG8_BAR; PG8_WAIT_L(0); PG8_MMA(1, 0, At, B0); PG8_BAR; PG8_SCHED;
            PG8_STAGE(PG8_SB(0, 1), b2 + hstep, voffB);
            PG8_WAIT_V(6); PG8_BAR; PG8_MMA(1, 1, At, B1); PG8_BAR;
            PG8_LDB(B0, 1, 0); PG8_SCHED; PG8_LDA(At, 1, 0); PG8_STAGE(PG8_SA(0, 1), a2 + hstep, voffA);
            PG8_WAIT_L(8); PG8_BAR; PG8_WAIT_L(0); PG8_MMA(0, 0, At, B0); PG8_BAR; PG8_SCHED;
            PG8_LDB(B1, 1, 1); PG8_STAGE(PG8_SB(1, 0), b3, voffB);
            PG8_BAR; PG8_WAIT_L(0); PG8_MMA(0, 1, At, B1); PG8_BAR;
            PG8_LDA(At, 1, 1); PG8_STAGE(PG8_SA(1, 0), a3, voffA);
            PG8_BAR; PG8_WAIT_L(0); PG8_MMA(1, 0, At, B0); PG8_BAR; PG8_SCHED;
            PG8_STAGE(PG8_SB(1, 1), b3 + hstep, voffB);
            PG8_WAIT_V(6); PG8_BAR; PG8_MMA(1, 1, At, B1); PG8_BAR;
            }
        }
        if constexpr (ALIGN_EPI) { if (wr == 0) PG8_BAR; }
        if constexpr (!Epi::AFTER_DRAIN) { E(acc, cur, wr, wc, fr, fq); S.done(cur); }
        if (!has_next) break;
#pragma unroll
        for (int a = 0; a < 2; ++a)
#pragma unroll
            for (int b = 0; b < 2; ++b)
#pragma unroll
                for (int m = 0; m < 4; ++m)
#pragma unroll
                    for (int n = 0; n < 2; ++n) acc[a][b][m][n] = (f32x4){0.f, 0.f, 0.f, 0.f};
        cur = nxt; cA = nA; cB = nB; ++ui;
        if constexpr (ALIGN_EPI) { if (wr == 1) PG8_BAR; }
    }
    PG8_WAIT_V(0);
    if constexpr (!ALIGN_EPI) { if (wr == 0) PG8_BAR; }
    PG8_BAR;
    if constexpr (Epi::AFTER_DRAIN) { E.fused(acc, cur, wr, wc, fr, fq, lds, wid, lane); S.done(cur); }
#undef PG8_SA
#undef PG8_SB
#undef PG8_STAGE
#undef PG8_LDA
#undef PG8_LDB
#undef PG8_MMA
#undef PG8_WAIT_V
#undef PG8_WAIT_L
#undef PG8_BAR
#undef PG8_SCHED
}
}

namespace attn_body {
using bf16=__hip_bfloat16;
using bf16x8=__attribute__((ext_vector_type(8)))short;
using s16x4=__attribute__((ext_vector_type(4)))short;
using f32x16=__attribute__((ext_vector_type(16)))float;
using u32x4=__attribute__((ext_vector_type(4)))unsigned;
constexpr int D=64;
constexpr int NW=8,QBLK=32,QB=QBLK*NW,KVBLK=64;
__device__ __forceinline__ int crow(int r,int hi){return (r&3)+8*(r>>2)+4*hi;}
#define SBAR() __builtin_amdgcn_sched_barrier(0)
__device__ __forceinline__ void cmask(f32x16&p0,f32x16&p1,int jb,int qrel,int hi){
  const float NEG=-INFINITY; int kb=64*jb+4*hi;
  #pragma unroll
  for(int r=0;r<16;++r){int kv=kb+(r&3)+8*(r>>2); if(kv>qrel)p0[r]=NEG; if(kv+32>qrel)p1[r]=NEG;}
}

constexpr int NSLOT=3, SLOTB=8192;
constexpr int LDS_K=0, LDS_V=NSLOT*SLOTB, LDS_WS=2*NSLOT*SLOTB, LDS_OST=LDS_WS+NW*64*4, LDS_BYTES=LDS_OST+NW*4096;
constexpr float C2=0.125f*1.4426950408889634f;
__device__ __forceinline__ void glds16(const void*gsrc,unsigned lds_dst){unsigned keep;
  asm volatile("s_mov_b32 %0, m0\n\ts_mov_b32 m0, %2\n\ts_nop 0\n\tglobal_load_lds_dwordx4 %1, off\n\ts_mov_b32 m0, %0":"=&s"(keep):"v"(gsrc),"s"(lds_dst):"memory");}
__device__ __forceinline__ float max3f(float a,float b,float c){float r;asm("v_max3_f32 %0, %1, %2, %3":"=v"(r):"v"(a),"v"(b),"v"(c));return r;}
__device__ __forceinline__ float max2f(float a,float b){float r;asm("v_max_f32_e32 %0, %1, %2":"=v"(r):"v"(a),"v"(b));return r;}
__device__ __forceinline__ float fadd_s(float a,float b){float r;asm("v_add_f32_e32 %0, %1, %2":"=v"(r):"v"(a),"v"(b));return r;}
__device__ __forceinline__ float fsub_s(float a,float b){float r;asm("v_sub_f32_e32 %0, %1, %2":"=v"(r):"v"(a),"v"(b));return r;}
typedef float f32x2_t __attribute__((ext_vector_type(2))); typedef __bf16 bf16x2_t __attribute__((ext_vector_type(2)));
__device__ __forceinline__ unsigned cvtpk_s(float lo,float hi){f32x2_t v={lo,hi};bf16x2_t b=__builtin_convertvector(v,bf16x2_t);return __builtin_bit_cast(unsigned,b);}
#define WAIT_BAR(N) asm volatile("s_waitcnt vmcnt(" #N ") lgkmcnt(0)\n\ts_barrier":::"memory")

__device__ __forceinline__ void qkt(f32x16&p0,f32x16&p1,const char*Kslot,const bf16x8*qr,const f32x16&negm,int r32,int hi){
  const char*kb=Kslot+hi*1024+r32*16;
  #pragma unroll
  for(int d0=0;d0<4;++d0){
    const bf16x8 b0=*reinterpret_cast<const bf16x8*>(kb+d0*2048);
    const bf16x8 b1=*reinterpret_cast<const bf16x8*>(kb+d0*2048+512);
    if(d0==0){p0=__builtin_amdgcn_mfma_f32_32x32x16_bf16(b0,qr[0],negm,0,0,0);p1=__builtin_amdgcn_mfma_f32_32x32x16_bf16(b1,qr[0],negm,0,0,0);}
    else{p0=__builtin_amdgcn_mfma_f32_32x32x16_bf16(b0,qr[d0],p0,0,0,0);p1=__builtin_amdgcn_mfma_f32_32x32x16_bf16(b1,qr[d0],p1,0,0,0);}}
}
typedef __attribute__((address_space(3))) const char* lds_cptr;
typedef short v4i16_t __attribute__((ext_vector_type(4)));
__device__ __forceinline__ void kload8(bf16x8*kf,lds_cptr kp){
  kf[0]=*(const __attribute__((address_space(3))) bf16x8*)(kp);      kf[1]=*(const __attribute__((address_space(3))) bf16x8*)(kp+512);
  kf[2]=*(const __attribute__((address_space(3))) bf16x8*)(kp+2048); kf[3]=*(const __attribute__((address_space(3))) bf16x8*)(kp+2560);
  kf[4]=*(const __attribute__((address_space(3))) bf16x8*)(kp+4096); kf[5]=*(const __attribute__((address_space(3))) bf16x8*)(kp+4608);
  kf[6]=*(const __attribute__((address_space(3))) bf16x8*)(kp+6144); kf[7]=*(const __attribute__((address_space(3))) bf16x8*)(kp+6656);
}
__device__ __forceinline__ void kload2(bf16x8*kf,lds_cptr kp,int j){ kf[2*j]=*(const __attribute__((address_space(3))) bf16x8*)(kp+j*2048); kf[2*j+1]=*(const __attribute__((address_space(3))) bf16x8*)(kp+j*2048+512); }
__device__ __forceinline__ s16x4 vtr(lds_cptr p){ return __builtin_bit_cast(s16x4,__builtin_amdgcn_ds_read_tr16_b64_v4i16((__attribute__((address_space(3))) v4i16_t*)p)); }
__device__ __forceinline__ float rowmax(const f32x16&p0,const f32x16&p1){
  float a=max3f(p0[0],p0[1],p1[0]),b=max3f(p0[2],p0[3],p1[1]);a=max3f(a,p1[2],p1[3]);
  #pragma unroll
  for(int r=4;r<16;r+=4){a=max3f(a,p0[r],p0[r+1]);b=max3f(b,p0[r+2],p0[r+3]);a=max3f(a,p1[r],p1[r+1]);b=max3f(b,p1[r+2],p1[r+3]);}
  const float m=max2f(a,b);
  auto rr=__builtin_amdgcn_permlane32_swap(__float_as_uint(m),__float_as_uint(m),false,false);
  return max2f(__uint_as_float(rr[0]),__uint_as_float(rr[1]));
}
__device__ __forceinline__ void pv(f32x16*o,int vb,bf16x8 pa0,bf16x8 pa1,bf16x8 pa2,bf16x8 pa3){
  #pragma unroll
  for(int d0=0;d0<2;++d0){s16x4 lo[4],hi[4];
    #pragma unroll
    for(int ks=0;ks<4;++ks){
      asm volatile("ds_read_b64_tr_b16 %0,%1 offset:%c2":"=&v"(lo[ks]):"v"(vb),"i"(d0*4096+ks*1024):"memory");
      asm volatile("ds_read_b64_tr_b16 %0,%1 offset:%c2":"=&v"(hi[ks]):"v"(vb),"i"(d0*4096+ks*1024+512):"memory");}
    asm volatile("s_waitcnt lgkmcnt(0)":::"memory");SBAR();
    #define PK(k) (bf16x8){lo[k][0],lo[k][1],lo[k][2],lo[k][3],hi[k][0],hi[k][1],hi[k][2],hi[k][3]}
    o[d0]=__builtin_amdgcn_mfma_f32_32x32x16_bf16(pa0,PK(0),o[d0],0,0,0);
    o[d0]=__builtin_amdgcn_mfma_f32_32x32x16_bf16(pa1,PK(1),o[d0],0,0,0);
    o[d0]=__builtin_amdgcn_mfma_f32_32x32x16_bf16(pa2,PK(2),o[d0],0,0,0);
    o[d0]=__builtin_amdgcn_mfma_f32_32x32x16_bf16(pa3,PK(3),o[d0],0,0,0);
    #undef PK
  }
}

#ifndef ATTN_STORE16
#define ATTN_STORE16(p,v) (*(u32x4*)(p)=(v))
#endif
template<int DV2,int P,int OP,int MODE> __device__ __forceinline__ void attn_unit2(const bf16*Q0,const bf16*__restrict__ Kh,const bf16*__restrict__ Vh,bf16*O0,const int NT,char*shm,const float*rpbh,const int gr0,
    const bool pre,const bool has_next,const bf16*__restrict__ Khn,const bf16*__restrict__ Vhn){
  const int tid=threadIdx.x,lane=tid&63,r32=lane&31,hi=lane>>5; const int wid=__builtin_amdgcn_readfirstlane(tid>>6);
  const bf16*Qw=Q0+(long)(wid*QBLK)*P;
  constexpr int VSL=DV2, LWS_=LDS_V+NSLOT*SLOTB*DV2, LOST_=LWS_+NW*64*4;
  const unsigned lds0=(unsigned)(uintptr_t)shm;
  float*wsf=(float*)(shm+LWS_)+wid*64;
  const bf16*ksrc=Kh+(long)lane*P+wid*8;
  const bf16*vsrc=Vh+(long)(16*(wid&3)+(lane>>2))*P+(wid>>2)*32+(lane&3)*8;
  const unsigned kdst=lds0+LDS_K+wid*1024, vdst=lds0+LDS_V+wid*1024;
  #define TROW(t) (MODE==1?((t)<4?(t)*64:nb0+(t)*64):(t)*64)
  #define DMA_K(t,slot) glds16(ksrc+(long)TROW(t)*P,(unsigned)__builtin_amdgcn_readfirstlane(kdst+(slot)))
  #define DMA_V(t,slot) do{ glds16(vsrc+(long)TROW(t)*P,(unsigned)__builtin_amdgcn_readfirstlane(vdst+(slot)*VSL)); \
    if constexpr(DV2==2) glds16(vsrc+64+(long)TROW(t)*P,(unsigned)__builtin_amdgcn_readfirstlane(vdst+(slot)*VSL+8192)); }while(0)
  const int vb0=(int)(lds0+LDS_V)+((lane>>4)&1)*32+(lane&3)*8+(4*hi+((lane&15)>>2))*64;
  const char*Kbase=shm+LDS_K; bf16x8 kf[8];
  const lds_cptr shm3=(lds_cptr)shm; const lds_cptr kp0=shm3+LDS_K+hi*1024+r32*16; const lds_cptr vp0=shm3+LDS_V+((lane>>4)&1)*32+(lane&3)*8+(4*hi+((lane&15)>>2))*64;
  const int rbase=min(max(gr0-4,0),116), nb0=256+rbase*64-256;
  const int qrow=gr0+(wid>>1), r0q=min(max(qrow-4,0),120), qc=32*(wid&1)+r32, c0q=min(max(qc-8,0),48);
  const int cb=15-qc+4*hi, kvb=4*hi-c0q;
  typedef __attribute__((address_space(3))) float* lds_fptr;
  const lds_fptr btab=(lds_fptr)(shm3+LOST_+NW*4096);
  if constexpr(MODE==1){ if(tid<465) btab[tid]=rpbh[tid]*1.4426950408889634f; }
  if(!pre){DMA_K(0,0);DMA_V(0,0);DMA_K(1,SLOTB);}
  bf16x8 qr[4];
  #pragma unroll
  for(int d0=0;d0<4;++d0)qr[d0]=*reinterpret_cast<const bf16x8*>(&Qw[(long)r32*P+d0*16+hi*8]);
  float l_reg=0.f;f32x16 o[2*DV2];
  #pragma unroll
  for(int i=0;i<2*DV2;++i)o[i]=f32x16{};
  const f32x16 zero16=f32x16{};
  #define CMASK(P0,P1,t) do{ if constexpr(MODE==1){ if((t)>=4){ const int kr_=rbase+(t)-4; const bool rv_=(unsigned)(kr_-r0q)<8u; const lds_fptr bt_=btab+(rv_?(kr_-qrow+7):0)*31+cb; \
      _Pragma("unroll") for(int r=0;r<16;++r){ const int kv_=(r&3)+8*(r>>2); const bool v0_=rv_&&((unsigned)(kv_+kvb)<16u), v1_=rv_&&((unsigned)(kv_+32+kvb)<16u); \
        const float b0_=bt_[kv_], b1_=bt_[kv_+32]; P0[r]=v0_?P0[r]+b0_:-INFINITY; P1[r]=v1_?P1[r]+b1_:-INFINITY; } } } }while(0)
  #define START(P0,P1) do{ _Pragma("unroll") for(int r=0;r<16;++r)P0[r]=__builtin_amdgcn_exp2f(P0[r]); }while(0)
  #define RESC() do{}while(0)
  f32x16 pA0,pA1,pB0,pB1;
  #define WAIT_K1V() do{ if constexpr(DV2==2){WAIT_BAR(3);} else {WAIT_BAR(2);} }while(0)
  #define WAIT_V1() do{ if constexpr(DV2==2){WAIT_BAR(2);} else {WAIT_BAR(1);} }while(0)
  int sl_prev=0,sl_cur=0,sl_next=SLOTB;
  #define ROT() do{sl_prev=sl_cur;sl_cur=sl_next;sl_next=(sl_next==(NSLOT-1)*SLOTB)?0:sl_next+SLOTB;}while(0)
  if(!pre)DMA_K(2,2*SLOTB);
  WAIT_BAR(3);
  qkt(pA0,pA1,Kbase,qr,zero16,r32,hi);asm volatile("s_nop 15\n\ts_nop 7":"+v"(pA0),"+v"(pA1));CMASK(pA0,pA1,0);
  START(pA0,pA1);
  _Pragma("unroll") for(int r=0;r<16;++r)pA1[r]=__builtin_amdgcn_exp2f(pA1[r]);
  WAIT_BAR(0);
  DMA_K(3,0);DMA_V(1,SLOTB);
  ROT();
  kload8(kf,kp0+sl_cur);
  WAIT_K1V();
  s16x4 vlo[8],vhi[8]; u32x4 pw0,pw1,pw2,pw3;
  #define PKW(P,B) cvtpk_s(P[B],P[B+1])
  #define PAF(k) __builtin_bit_cast(bf16x8,pw##k)
  #define VFR(i) (bf16x8){vlo[i][0],vlo[i][1],vlo[i][2],vlo[i][3],vhi[i][0],vhi[i][1],vhi[i][2],vhi[i][3]}
  #define PIN(x) asm volatile("":"+v"(x))
  #define MX3(a,b,c) __builtin_fmaxf(__builtin_fmaxf((a),(b)),(c))
  #define GAPA(MF,A0,A1,A2,A3,W0,W1,PW) do{ MF; sacc+=A0; sacc+=A1; sacc+=A2; sacc+=A3; PIN(sacc); W0; W1; PIN(PW); SBAR(); }while(0)
  #define EX(v) __builtin_amdgcn_exp2f(v)
  #define GAPB(MF,X,B) do{ MF; X[B]=EX(X[B]); X[B+1]=EX(X[B+1]); X[B+2]=EX(X[B+2]); X[B+3]=EX(X[B+3]); PIN(X); SBAR(); }while(0)
  #define VRD(i) do{ vlo[i]=vtr(vp_+(((i)>>2)*4096+((i)&3)*1024)); vhi[i]=vtr(vp_+(((i)>>2)*4096+((i)&3)*1024+512)); }while(0)
  #define KRD(G,j) do{ if(G){ kload2(kf,kp0+sl_next,j); SBAR(); } }while(0)
  #define H1MF(oi,k,i) do{ if constexpr(DV2==2){ o[oi]=__builtin_amdgcn_mfma_f32_32x32x16_bf16(PAF(k),VFR(i),o[oi],0,0,0); } }while(0)
  #define VRDH(i) do{ if constexpr(DV2==2){ vlo[i]=vtr(vp_+(8192+((i)>>2)*4096+((i)&3)*1024)); vhi[i]=vtr(vp_+(8192+((i)>>2)*4096+((i)&3)*1024+512)); } }while(0)
  #define STEP(C0,C1,P0,P1,t,GK,GV,GL) do{ SBAR(); \
    const lds_cptr vp_=vp0+sl_prev*VSL; \
    VRD(0); SBAR(); float sacc=(P0[0]+P0[1]); \
    GAPA(C0=__builtin_amdgcn_mfma_f32_32x32x16_bf16(kf[0],qr[0],zero16,0,0,0), P0[2],P0[3],P0[4],P0[5],     pw0[0]=PKW(P0,0), pw0[1]=PKW(P0,2), pw0); \
    VRD(4); SBAR(); GAPA(C1=__builtin_amdgcn_mfma_f32_32x32x16_bf16(kf[1],qr[0],zero16,0,0,0), P0[6],P0[7],P0[8],P0[9],     pw0[2]=PKW(P0,4), pw0[3]=PKW(P0,6), pw0); \
    VRD(1); SBAR(); GAPA(C0=__builtin_amdgcn_mfma_f32_32x32x16_bf16(kf[2],qr[1],C0,0,0,0),   P0[10],P0[11],P0[12],P0[13], pw1[0]=PKW(P0,8), pw1[1]=PKW(P0,10), pw1); \
    VRD(5); SBAR(); GAPA(C1=__builtin_amdgcn_mfma_f32_32x32x16_bf16(kf[3],qr[1],C1,0,0,0),   P0[14],P0[15],P1[0],P1[1],   pw1[2]=PKW(P0,12),pw1[3]=PKW(P0,14), pw1); \
    VRD(2); SBAR(); GAPA(C0=__builtin_amdgcn_mfma_f32_32x32x16_bf16(kf[4],qr[2],C0,0,0,0),   P1[2],P1[3],P1[4],P1[5],     pw2[0]=PKW(P1,0), pw2[1]=PKW(P1,2), pw2); \
    VRD(6); SBAR(); GAPA(C1=__builtin_amdgcn_mfma_f32_32x32x16_bf16(kf[5],qr[2],C1,0,0,0),   P1[6],P1[7],P1[8],P1[9],     pw2[2]=PKW(P1,4), pw2[3]=PKW(P1,6), pw2); \
    VRD(3); SBAR(); GAPA(C0=__builtin_amdgcn_mfma_f32_32x32x16_bf16(kf[6],qr[3],C0,0,0,0),   P1[10],P1[11],P1[12],P1[13], pw3[0]=PKW(P1,8), pw3[1]=PKW(P1,10), pw3); \
    VRD(7); SBAR(); GAPA(C1=__builtin_amdgcn_mfma_f32_32x32x16_bf16(kf[7],qr[3],C1,0,0,0),   P1[14],P1[15],0.f,0.f,       pw3[2]=PKW(P1,12),pw3[3]=PKW(P1,14), pw3); \
    l_reg+=sacc; \
    if(GK){DMA_K((t)+3,sl_cur);} if(GV){DMA_V((t)+1,sl_next);} \
    CMASK(C0,C1,t); \
    SBAR(); \
    GAPB(o[0]=__builtin_amdgcn_mfma_f32_32x32x16_bf16(PAF(0),VFR(0),o[0],0,0,0); VRDH(0), C0,0); \
    GAPB(o[1]=__builtin_amdgcn_mfma_f32_32x32x16_bf16(PAF(0),VFR(4),o[1],0,0,0); VRDH(4), C0,4); \
    KRD(GL,0); GAPB(o[0]=__builtin_amdgcn_mfma_f32_32x32x16_bf16(PAF(1),VFR(1),o[0],0,0,0); H1MF(2,0,0); VRDH(1), C0,8); \
    KRD(GL,1); GAPB(o[1]=__builtin_amdgcn_mfma_f32_32x32x16_bf16(PAF(1),VFR(5),o[1],0,0,0); H1MF(3,0,4); VRDH(5), C0,12); \
    KRD(GL,2); GAPB(o[0]=__builtin_amdgcn_mfma_f32_32x32x16_bf16(PAF(2),VFR(2),o[0],0,0,0); H1MF(2,1,1); VRDH(2), C1,0); \
    KRD(GL,3); GAPB(o[1]=__builtin_amdgcn_mfma_f32_32x32x16_bf16(PAF(2),VFR(6),o[1],0,0,0); H1MF(3,1,5); VRDH(6), C1,4); \
    GAPB(o[0]=__builtin_amdgcn_mfma_f32_32x32x16_bf16(PAF(3),VFR(3),o[0],0,0,0); H1MF(2,2,2); VRDH(3), C1,8); \
    GAPB(o[1]=__builtin_amdgcn_mfma_f32_32x32x16_bf16(PAF(3),VFR(7),o[1],0,0,0); H1MF(3,2,6); VRDH(7), C1,12); \
    if constexpr(DV2==2){ H1MF(2,3,3); H1MF(3,3,7); SBAR(); } \
    }while(0)
  int t=1;
  for(;t+5<NT;t+=2){
    STEP(pB0,pB1,pA0,pA1,t,true,true,true);     WAIT_K1V(); RESC(); ROT();
    STEP(pA0,pA1,pB0,pB1,t+1,true,true,true);   WAIT_K1V(); RESC(); ROT();
  }
  #define ENDW(tt) do{ if((tt)+3<NT){WAIT_K1V();} else if((tt)+2<NT){WAIT_V1();} else {WAIT_BAR(0);} }while(0)
  for(;t+1<NT;t+=2){
    STEP(pB0,pB1,pA0,pA1,t,(t+3<NT),(t+1<NT),(t+1<NT));       ENDW(t);   RESC(); ROT();
    STEP(pA0,pA1,pB0,pB1,t+1,(t+4<NT),(t+2<NT),(t+2<NT));     ENDW(t+1); RESC(); ROT();
  }
  STEP(pB0,pB1,pA0,pA1,NT-1,false,false,false); RESC();
  { float sacc=pB0[0]+pB0[1]; _Pragma("unroll") for(int r=2;r<16;++r)sacc+=pB0[r]; _Pragma("unroll") for(int r=0;r<16;++r)sacc+=pB1[r]; l_reg+=sacc;
    pw0=(u32x4){PKW(pB0,0),PKW(pB0,2),PKW(pB0,4),PKW(pB0,6)};pw1=(u32x4){PKW(pB0,8),PKW(pB0,10),PKW(pB0,12),PKW(pB0,14)};pw2=(u32x4){PKW(pB1,0),PKW(pB1,2),PKW(pB1,4),PKW(pB1,6)};pw3=(u32x4){PKW(pB1,8),PKW(pB1,10),PKW(pB1,12),PKW(pB1,14)};
    SBAR(); pv(o,vb0+sl_cur*VSL,PAF(0),PAF(1),PAF(2),PAF(3)); if constexpr(DV2==2) pv(o+2,vb0+sl_cur*VSL+8192,PAF(0),PAF(1),PAF(2),PAF(3)); }
  #undef PKW
  #undef PAF
  #undef VFR
  #undef PIN
  #undef MX3
  #undef GAPA
  #undef GAPB
  #undef EX
  #undef VRD
  #undef KRD
  #undef STEP
  #undef ENDW
  asm volatile("s_waitcnt lgkmcnt(0)\n\ts_barrier":::"memory");
  if(has_next){ const bf16*ksn=Khn+(long)lane*P+wid*8; const bf16*vsn=Vhn+(long)(16*(wid&3)+(lane>>2))*P+(wid>>2)*32+(lane&3)*8;
    glds16(ksn,(unsigned)__builtin_amdgcn_readfirstlane(kdst)); glds16(vsn,(unsigned)__builtin_amdgcn_readfirstlane(vdst));
    if constexpr(DV2==2) glds16(vsn+64,(unsigned)__builtin_amdgcn_readfirstlane(vdst+8192));
    glds16(ksn+(long)64*P,(unsigned)__builtin_amdgcn_readfirstlane(kdst+SLOTB)); glds16(ksn+(long)128*P,(unsigned)__builtin_amdgcn_readfirstlane(kdst+2*SLOTB)); }
  {auto rr=__builtin_amdgcn_permlane32_swap(__float_as_uint(l_reg),__float_as_uint(l_reg),false,false);l_reg=__uint_as_float(rr[0])+__uint_as_float(rr[1]);}
  if(hi==0)wsf[32+r32]=l_reg;asm volatile("s_waitcnt lgkmcnt(0)":::"memory");
  float rli[16];
  #pragma unroll
  for(int r=0;r<16;++r)rli[r]=__builtin_amdgcn_rcpf(wsf[32+crow(r,hi)]);
  bf16*Ow=O0+(long)(wid*QBLK)*OP;
  { bf16*stg=(bf16*)(shm+LOST_)+wid*2048;
    #pragma unroll
    for(int hh=0;hh<DV2;++hh){
      #pragma unroll
      for(int r=0;r<16;++r){const int orow=crow(r,hi);
        #pragma unroll
        for(int d0=0;d0<2;++d0)stg[orow*64+d0*32+r32]=__float2bfloat16(o[2*hh+d0][r]*rli[r]);}
      asm volatile("s_waitcnt lgkmcnt(0)":::"memory");
      #pragma unroll
      for(int i=0;i<4;++i){const int row=i*8+(lane>>3),ch=lane&7; const u32x4 v=*(const u32x4*)(stg+row*64+ch*8); ATTN_STORE16(Ow+(long)row*OP+hh*64+ch*8,v);}
      asm volatile("s_waitcnt lgkmcnt(0)":::"memory"); } }
  asm volatile("s_waitcnt lgkmcnt(0)\n\ts_barrier":::"memory");
  #undef DMA_K
  #undef DMA_V
  #undef CMASK
  #undef START
  #undef RESC
  #undef ROT
  #undef TROW
  #undef WAIT_K1V
  #undef WAIT_V1
  #undef VRDH
  #undef H1MF
}

#undef SBAR
#undef WAIT_BAR
}

constexpr int NWAVES = 8;
#ifndef DBGZ
#define DBGZ 0
#endif
#ifndef MK_PER_PHASE
#define MK_PER_PHASE 0
#endif

constexpr int NB = 8, TL = 8192, CL = 256, RPB = TL + CL  , MT = NB * RPB  , DM = 1024;
constexpr int N_IN0 = 2560, N_IN1 = 2304, N_WQ = 2048, OD_P = 1536;
constexpr float EPS = 1e-6f, LOG2E = 1.4426950408889634f, QSCALE = 0.125f * 1.4426950408889634f;
constexpr int PH_PER_LAYER = 10, N_PHASES = 1 + 2 * PH_PER_LAYER;

constexpr size_t MiB = 1u << 20;
constexpr size_t WS_CTL = 0, CTL_ZERO_BYTES = 1 * MiB;
constexpr size_t WS_MOD = 1 * MiB;
constexpr size_t WS_ROPE = 2 * MiB;
constexpr size_t WS_WIN0 = 3 * MiB, WS_WOUT0 = 8 * MiB, WS_WQ0 = 10 * MiB, WS_WIN1 = 14 * MiB, WS_WOUT1 = 19 * MiB, WS_WQ1 = 21 * MiB;
constexpr size_t WS_KEYS0 = 25 * MiB, WS_KEYS1 = 25 * MiB + 512 * 1024;
constexpr size_t WS_U0 = 32 * MiB, WS_U1 = 64 * MiB;
constexpr float U_SCALE = 64.f, V_SCALE = 4.f;
constexpr size_t WS_XS = 160 * MiB;
constexpr size_t WS_XN = 424 * MiB;
constexpr size_t WS_PB = 556 * MiB;
constexpr size_t WS_EI = WS_PB + 264 * MiB, WS_EG = WS_EI + 33 * MiB;
constexpr size_t WS_END = 886 * MiB;
static_assert((size_t)MT * 1024 * 4 == 264 * MiB && (size_t)MT * 2560 * 2 == 330 * MiB && (size_t)MT * 128 * 4 == 33 * MiB, "ws map");
constexpr int CW_TMO = 0, CW_BAR = 4096;

constexpr int RING_BYTES = 131072, LDSCTL_OFF = RING_BYTES, MISC_OFF = LDSCTL_OFF + 320, LDS_BYTES = 147456;

#define GAS __attribute__((address_space(1)))
#define LAS __attribute__((address_space(3)))
typedef unsigned short bf16;
typedef unsigned v4u __attribute__((ext_vector_type(4)));
typedef unsigned v2u __attribute__((ext_vector_type(2)));
typedef float f32x4 __attribute__((ext_vector_type(4)));
typedef float f32x16 __attribute__((ext_vector_type(16)));
typedef short bf16x8 __attribute__((ext_vector_type(8)));
typedef __bf16 bf16x2v __attribute__((ext_vector_type(2)));
typedef GAS unsigned gu32;
#define RLX_AGENT __ATOMIC_RELAXED, __HIP_MEMORY_SCOPE_AGENT
__device__ __forceinline__ unsigned f2bf(float f) { unsigned u = __builtin_bit_cast(unsigned, f); return (u + 0x7fffu + ((u >> 16) & 1u)) >> 16; }
__device__ __forceinline__ unsigned pk2(float lo, float hi) { return f2bf(lo) | (f2bf(hi) << 16); }
__device__ __forceinline__ float bflo(unsigned u) { return __builtin_bit_cast(float, u << 16); }
__device__ __forceinline__ float bfhi(unsigned u) { return __builtin_bit_cast(float, u & 0xffff0000u); }
__device__ __forceinline__ float bf1(bf16 h) { return __builtin_bit_cast(float, (unsigned)h << 16); }
__device__ __forceinline__ float wave_sum(float v) {
#pragma unroll
    for (int o = 1; o < 64; o <<= 1) v += __shfl_xor(v, o);
    return v;
}
__device__ __forceinline__ float dot2bf(unsigned w, unsigned x, float acc) { return __builtin_amdgcn_fdot2_f32_bf16(__builtin_bit_cast(bf16x2v, w), __builtin_bit_cast(bf16x2v, x), acc, false); }
__device__ __forceinline__ float fast_exp2(float x) { return __builtin_amdgcn_exp2f(x); }
__device__ __forceinline__ float gelu_erf(float v) {
    const float av = fabsf(v), t = __builtin_amdgcn_rcpf(av * 0.2316418882f + 1.0f);
    float q = t * 0.5307027145f + (-0.7265760135f); q = q * t + 0.7107068705f; q = q * t + (-0.142248368f); q = q * t + 0.127414796f; q = q * t;
    const float e = __builtin_amdgcn_exp2f((v * v) * (-0.72134752044f));
    const float m = v * (q * e);
    return v < 0.f ? m : v - m;
}

#define XB_TMO      128
#define XB_XCNT(j)  (256  + 64 * (j))
#define XB_XSUB(j)  (1280 + 64 * (j))
#define XB_XGEN(j)  (2304 + 64 * (j))
#define XB_TOP      3328
#define XB_TOPGEN   3392
#define XCD_BAR_WORDS 3456
#define XB_SPIN_CAP (1u << 18)

__device__ __forceinline__ unsigned xb_ld(unsigned* p)              { return __hip_atomic_load(p, __ATOMIC_RELAXED, __HIP_MEMORY_SCOPE_AGENT); }
__device__ __forceinline__ unsigned xb_add(unsigned* p, unsigned v) { return __hip_atomic_fetch_add(p, v, __ATOMIC_RELAXED, __HIP_MEMORY_SCOPE_AGENT); }
__device__ __forceinline__ unsigned xb_xcc_id() { return (unsigned)__builtin_amdgcn_s_getreg((3 << 11) | 20) & 0xFu; }
#define XB_SPIN(cond, bar) do { unsigned _sp = 0; while (cond) { __builtin_amdgcn_s_sleep(1); \
    if ((++_sp & 255u) == 0u) { if (xb_ld(&(bar)[XB_TMO])) break; if (_sp > XB_SPIN_CAP) { atomicAdd(&(bar)[XB_TMO], 1u); break; } } } } while (0)

struct XcdBarrier {
    unsigned* bar; unsigned x;
    volatile LAS unsigned* st;
};

__device__ __forceinline__ XcdBarrier xcd_barrier_post(unsigned* bar, volatile LAS unsigned* st) {
    XcdBarrier b; b.bar = bar; b.x = xb_xcc_id(); b.st = st;
    if (threadIdx.x == 0) (void)xb_add(&bar[XB_XCNT(b.x)], 1u);
    return b;
}
__device__ __forceinline__ void xcd_barrier_complete(unsigned* bar, unsigned x, unsigned& nloc, unsigned& nx) {
    const unsigned G = gridDim.x * gridDim.y * gridDim.z;
    unsigned sum, cnt, mine, sp = 0u;
    for (;;) {
        sum = 0u; cnt = 0u; mine = 0u;
#pragma unroll
        for (unsigned j = 0; j < 16; ++j) { const unsigned c = xb_ld(&bar[XB_XCNT(j)]); sum += c; cnt += (c > 0u) ? 1u : 0u; mine = (j == x) ? c : mine; }
        if (sum == G) break;
        __builtin_amdgcn_s_sleep(1);
        if ((++sp & 255u) == 0u) { if (xb_ld(&bar[XB_TMO])) break; if (sp > XB_SPIN_CAP) { atomicAdd(&bar[XB_TMO], 1u); break; } }
    }
    nloc = mine > 0u ? mine : 1u; nx = cnt > 0u ? cnt : 1u;
}

__device__ __forceinline__ void xcd_barrier(const XcdBarrier& b) {
    asm volatile("s_waitcnt vmcnt(0)" ::: "memory");
    __syncthreads();
    if (threadIdx.x == 0) {
        unsigned* bar = b.bar;
        __builtin_amdgcn_s_waitcnt(0);
        unsigned nloc = b.st[0], nx = b.st[1];
        if (nloc == 0u) { xcd_barrier_complete(bar, b.x, nloc, nx); b.st[0] = nloc; b.st[1] = nx; }
        const unsigned old = xb_add(&bar[XB_XSUB(b.x)], 1u);
        const unsigned gen = old / nloc;
        if (old + 1u == (gen + 1u) * nloc) {
            __builtin_amdgcn_fence(__ATOMIC_RELEASE, "agent");
            asm volatile("s_waitcnt vmcnt(0)" ::: "memory");
            const unsigned og = xb_add(&bar[XB_TOP], 1u);
            const unsigned tg = og / nx;
            if (og + 1u == (tg + 1u) * nx) xb_add(&bar[XB_TOPGEN], 1u);
            else XB_SPIN(xb_ld(&bar[XB_TOPGEN]) == tg, bar);
            __builtin_amdgcn_fence(__ATOMIC_ACQUIRE, "agent");
            xb_add(&bar[XB_XGEN(b.x)], 1u);
            asm volatile("s_waitcnt vmcnt(0)" ::: "memory");
        } else {
            XB_SPIN(xb_ld(&bar[XB_XGEN(b.x)]) == gen, bar);
            __builtin_amdgcn_fence(__ATOMIC_ACQUIRE, "agent");
            asm volatile("s_waitcnt vmcnt(0)" ::: "memory");
        }
    }
    __syncthreads();
}


struct Frame {
    LAS unsigned char* lds;
    gu32* ctl;
    int tid, lane, wave, vcu, G, gw, NGW;
};

struct Args { const float* in[38]; float* out; unsigned char* ws; int ph_lo, ph_hi, li, pad; };

__device__ __forceinline__ void p0_transpose_item(const float* W, int K, int N, bf16* WT, LAS float* scr, int item, int lane) {
    const int nblk = N / 32, kb = item / nblk, nb = item % nblk, k0 = 64 * kb, n0 = 32 * nb;
#pragma unroll 8
    for (int i = 0; i < 32; ++i) { const int kk = 2 * i + (lane >> 5); scr[kk * 33 + (lane & 31)] = W[(size_t)(k0 + kk) * N + n0 + (lane & 31)]; }
    asm volatile("s_waitcnt lgkmcnt(0)" ::: "memory");
    const int c = lane & 7;
#pragma unroll
    for (int j = 0; j < 4; ++j) { const int n = (lane >> 3) + 8 * j; const LAS float* s = scr + (8 * c) * 33 + n;
        v4u o; o.x = pk2(s[0 * 33], s[1 * 33]); o.y = pk2(s[2 * 33], s[3 * 33]); o.z = pk2(s[4 * 33], s[5 * 33]); o.w = pk2(s[6 * 33], s[7 * 33]);
        *(v4u*)(WT + (size_t)(n0 + n) * K + k0 + 8 * c) = o; }
    asm volatile("s_waitcnt lgkmcnt(0)" ::: "memory");
}
__device__ __forceinline__ void cvt_bf16_stream(const float* src, bf16* dst, size_t n, int gtid, int nthr) {
    for (size_t i = (size_t)gtid * 8; i < n; i += (size_t)nthr * 8) {
        const f32x4 a = *(const f32x4*)(src + i), b = *(const f32x4*)(src + i + 4);
        v4u o; o.x = pk2(a.x, a.y); o.y = pk2(a.z, a.w); o.z = pk2(b.x, b.y); o.w = pk2(b.z, b.w);
        *(v4u*)(dst + i) = o; }
}
__device__ __forceinline__ unsigned enc8_fp4(const float* p, float sc) {
    const f32x4 a = *(const f32x4*)p, b = *(const f32x4*)(p + 4);
    unsigned r = 0;
    r = __builtin_amdgcn_cvt_scalef32_pk_fp4_f32(r, a.x * sc, a.y * sc, 1.0f, 0); r = __builtin_amdgcn_cvt_scalef32_pk_fp4_f32(r, a.z * sc, a.w * sc, 1.0f, 1);
    r = __builtin_amdgcn_cvt_scalef32_pk_fp4_f32(r, b.x * sc, b.y * sc, 1.0f, 2); r = __builtin_amdgcn_cvt_scalef32_pk_fp4_f32(r, b.z * sc, b.w * sc, 1.0f, 3);
    return r; }
__device__ __forceinline__ void cvt_fp4_uv(const float* u, const float* v, unsigned char* dst, int gtid, int nthr) {
#pragma unroll 4
    for (size_t i = (size_t)gtid * 8; i < (size_t)16384 * 1024; i += (size_t)nthr * 8) {
        unsigned char* rowp = dst + (i >> 10) * 1024 + ((i & 1023) >> 1);
        *(unsigned*)rowp = enc8_fp4(u + i, U_SCALE); *(unsigned*)(rowp + 512) = enc8_fp4(v + i, V_SCALE); }
}
__device__ __forceinline__ void sincos_small(double x, double& s, double& c) {
    const double n = __builtin_rint(x * 0.63661977236758134308);
    double r = __builtin_fma(-n, 1.57079632679489655800e+00, x); r = __builtin_fma(-n, 6.12323399573676603587e-17, r);
    const int q = (int)n & 3; const double r2 = r * r;
    const double sp = r * (1.0 + r2 * (-1.0 / 6 + r2 * (1.0 / 120 + r2 * (-1.0 / 5040 + r2 * (1.0 / 362880 + r2 * (-1.0 / 39916800 + r2 * (1.0 / 6227020800.0)))))));
    const double cp = 1.0 + r2 * (-0.5 + r2 * (1.0 / 24 + r2 * (-1.0 / 720 + r2 * (1.0 / 40320 + r2 * (-1.0 / 3628800 + r2 * (1.0 / 479001600 + r2 * (-1.0 / 87178291200.0)))))));
    s = (q == 0) ? sp : (q == 1) ? cp : (q == 2) ? -sp : -cp;
    c = (q == 0) ? cp : (q == 1) ? -sp : (q == 2) ? -cp : sp;
}
__device__ __forceinline__ float inv_freq(int i) {
    const float t[16] = {1.0f, 0.5623413251903491f, 0.31622776601683794f, 0.17782794100389228f, 0.1f, 0.05623413251903491f, 0.031622776601683794f, 0.017782794100389228f,
                         0.01f, 0.005623413251903491f, 0.0031622776601683794f, 0.0017782794100389228f, 0.001f, 0.0005623413251903491f, 0.00031622776601683794f, 0.00017782794100389228f};
    float r = t[0];
#pragma unroll
    for (int k = 1; k < 16; ++k) r = (i == k) ? t[k] : r;
    return r;
}
__device__ __forceinline__ void p0_prologue(const Frame& F, const Args& A) {
    unsigned char* ws = A.ws;
    LAS float* sil = (LAS float*)F.lds;
    for (int i = F.tid; i < 9 * 1024; i += NWAVES * 64) { const int r = i >> 10, k = i & 1023; const float cv = r < 8 ? A.in[1][r * 1024 + k] : A.in[3][k]; sil[i] = cv / (1.0f + fast_exp2(-cv * LOG2E)); }
    __syncthreads();
    LAS float* part = (LAS float*)(F.lds + 110592);
    if (F.vcu < 192) {
        const int layer = F.vcu / 96, col = (F.vcu % 96) * 64 + F.lane;
        const float* W = A.in[layer ? 23 : 4];
        float acc[9];
#pragma unroll
        for (int r = 0; r < 9; ++r) acc[r] = 0.f;
#pragma unroll 1
        for (int k = F.wave * 128; k < F.wave * 128 + 128; k += 16) {
            const float* wk = W + (size_t)k * 6144;
            float w[16];
#pragma unroll
            for (int i = 0; i < 16; ++i) w[i] = wk[(unsigned)(col + i * 6144)];
#pragma unroll
            for (int i = 0; i < 16; i += 4) {
#pragma unroll
                for (int r = 0; r < 9; ++r) { const f32x4 s4 = *(const LAS f32x4*)(sil + r * 1024 + k + i); acc[r] += (s4.x * w[i] + s4.y * w[i + 1]) + (s4.z * w[i + 2] + s4.w * w[i + 3]); }
                __builtin_amdgcn_sched_barrier(0); }
        }
#pragma unroll
        for (int r = 0; r < 9; ++r) part[(F.wave * 9 + r) * 64 + F.lane] = acc[r];
    }
    __syncthreads();
    if (F.vcu < 192 && F.wave == 0) {
        const int layer = F.vcu / 96, col = (F.vcu % 96) * 64 + F.lane;
        const float* bb = A.in[layer ? 24 : 5];
        float* MOD = (float*)(ws + WS_MOD);
#pragma unroll
        for (int r = 0; r < 9; ++r) { float t = bb[col];
#pragma unroll
            for (int w = 0; w < 8; ++w) t += part[(w * 9 + r) * 64 + F.lane];
            MOD[(size_t)(layer * 9 + r) * 6144 + col] = t; }
    }
    { const int g = F.vcu * (NWAVES * 64) + F.tid;
      if (g < 2048) { const int pos = g >> 4, i = g & 15; const float ang = (float)pos * inv_freq(i); double s, c; sincos_small((double)ang, s, c);
          float* RT = (float*)(ws + WS_ROPE); RT[g] = (float)c; RT[2048 + g] = (float)s; } }
    { const int g = F.vcu * (NWAVES * 64) + F.tid;
      if (g < 512) { const int layer = g >> 8, j = (g >> 6) & 3, i = g & 63; const int src = layer ? 29 + j : (j == 0 ? 12 : 13);
          ((float*)(ws + WS_ROPE))[4096 + g] = (layer == 0 && j >= 2) ? 1.0f : A.in[src][i]; } }
    { LAS float* scr = (LAS float*)(F.lds + 40960 + F.wave * 8704);
      constexpr int I0 = 16 * (N_IN0 / 32), I1 = 16 * 32, I2 = 16 * (N_WQ / 32), I3 = 16 * (N_IN1 / 32);
      constexpr int NIT = I0 + I1 + I2 + I3 + I1 + I2;
      for (int it = F.gw; it < NIT; it += F.NGW) {
          int r = it;
          if (r < I0) { p0_transpose_item(A.in[8], 1024, N_IN0, (bf16*)(ws + WS_WIN0), scr, r, F.lane); continue; } r -= I0;
          if (r < I1) { p0_transpose_item(A.in[9], 1024, 1024, (bf16*)(ws + WS_WOUT0), scr, r, F.lane); continue; } r -= I1;
          if (r < I2) { p0_transpose_item(A.in[19], 1024, N_WQ, (bf16*)(ws + WS_WQ0), scr, r, F.lane); continue; } r -= I2;
          if (r < I3) { p0_transpose_item(A.in[27], 1024, N_IN1, (bf16*)(ws + WS_WIN1), scr, r, F.lane); continue; } r -= I3;
          if (r < I1) { p0_transpose_item(A.in[28], 1024, 1024, (bf16*)(ws + WS_WOUT1), scr, r, F.lane); continue; } r -= I1;
          p0_transpose_item(A.in[34], 1024, N_WQ, (bf16*)(ws + WS_WQ1), scr, r, F.lane);
      } }
    { const int gt = F.vcu * (NWAVES * 64) + F.tid, nt = F.G * NWAVES * 64;
      cvt_bf16_stream(A.in[20], (bf16*)(ws + WS_KEYS0), (size_t)8 * 2 * 128 * 128, gt, nt);
      cvt_bf16_stream(A.in[35], (bf16*)(ws + WS_KEYS1), (size_t)8 * 2 * 128 * 128, gt, nt);
      cvt_fp4_uv(A.in[21], A.in[22], ws + WS_U0, gt, nt);
      cvt_fp4_uv(A.in[36], A.in[37], ws + WS_U1, gt, nt); }
}

template <bool FROM_INPUT> __device__ __forceinline__ void norm_mod_phase(const Frame& F, const float* x, const float* ctx, const bf16* XS, const float* gain, const float* sh, const float* sc, bf16* dst, bool lat_only) {
    for (int row = F.gw; row < MT; row += F.NGW) {
        const int b = row / RPB, r = row - b * RPB; const bool cr = r < CL; if (lat_only && cr) continue;
        const int mr = cr ? 8 : b;
        const float* xr = cr ? ctx + ((size_t)b * CL + r) * DM : x + ((size_t)b * TL + (r - CL)) * DM;
        f32x4 v[4]; float s = 0.f;
#pragma unroll
        for (int j = 0; j < 4; ++j) {
            if (FROM_INPUT) v[j] = *(const f32x4*)(xr + 4 * F.lane + 256 * j);
            else { const v2u w = *(const v2u*)(XS + (size_t)row * DM + 4 * F.lane + 256 * j); v[j] = (f32x4){bflo(w.x), bfhi(w.x), bflo(w.y), bfhi(w.y)}; }
            s += (v[j].x * v[j].x + v[j].y * v[j].y) + (v[j].z * v[j].z + v[j].w * v[j].w); }
        const float rs = __builtin_amdgcn_rsqf(wave_sum(s) * (1.f / DM) + EPS);
#pragma unroll
        for (int j = 0; j < 4; ++j) { const int col = 4 * F.lane + 256 * j;
            const f32x4 g = *(const f32x4*)(gain + col), a = *(const f32x4*)(sc + (size_t)mr * 6144 + col), h = *(const f32x4*)(sh + (size_t)mr * 6144 + col);
            const f32x4 y = v[j] * rs * g * (a + 1.0f) + h;
            v2u o; o.x = pk2(y.x, y.y); o.y = pk2(y.z, y.w);
            *(v2u*)(dst + (size_t)row * DM + col) = o; }
    }
}

__device__ __forceinline__ void l0_headnorm_pool_phase(const Frame& F, const Args& A, bf16* PB, bf16* Y, const float* RT) {
    LAS float* wl = (LAS float*)F.lds;
    for (int i = F.tid; i < 4 * 64 * 64; i += NWAVES * 64) wl[i] = A.in[10][i];
    __syncthreads();
    const float* pscale = A.in[11];
    {
        const int l = F.lane, g = l >> 4, hw = 1 << g, d0 = 4 * (l & 15);
        LAS float* ps = (LAS float*)(F.lds + 65536) + F.wave * 256;
        const f32x4 sc4 = *(const f32x4*)(pscale + 4 * l);
        for (int row = F.gw; row < MT; row += F.NGW) {
            const int b = row / RPB, r = row - b * RPB; const bool lat = r >= CL;
            const int pos = lat ? r - CL : r, L = lat ? TL : CL; const size_t segbase = (size_t)b * RPB + (lat ? CL : 0);
            v2u raw[16];
#pragma unroll
            for (int k = 0; k < 16; ++k) { const int p = pos + k - 8; const int pc = min(max(p, 0), L - 1); raw[k] = *(const v2u*)(PB + (segbase + pc) * N_IN0 + 4 * l); }
            f32x4 sum = {0.f, 0.f, 0.f, 0.f};
#pragma unroll
            for (int k = 0; k < 16; ++k) { const int dp = k - 8, p = pos + dp; const bool use = dp >= -hw && dp < hw && p >= 0 && p < L;
                const f32x4 v = {bflo(raw[k].x), bfhi(raw[k].x), bflo(raw[k].y), bfhi(raw[k].y)}; sum = use ? sum + v : sum; }
            const f32x4 self = {bflo(raw[8].x), bfhi(raw[8].x), bflo(raw[8].y), bfhi(raw[8].y)};
            const float rc = 1.0f / (float)(min(pos + hw, L) - max(pos - hw, 0));
            const f32x4 pv = sum * rc - self;
            *(LAS f32x4*)(ps + 4 * l) = pv;
            f32x4 y = {0.f, 0.f, 0.f, 0.f};
#pragma unroll 4
            for (int c = 0; c < 64; c += 4) { const f32x4 p4 = *(const LAS f32x4*)(ps + g * 64 + c);
                const LAS float* wp = wl + (g * 64 + c) * 64 + d0;
                y += p4.x * *(const LAS f32x4*)(wp) + p4.y * *(const LAS f32x4*)(wp + 64) + p4.z * *(const LAS f32x4*)(wp + 128) + p4.w * *(const LAS f32x4*)(wp + 192); }
            y = y * sc4;
            v2u o; o.x = pk2(y.x, y.y); o.y = pk2(y.z, y.w);
            if (DBGZ & 1) { o.x = 0u; o.y = 0u; }
            *(v2u*)(Y + (size_t)row * DM + 4 * l) = o;
        }
    }
    __syncthreads();
}

__device__ __forceinline__ void l0_diff_combine_phase(const Frame& F, const Args& A, const bf16* OD, bf16* Y) {
    const float s1 = wave_sum(A.in[14][F.lane] * A.in[15][F.lane]), s2 = wave_sum(A.in[16][F.lane] * A.in[17][F.lane]);
    const float lam = fast_exp2(s1 * LOG2E) - fast_exp2(s2 * LOG2E) + 0.2f;
    const int l32 = F.lane & 31;
    const f32x4 sub = *(const f32x4*)(A.in[18] + 4 * l32);
    for (int row = F.gw; row < MT; row += F.NGW) {
#pragma unroll
        for (int pass = 0; pass < 3; ++pass) { const int h = pass * 2 + (F.lane >> 5);
            const v2u a = *(const v2u*)(OD + (size_t)row * OD_P + (2 * h) * 128 + 4 * l32), c = *(const v2u*)(OD + (size_t)row * OD_P + (2 * h + 1) * 128 + 4 * l32);
            f32x4 o; o.x = bflo(a.x) - lam * bflo(c.x); o.y = bfhi(a.x) - lam * bfhi(c.x); o.z = bflo(a.y) - lam * bflo(c.y); o.w = bfhi(a.y) - lam * bfhi(c.y);
            float ss = (o.x * o.x + o.y * o.y) + (o.z * o.z + o.w * o.w);
            ss += __shfl_xor(ss, 1); ss += __shfl_xor(ss, 2); ss += __shfl_xor(ss, 4); ss += __shfl_xor(ss, 8); ss += __shfl_xor(ss, 16);
            const float rs = __builtin_amdgcn_rsqf(ss * (1.f / 128) + EPS) * 0.8f;
            v2u w; w.x = pk2(o.x * rs * sub.x, o.y * rs * sub.y); w.y = pk2(o.z * rs * sub.z, o.w * rs * sub.w);
            if (DBGZ & 2) { w.x = 0u; w.y = 0u; }
            *(v2u*)(Y + (size_t)row * DM + 256 + h * 128 + 4 * l32) = w; }
    }
}

constexpr int NCAND = 50;
__device__ __forceinline__ void ce_desc(float& a, float& b) {
    float hi_, lo_; asm("v_max_f32 %0, %2, %3\n\tv_min_f32 %1, %2, %3" : "=&v"(hi_), "=&v"(lo_) : "v"(a), "v"(b)); a = hi_; b = lo_; }
__device__ __forceinline__ float fmax_raw(float a, float b) { float r; asm("v_max_f32 %0, %1, %2" : "=v"(r) : "v"(a), "v"(b)); return r; }
template <int N, int OFF, int NTOT> __device__ __forceinline__ void bitonic_sort_desc(float (&v)[NTOT]) {
#pragma unroll
    for (int k = 2; k <= N; k <<= 1)
#pragma unroll
        for (int j = k >> 1; j > 0; j >>= 1)
#pragma unroll
            for (int i = 0; i < N; ++i) { const int l = i ^ j; if (l > i) { if ((i & k) == 0) ce_desc(v[OFF + i], v[OFF + l]); else ce_desc(v[OFF + l], v[OFF + i]); } }
}
template <int OFF, int NTOT> __device__ __forceinline__ void bitonic_merge16_desc(float (&v)[NTOT]) {
#pragma unroll
    for (int j = 8; j > 0; j >>= 1)
#pragma unroll
        for (int i = 0; i < 16; ++i) { const int l = i ^ j; if (l > i) ce_desc(v[OFF + i], v[OFF + l]); }
}
template <int A, int B, int NTOT> __device__ __forceinline__ void top16_merge(float (&v)[NTOT]) {
#pragma unroll
    for (int i = 0; i < 16; ++i) v[A + i] = fmax_raw(v[A + i], v[B + 15 - i]);
    bitonic_merge16_desc<A, NTOT>(v);
}
__device__ __forceinline__ void partner_top16(float (&t)[16], bool hi) {
    float a[16];
#pragma unroll
    for (int i = 0; i < 16; ++i) a[i] = hi ? t[15 - i] : t[i];
#pragma unroll
    for (int i = 0; i < 16; ++i) { const auto rr = __builtin_amdgcn_permlane32_swap(__builtin_bit_cast(unsigned, a[i]), __builtin_bit_cast(unsigned, a[i]), false, false);
        const unsigned r0_ = rr[0], r1_ = rr[1];
        t[i] = fmax_raw(__builtin_bit_cast(float, r0_), __builtin_bit_cast(float, r1_)); }
    bitonic_merge16_desc<0, 16>(t);
}
template <bool KL> __device__ __forceinline__ void topk_task(const Frame& F, const bf16* QP, const bf16* KEYS, const LAS unsigned char* klds, LAS unsigned short* kt, int* EI, float* EG, const int R0, const int h) {
    const int tk = F.lane & 31, hi = F.lane >> 5;
    const float neg_inf = -INFINITY;
    {
        float sv[2][16];
        unsigned koff = (unsigned)(tk * 128 + hi * 8), qoff = (unsigned)(tk * N_WQ + hi * 8);
        asm volatile("" : "+v"(koff), "+v"(qoff));
        const bf16* qp0 = QP + (size_t)R0 * N_WQ + (2 * h) * 128 + qoff;
        const bf16* kp0 = KEYS + ((size_t)(h * 2) * 128) * 128 + koff;
        const LAS unsigned char* kl0 = klds + tk * 272 + hi * 16;
        bf16x8 qf[8], kf[2][8];
#pragma unroll
        for (int ks = 0; ks < 8; ++ks) qf[ks] = *(const bf16x8*)(qp0 + ks * 16);
#pragma unroll
        for (int ks = 0; ks < 8; ++ks) kf[0][ks] = KL ? *(const LAS bf16x8*)(kl0 + ks * 32) : *(const bf16x8*)(kp0 + ks * 16);
        float v[64];
#pragma unroll
        for (int st = 0; st < 8; ++st) { const int p = st >> 2, kb = st & 3;
            if (st < 7) {
#pragma unroll
                for (int ks = 0; ks < 8; ++ks) kf[(st + 1) & 1][ks] = KL ? *(const LAS bf16x8*)(kl0 + (st + 1) * 32 * 272 + ks * 32) : *(const bf16x8*)(kp0 + (size_t)(st + 1) * 32 * 128 + ks * 16); }
            if (!KL) asm volatile("" ::: "memory");
            f32x16 acc = {};
#pragma unroll
            for (int ks = 0; ks < 8; ++ks) acc = __builtin_amdgcn_mfma_f32_32x32x16_bf16(kf[st & 1][ks], qf[ks], acc, 0, 0, 0);
#pragma unroll
            for (int rg = 0; rg < 16; ++rg) { const unsigned key = (unsigned)(kb * 32 + (rg & 3) + 8 * (rg >> 2)) + 4u * (unsigned)hi;
                const float av = acc[rg];
                v[kb * 16 + rg] = __builtin_bit_cast(float, (__builtin_bit_cast(unsigned, av) & ~127u) | key); }
            if (st == 3) {
#pragma unroll
                for (int ks = 0; ks < 8; ++ks) qf[ks] = *(const bf16x8*)(qp0 + 128 + ks * 16); }
            __builtin_amdgcn_sched_barrier(0);
            if (kb == 0) bitonic_sort_desc<16, 0, 64>(v); else if (kb == 1) bitonic_sort_desc<16, 16, 64>(v); else if (kb == 2) bitonic_sort_desc<16, 32, 64>(v); else bitonic_sort_desc<16, 48, 64>(v);
            if (kb == 3) {
                top16_merge<0, 16, 64>(v); top16_merge<32, 48, 64>(v); top16_merge<0, 32, 64>(v);
                float t[16];
#pragma unroll
                for (int i = 0; i < 16; ++i) t[i] = v[i];
                partner_top16(t, hi != 0);
#pragma unroll
                for (int i = 0; i < 16; ++i) sv[p][i] = t[i];
                __builtin_amdgcn_sched_barrier(0);
            }
        }
        float cv[32];
        {
            int n = 0;
#pragma unroll
            for (int i = 0; i < 16; ++i)
#pragma unroll
                for (int j = 0; j < 16; ++j) if ((i + 1) * (j + 1) <= 16) {
                    const float sum = sv[0][i] + sv[1][j];
                    const float c = __builtin_bit_cast(float, (__builtin_bit_cast(unsigned, sum) & ~255u) | (unsigned)(i * 16 + j));
                    if (n < 25) cv[n] = c; else cv[n - 25] = hi ? c : cv[n - 25];
                    ++n; }
#pragma unroll
            for (int k = 25; k < 32; ++k) cv[k] = neg_inf;
        }
#pragma unroll
        for (int p = 0; p < 2; ++p)
#pragma unroll
            for (int i = 0; i < 16; ++i) kt[(p * 16 + i) * 64 + F.lane] = (unsigned short)(__builtin_bit_cast(unsigned, sv[p][i]) & 127u);
        bitonic_sort_desc<16, 0, 32>(cv); bitonic_sort_desc<16, 16, 32>(cv); top16_merge<0, 16, 32>(cv);
        float tv[16]; int te[16];
#pragma unroll
        for (int i = 0; i < 16; ++i) tv[i] = cv[i];
        partner_top16(tv, hi != 0);
#pragma unroll
        for (int rd = 0; rd < 16; ++rd) { const unsigned id = __builtin_bit_cast(unsigned, tv[rd]) & 255u;
            te[rd] = (int)kt[(id >> 4) * 64 + F.lane] * 128 + (int)kt[(16 + (id & 15u)) * 64 + F.lane]; }
        float den = 0.f; const float tmax = tv[0];
#pragma unroll
        for (int rd = 0; rd < 16; ++rd) { tv[rd] = fast_exp2((tv[rd] - tmax) * LOG2E); den += tv[rd]; }
        const float rden = 1.0f / den;
        const size_t off = (size_t)(R0 + tk) * 128 + h * 16;
        if (hi == 0) {
#pragma unroll
            for (int q = 0; q < 4; ++q) { v4u o; o.x = (unsigned)te[4 * q]; o.y = (unsigned)te[4 * q + 1]; o.z = (unsigned)te[4 * q + 2]; o.w = (unsigned)te[4 * q + 3]; *(v4u*)(EI + off + 4 * q) = o; }
        } else {
#pragma unroll
            for (int q = 0; q < 4; ++q) { f32x4 o; o.x = tv[4 * q] * rden; o.y = tv[4 * q + 1] * rden; o.z = tv[4 * q + 2] * rden; o.w = tv[4 * q + 3] * rden; *(f32x4*)(EG + off + 4 * q) = o; }
        }
    }
}
__device__ __forceinline__ void peer_topk_phase(const Frame& F, const bf16* QP, const bf16* KEYS, int* EI, float* EG, bool lat_only) {
    LAS unsigned char* klds = F.lds;
    LAS unsigned short* kt = (LAS unsigned short*)(F.lds + 69632) + F.wave * 2048;
    for (int h = 0; h < 8; ++h) {
        __syncthreads();
#pragma unroll
        for (int i = 0; i < 8; ++i) { const int ch = F.tid + i * 512, row = ch >> 4, c16 = ch & 15;
            *(LAS v4u*)(klds + row * 272 + c16 * 16) = *(const v4u*)(KEYS + ((size_t)(h * 2) * 128 + row) * 128 + c16 * 8); }
        __syncthreads();
        for (int tgl = F.gw; tgl < NB * (TL / 32); tgl += F.NGW) { const int b = tgl >> 8, j = tgl & 255;
            topk_task<true>(F, QP, KEYS, klds, kt, EI, EG, b * RPB + CL + j * 32, h); }
    }
    __syncthreads();
    if (!lat_only) {
        for (int task = F.gw; task < NB * (CL / 32) * 8; task += F.NGW) { const int tgc = task >> 3, h = task & 7, b = tgc >> 3, j = tgc & 7;
            topk_task<false>(F, QP, KEYS, klds, kt, EI, EG, b * RPB + j * 32, h); }
    }
}

typedef float f32x2v __attribute__((ext_vector_type(2)));
typedef int v8i __attribute__((ext_vector_type(8)));
typedef int v2i_t __attribute__((ext_vector_type(2)));
template <int IMM> __device__ __forceinline__ void glds16_s(const unsigned char* sbase, unsigned voff, unsigned lds_dst) { unsigned keep;
    asm volatile("s_mov_b32 %0, m0\n\ts_mov_b32 m0, %3\n\ts_nop 0\n\tglobal_load_lds_dwordx4 %1, %2 offset:%4\n\ts_mov_b32 m0, %0" : "=&s"(keep) : "v"(voff), "s"(sbase), "s"(lds_dst), "n"(IMM) : "memory"); }
__device__ __forceinline__ v2i_t tr4(const LAS unsigned char* p) { return __builtin_amdgcn_ds_read_tr4_b64_v2i32((LAS v2i_t*)p); }
constexpr int G6_WF = 133120, G6_CF = 137216, G6_HB = 139264;
#define PG6_WAITV(n) do { if (GP == 6) asm volatile("s_waitcnt vmcnt(40)" ::: "memory"); else asm volatile("s_waitcnt vmcnt(" #n ")" ::: "memory"); } while (0)
#define PG6_WAITL() asm volatile("s_waitcnt lgkmcnt(0)" ::: "memory")
#define PG7_DMAU(VO, bt, slot) do { if (GP == 2 || GP == 3) break; _Pragma("unroll") for (int k_ = 0; k_ < 8; ++k_) glds16_s<0>(T + 64 * k_, VO[bt], (unsigned)__builtin_amdgcn_readfirstlane(vsm0 + (slot) * 8192 + k_ * 1024)); } while (0)
#define PG7_UREAD(slot) do { if (GP == 5 || GP == 6 || GP == 7 || GP == 8) break; _Pragma("unroll") for (int s_ = 0; s_ < 8; ++s_) ur[s_] = *(const LAS v4u*)(vsl + ua + ((slot) * 8192 + 1024 * s_)); } while (0)
#define PG7_UMFMA(bt) do { if (GP == 5 || GP == 6 || GP == 7 || GP == 8) break; f32x4 d_ = {0.f, 0.f, 0.f, 0.f}; \
    _Pragma("unroll") for (int s_ = 0; s_ < 8; ++s_) { v8i a_; a_[0] = (int)ur[s_].x; a_[1] = (int)ur[s_].y; a_[2] = (int)ur[s_].z; a_[3] = (int)ur[s_].w; a_[4] = 0; a_[5] = 0; a_[6] = 0; a_[7] = 0; \
        d_ = __builtin_amdgcn_mfma_scale_f32_16x16x128_f8f6f4(a_, bh[s_], d_, 4, 0, 0, 0, 0, 0); } \
    if (l15 == 0) *(LAS f32x4*)(wf + 4 * (16 * (bt) + 4 * q4)) = d_; } while (0)
#define PG7_DMAV2(c, h) do { if (GP == 1 || GP == 3 || GP == 8) break; _Pragma("unroll") for (int k_ = 0; k_ < 8; ++k_) \
    glds16_s<0>(T + 512 + 128 * (c) + 64 * (k_ & 1), voff[(k_ >> 1) + 4 * (h)], (unsigned)__builtin_amdgcn_readfirstlane(vsm0 + (h) * 8192 + k_ * 1024)); } while (0)
#define PG7_VREAD2() do { if (GP >= 5) break; _Pragma("unroll") for (int cg_ = 0; cg_ < 16; ++cg_) { const LAS unsigned char* ap_ = vsl + trp2[(cg_ >> 1) & 3] + (1024 * (cg_ >> 3) + 8 * (cg_ & 1)); vb0[cg_] = tr4(ap_); vb1[cg_] = tr4(ap_ + 2048); } } while (0)
#define PG7_SEL2(D, c, cg) do { const bool m_ = l15 == (cg); _Pragma("unroll") for (int i_ = 0; i_ < 4; ++i_) R[c][i_] = m_ ? D[i_] : R[c][i_]; \
    asm volatile("" : "+v"(R[c][0]), "+v"(R[c][1]), "+v"(R[c][2]), "+v"(R[c][3])); } while (0)
#define PG7_VMFMA2(c) do { if (GP >= 5) break; _Pragma("unroll") for (int cg_ = 0; cg_ < 16; ++cg_) { v8i a_; a_[0] = vb0[cg_].x; a_[1] = vb0[cg_].y; a_[2] = vb1[cg_].x; a_[3] = vb1[cg_].y; a_[4] = 0; a_[5] = 0; a_[6] = 0; a_[7] = 0; \
        f32x4 d_ = {0.f, 0.f, 0.f, 0.f}; \
        d_ = __builtin_amdgcn_mfma_scale_f32_16x16x128_f8f6f4(a_, bhi, d_, 4, 0, 0, 0, 0, 0); d_ = __builtin_amdgcn_mfma_scale_f32_16x16x128_f8f6f4(a_, blo, d_, 4, 0, 0, 0, 0, 0); \
        PG7_SEL2(d_, c, cg_); } } while (0)
#define PG7_VCHUNK(c, ISSUE) do { PG7_VREAD2(); PG6_WAITL(); ISSUE; __builtin_amdgcn_sched_barrier(0); PG7_VMFMA2(c); } while (0)
#define PG7_USTEP(bt, slot, ISSUE) do { PG7_UREAD(slot); PG6_WAITL(); ISSUE; __builtin_amdgcn_sched_barrier(0); PG7_UMFMA(bt); } while (0)
#define PG7_VOFF(VO, EL, EH) do { _Pragma("unroll") for (int k_ = 0; k_ < 8; ++k_) VO[k_] = (unsigned)__shfl(k_ < 4 ? EL : EH, ((16 * k_) & 63) + (lane >> 2)) * 1024u + vlane; } while (0)
#define PG7_H8(HA, HC, O) do { int p_; \
    p_ = __builtin_amdgcn_cvt_pk_fp8_f32(bflo(HA.x), bfhi(HA.x), 0, false); p_ = __builtin_amdgcn_cvt_pk_fp8_f32(bflo(HA.y), bfhi(HA.y), p_, true); O.x = (unsigned)p_; \
    p_ = __builtin_amdgcn_cvt_pk_fp8_f32(bflo(HA.z), bfhi(HA.z), 0, false); p_ = __builtin_amdgcn_cvt_pk_fp8_f32(bflo(HA.w), bfhi(HA.w), p_, true); O.y = (unsigned)p_; \
    p_ = __builtin_amdgcn_cvt_pk_fp8_f32(bflo(HC.x), bfhi(HC.x), 0, false); p_ = __builtin_amdgcn_cvt_pk_fp8_f32(bflo(HC.y), bfhi(HC.y), p_, true); O.z = (unsigned)p_; \
    p_ = __builtin_amdgcn_cvt_pk_fp8_f32(bflo(HC.z), bfhi(HC.z), 0, false); p_ = __builtin_amdgcn_cvt_pk_fp8_f32(bflo(HC.w), bfhi(HC.w), p_, true); O.w = (unsigned)p_; } while (0)
template <bool FINAL, int GP = 0> __device__ __forceinline__ void peer_gather7_phase(const Frame& F, const bf16* HN, const unsigned char* T, const int* EI, const float* EG, const float* g2, bf16* XS, float* out, bool lat_only, const float* gain_n, const float* mod_n, bf16* XNn) {
    const int lane = F.lane, l15 = lane & 15, q4 = lane >> 4, half = lane >> 5, c32 = lane & 31;
    LAS unsigned char* hb = F.lds + G6_HB + F.wave * 1024;
    LAS unsigned char* wf = F.lds + G6_WF + F.wave * 512;
    LAS unsigned char* cf = F.lds + G6_CF + F.wave * 256;
    const LAS unsigned char* vsl = F.lds + F.wave * 16384;
    const unsigned vsm0 = (unsigned)(uintptr_t)F.lds + (unsigned)F.wave * 16384u;
    unsigned trp[4];
#pragma unroll
    for (int p = 0; p < 4; ++p) trp[p] = 2048u * q4 + 64u * l15 + 16u * ((p + (l15 >> 2)) & 3);
    unsigned trp2[4];
#pragma unroll
    for (int p = 0; p < 4; ++p) trp2[p] = 4096u * q4 + 64u * l15 + 16u * ((p + (l15 >> 2)) & 3);
    const unsigned ua = 64u * l15 + 16u * ((q4 + (l15 >> 2)) & 3);
    const unsigned hoff = (unsigned)(32 * c32 + 16 * half);
    const unsigned coff = (unsigned)(16 * l15 + 4 * q4);
    const unsigned vlane = 16u * (unsigned)(((lane & 3) - (lane >> 4)) & 3);
    const int NV = lat_only ? NB * TL : MT;
    int it = F.gw; if (it >= NV) return;
    int row = lat_only ? (it >> 13) * RPB + CL + (it & 8191) : it;
    int e_lo = EI[(size_t)row * 128 + lane], e_hi = EI[(size_t)row * 128 + 64 + lane];
    float g_lo = EG[(size_t)row * 128 + lane], g_hi = EG[(size_t)row * 128 + 64 + lane];
    unsigned voff[8];
    PG7_VOFF(voff, e_lo, e_hi);
    { const v4u ha = *(const v4u*)(HN + (size_t)row * DM + hoff), hc = *(const v4u*)(HN + (size_t)row * DM + hoff + 8); v4u o; PG7_H8(ha, hc, o); *(LAS v4u*)(hb + hoff) = o; }
    v2u xa[4]; f32x4 gv[4];
    { const int b0 = row / RPB, r0 = row - b0 * RPB; const int mr0 = r0 < CL ? 8 : b0;
      const float* gp = g2 + (size_t)mr0 * 6144 + coff; const bf16* xr = XS + (size_t)row * DM + coff;
#pragma unroll
      for (int ch = 0; ch < 4; ++ch) { xa[ch] = *(const v2u*)(xr + 256 * ch); gv[ch] = *(const f32x4*)(gp + 256 * ch); } }
    PG7_DMAU(voff, 0, 0); PG7_DMAU(voff, 1, 1);
    bool first = true;
    for (;;) {
        const int itn = it + F.NGW; const bool hn = itn < NV; const int rown = hn ? (lat_only ? (itn >> 13) * RPB + CL + (itn & 8191) : itn) : row;
        const int b = row / RPB, r = row - b * RPB; const bool cr = r < CL;
        const int mr = cr ? 8 : b;
        v8i bh[8];
#pragma unroll
        for (int s_ = 0; s_ < 8; ++s_) { const v4u b0 = *(const LAS v4u*)(hb + 128 * s_ + 16 * q4), b1 = *(const LAS v4u*)(hb + 128 * s_ + 64 + 16 * q4);
            bh[s_][0] = (int)b0.x; bh[s_][1] = (int)b0.y; bh[s_][2] = (int)b0.z; bh[s_][3] = (int)b0.w; bh[s_][4] = (int)b1.x; bh[s_][5] = (int)b1.y; bh[s_][6] = (int)b1.z; bh[s_][7] = (int)b1.w; }
        asm volatile("" : "+v"(bh[0]), "+v"(bh[1]), "+v"(bh[2]), "+v"(bh[3]), "+v"(bh[4]), "+v"(bh[5]), "+v"(bh[6]), "+v"(bh[7]));
        if (first) { PG6_WAITV(8); } else { PG6_WAITV(12); }
        v4u ur[8];
        PG7_USTEP(0, 0, PG7_DMAU(voff, 2, 0)); if (first) { PG6_WAITV(8); } else { PG6_WAITV(12); }
        first = false;
        PG7_USTEP(1, 1, PG7_DMAU(voff, 3, 1)); PG6_WAITV(8);
        PG7_USTEP(2, 0, PG7_DMAU(voff, 4, 0)); PG6_WAITV(8);
        PG7_USTEP(3, 1, PG7_DMAU(voff, 5, 1)); PG6_WAITV(8);
        PG7_USTEP(4, 0, PG7_DMAU(voff, 6, 0)); PG6_WAITV(8);
        PG7_USTEP(5, 1, PG7_DMAU(voff, 7, 1)); PG6_WAITV(8);
        int e_lo_n = __builtin_nontemporal_load(EI + (size_t)rown * 128 + lane), e_hi_n = __builtin_nontemporal_load(EI + (size_t)rown * 128 + 64 + lane);
        float g_lo_n = __builtin_nontemporal_load(EG + (size_t)rown * 128 + lane), g_hi_n = __builtin_nontemporal_load(EG + (size_t)rown * 128 + 64 + lane);
        v4u hna = __builtin_nontemporal_load((const v4u*)(HN + (size_t)rown * DM + hoff)), hnc = __builtin_nontemporal_load((const v4u*)(HN + (size_t)rown * DM + hoff + 8));
        v2u xan[4]; f32x4 gvn[4];
        { const int bn = rown / RPB, rn = rown - bn * RPB; const int mrn = rn < CL ? 8 : bn;
          const float* gp = g2 + (size_t)mrn * 6144 + coff; const bf16* xr = XS + (size_t)rown * DM + coff;
#pragma unroll
          for (int ch = 0; ch < 4; ++ch) { xan[ch] = __builtin_nontemporal_load((const v2u*)(xr + 256 * ch)); gvn[ch] = *(const f32x4*)(gp + 256 * ch); } }
        PG7_USTEP(6, 0, PG7_DMAV2(0, 0)); PG6_WAITV(8);
        PG7_USTEP(7, 1, PG7_DMAV2(0, 1)); PG6_WAITV(0);
        asm volatile("" : "+v"(e_lo_n), "+v"(e_hi_n), "+v"(g_lo_n), "+v"(g_hi_n), "+v"(hna), "+v"(hnc));
        asm volatile("" : "+v"(xan[0]), "+v"(xan[1]), "+v"(xan[2]), "+v"(xan[3]), "+v"(gvn[0]), "+v"(gvn[1]), "+v"(gvn[2]), "+v"(gvn[3]));
        { v4u o; PG7_H8(hna, hnc, o); *(LAS v4u*)(hb + hoff) = o; }
        unsigned voffn[8];
        PG7_VOFF(voffn, e_lo_n, e_hi_n);
        f32x2v w2; w2.x = gelu_erf(*(const LAS float*)(wf + 4 * lane) * (1.0f / U_SCALE)) * g_lo; w2.y = gelu_erf(*(const LAS float*)(wf + 256 + 4 * lane) * (1.0f / U_SCALE)) * g_hi;
        float mx = __builtin_fmaxf(__builtin_fabsf(w2.x), __builtin_fabsf(w2.y));
#pragma unroll
        for (int o = 1; o < 64; o <<= 1) mx = __builtin_fmaxf(mx, __shfl_xor(mx, o));
        const float csc = 384.0f / __builtin_fmaxf(mx, 1e-30f);
        { const float s0 = w2.x * csc, s1 = w2.y * csc;
          const int hi8 = __builtin_amdgcn_cvt_pk_fp8_f32(s0, s1, 0, false); const f32x2v hf = __builtin_amdgcn_cvt_pk_f32_fp8(hi8, false);
          const int lo8 = __builtin_amdgcn_cvt_pk_fp8_f32(s0 - hf.x, s1 - hf.y, 0, false);
          cf[lane] = (unsigned char)(hi8 & 0xff); cf[64 + lane] = (unsigned char)((hi8 >> 8) & 0xff); cf[128 + lane] = (unsigned char)(lo8 & 0xff); cf[192 + lane] = (unsigned char)((lo8 >> 8) & 0xff); }
        v8i bhi, blo;
        { const v4u h0 = *(const LAS v4u*)(cf + 16 * q4), h1 = *(const LAS v4u*)(cf + 64 + 16 * q4), l0 = *(const LAS v4u*)(cf + 128 + 16 * q4), l1 = *(const LAS v4u*)(cf + 192 + 16 * q4);
          bhi[0] = (int)h0.x; bhi[1] = (int)h0.y; bhi[2] = (int)h0.z; bhi[3] = (int)h0.w; bhi[4] = (int)h1.x; bhi[5] = (int)h1.y; bhi[6] = (int)h1.z; bhi[7] = (int)h1.w;
          blo[0] = (int)l0.x; blo[1] = (int)l0.y; blo[2] = (int)l0.z; blo[3] = (int)l0.w; blo[4] = (int)l1.x; blo[5] = (int)l1.y; blo[6] = (int)l1.z; blo[7] = (int)l1.w; }
        float R[4][4];
#pragma unroll
        for (int i = 0; i < 4; ++i) { R[i][0] = 0.f; R[i][1] = 0.f; R[i][2] = 0.f; R[i][3] = 0.f; }
        v2i_t vb0[16], vb1[16];
        PG7_VCHUNK(0, PG7_DMAV2(1, 0); PG7_DMAV2(1, 1)); PG6_WAITV(0);
        PG7_VCHUNK(1, PG7_DMAV2(2, 0); PG7_DMAV2(2, 1)); PG6_WAITV(0);
        PG7_VCHUNK(2, PG7_DMAV2(3, 0); PG7_DMAV2(3, 1)); PG6_WAITV(0);
        PG7_VCHUNK(3, if (hn) { PG7_DMAU(voffn, 0, 0); PG7_DMAU(voffn, 1, 1); });
        const float osc = 1.0f / (V_SCALE * csc);
        float xn[16];
#pragma unroll
        for (int ch = 0; ch < 4; ++ch) {
            xn[4 * ch] = bflo(xa[ch].x) + gv[ch].x * (R[ch][0] * osc); xn[4 * ch + 1] = bfhi(xa[ch].x) + gv[ch].y * (R[ch][1] * osc); xn[4 * ch + 2] = bflo(xa[ch].y) + gv[ch].z * (R[ch][2] * osc); xn[4 * ch + 3] = bfhi(xa[ch].y) + gv[ch].w * (R[ch][3] * osc); }
        if (FINAL) {
            float* orow = out + ((size_t)b * TL + (r - CL)) * DM + coff;
#pragma unroll
            for (int ch = 0; ch < 4; ++ch) { f32x4 o; o.x = xn[4 * ch]; o.y = xn[4 * ch + 1]; o.z = xn[4 * ch + 2]; o.w = xn[4 * ch + 3]; __builtin_nontemporal_store(o, (f32x4*)(orow + 256 * ch)); }
        } else {
            bf16* orow = XS + (size_t)row * DM + coff;
#pragma unroll
            for (int ch = 0; ch < 4; ++ch) { v2u o; o.x = pk2(xn[4 * ch], xn[4 * ch + 1]); o.y = pk2(xn[4 * ch + 2], xn[4 * ch + 3]); *(v2u*)(orow + 256 * ch) = o; }
            float ss = 0.f;
#pragma unroll
            for (int i = 0; i < 16; ++i) ss += xn[i] * xn[i];
            const float rs = __builtin_amdgcn_rsqf(wave_sum(ss) * (1.f / DM) + EPS);
            const float* gn = gain_n + coff; const float* shp = mod_n + (size_t)mr * 6144 + coff; const float* scp = shp + 1024;
            bf16* nxp = XNn + (size_t)row * DM + coff;
#pragma unroll
            for (int ch = 0; ch < 4; ++ch) { const f32x4 g = *(const f32x4*)(gn + 256 * ch), sh = *(const f32x4*)(shp + 256 * ch), sc = *(const f32x4*)(scp + 256 * ch);
                const float y0 = xn[4 * ch] * rs * g.x * (sc.x + 1.0f) + sh.x, y1 = xn[4 * ch + 1] * rs * g.y * (sc.y + 1.0f) + sh.y, y2 = xn[4 * ch + 2] * rs * g.z * (sc.z + 1.0f) + sh.z, y3 = xn[4 * ch + 3] * rs * g.w * (sc.w + 1.0f) + sh.w;
                v2u o; o.x = pk2(y0, y1); o.y = pk2(y2, y3); *(v2u*)(nxp + 256 * ch) = o; }
        }
        if (!hn) break;
        it = itn; row = rown; e_lo = e_lo_n; e_hi = e_hi_n; g_lo = g_lo_n; g_hi = g_hi_n;
#pragma unroll
        for (int k = 0; k < 8; ++k) voff[k] = voffn[k];
#pragma unroll
        for (int ch = 0; ch < 4; ++ch) { xa[ch] = xan[ch]; gv[ch] = gvn[ch]; }
    }
}

#ifndef MK_MASK
#define MK_MASK 0x7ff
#endif
#define ENAB(r) (((MK_MASK) >> (r)) & 1)
#define IN(k) (lo <= (k) && (k) < hi)
#define SEAM(k) do { if ((k) + 1 < hi) { if (MK_PER_PHASE) { if (F.tid == 0) __hip_atomic_store(F.ctl + CW_TMO, 0xBADBA0u, RLX_AGENT); } else xcd_barrier(bar); } } while (0)

template <int layer> __device__ __forceinline__ void run_layer(const Frame& F, const Args& args, const XcdBarrier& bar, const int lo, const int hi, unsigned char* lds) {
    unsigned char* ws = args.ws;
    float* MOD = (float*)(ws + WS_MOD);
    const float* RT = (const float*)(ws + WS_ROPE);
    bf16* XS = (bf16*)(ws + WS_XS);
    bf16* OD = (bf16*)(ws + WS_XS);
    bf16* XN = (bf16*)(ws + WS_XN);
    bf16* PB = (bf16*)(ws + WS_PB);
    int* EI = (int*)(ws + WS_EI); float* EG = (float*)(ws + WS_EG);
        const int pb = 1 + layer * PH_PER_LAYER;
        const float* mod = MOD + (size_t)layer * 9 * 6144;
        const float* norm1 = args.in[layer ? 25 : 6]; const float* norm2 = args.in[layer ? 26 : 7];
        const bf16* W_in = (const bf16*)(ws + (layer ? WS_WIN1 : WS_WIN0)); const bf16* W_out = (const bf16*)(ws + (layer ? WS_WOUT1 : WS_WOUT0)); const bf16* W_q = (const bf16*)(ws + (layer ? WS_WQ1 : WS_WQ0));
        const bf16* KEYS = (const bf16*)(ws + (layer ? WS_KEYS1 : WS_KEYS0)); const unsigned char* PU = ws + (layer ? WS_U1 : WS_U0); const unsigned char* PV = PU;
        const int n_in = layer ? N_IN1 : N_IN0;
        const bool lat_only = layer == 1;

        if (ENAB(0) && IN(pb + 0)) {
            if (layer == 0) { norm_mod_phase<true>(F, args.in[0], args.in[2], XS, norm1, mod + 0, mod + 1024, XN, false); SEAM(pb + 0); }
        }
        if (ENAB(1) && IN(pb + 1)) {
            pg8::Gemm g{XN, W_in, MT, n_in, DM}; pg8::StaticOrder S; S.init(MT, n_in, F.G, (int)blockIdx.x);
            PG8_LAS float* xch = (PG8_LAS float*)(F.lds + 132096);
            pg8::EpiHeadNorm<layer> E{PB, n_in, RT + 4096 + layer * 256, RT, xch, QSCALE};
            pg8::gemm_phase<pg8::EpiHeadNorm<layer>, pg8::StaticOrder, true, true>(F.lds, g, S, E);
            SEAM(pb + 1);
        }
        if (ENAB(2) && IN(pb + 2)) {
            if (layer == 0) { l0_headnorm_pool_phase(F, args, PB, XN, RT); SEAM(pb + 2); }
        }
        if (ENAB(3) && IN(pb + 3)) {
            using abf = attn_body::bf16;
            if (layer == 0) {
                for (int u = F.vcu, first = 1; u < NB * 12 * 32; u += F.G, first = 0) {
                    const int combo = u >> 5, qb = u & 31, b = combo / 12, s = combo % 12;
                    const size_t kr0 = (size_t)b * RPB, qr0 = kr0 + CL + (size_t)qb * 256;
                    const int un = u + F.G; const bool hn = un < NB * 12 * 32; const int cn = (hn ? un : u) >> 5, bn = cn / 12, sn = cn % 12; const size_t krn = (size_t)bn * RPB;
                    attn_body::attn_unit2<2, N_IN0, OD_P, 0>((const abf*)(PB + qr0 * N_IN0 + 256 + s * 64), (const abf*)(PB + kr0 * N_IN0 + 1024 + s * 64), (const abf*)(PB + kr0 * N_IN0 + 1792 + (s >> 1) * 128),
                                                         (abf*)(OD + qr0 * OD_P + s * 128), (RPB / 64), (char*)lds, nullptr, 0,
                                                         !first, hn, (const abf*)(PB + krn * N_IN0 + 1024 + sn * 64), (const abf*)(PB + krn * N_IN0 + 1792 + (sn >> 1) * 128));
                }
                for (int u = F.vcu; u < NB * 12; u += F.G) {
                    const int b = u / 12, s = u % 12; const size_t kr0 = (size_t)b * RPB;
                    attn_body::attn_unit2<2, N_IN0, OD_P, 0>((const abf*)(PB + kr0 * N_IN0 + 256 + s * 64), (const abf*)(PB + kr0 * N_IN0 + 1024 + s * 64), (const abf*)(PB + kr0 * N_IN0 + 1792 + (s >> 1) * 128),
                                                         (abf*)(OD + kr0 * OD_P + s * 128), (CL / 64), (char*)lds, nullptr, 0, false, false, nullptr, nullptr);
                }
            } else {
                for (int u = F.vcu, first = 1; u < NB * 8 * 32; u += F.G, first = 0) {
                    const int combo = u >> 5, qb = u & 31, b = combo >> 3, h = combo & 7;
                    const size_t kr0 = (size_t)b * RPB, qr0 = kr0 + CL + (size_t)qb * 256;
                    const int un = u + F.G; const bool hn = un < NB * 8 * 32; const int cn = (hn ? un : u) >> 5, bn = cn >> 3, hn_ = cn & 7; const size_t krn = (size_t)bn * RPB;
                    attn_body::attn_unit2<1, N_IN1, DM, 0>((const abf*)(PB + qr0 * N_IN1 + h * 64), (const abf*)(PB + kr0 * N_IN1 + 512 + (h >> 2) * 64), (const abf*)(PB + kr0 * N_IN1 + 640 + (h >> 2) * 64),
                                                       (abf*)(XN + qr0 * DM + h * 64), (RPB / 64), (char*)lds, nullptr, 0,
                                                       !first, hn, (const abf*)(PB + krn * N_IN1 + 512 + (hn_ >> 2) * 64), (const abf*)(PB + krn * N_IN1 + 640 + (hn_ >> 2) * 64));
                }
            }
            if (layer == 0) SEAM(pb + 3);
        }
        if (ENAB(4) && IN(pb + 4)) {
            if (layer == 0) l0_diff_combine_phase(F, args, OD, XN);
            else {
                if (!(DBGZ & 16)) {
                    using abf = attn_body::bf16;
                    for (int u = F.vcu, first = 1; u < NB * 8 * 32; u += F.G, first = 0) {
                        const int combo = u >> 5, qb = u & 31, b = combo >> 3, h = combo & 7;
                        const size_t kr0 = (size_t)b * RPB, qr0 = kr0 + CL + (size_t)qb * 256;
                        const int un = u + F.G; const bool hn = un < NB * 8 * 32; const int cn = (hn ? un : u) >> 5, bn = cn >> 3, hn_ = cn & 7; const size_t krn = (size_t)bn * RPB;
                        attn_body::attn_unit2<1, N_IN1, DM, 1>((const abf*)(PB + qr0 * N_IN1 + 768 + h * 64), (const abf*)(PB + kr0 * N_IN1 + 1280 + h * 64), (const abf*)(PB + kr0 * N_IN1 + 1792 + h * 64),
                                                              (abf*)(XN + qr0 * DM + 512 + h * 64), 16, (char*)lds, args.in[33] + h * 465, qb * 4,
                                                              !first, hn, (const abf*)(PB + krn * N_IN1 + 1280 + hn_ * 64), (const abf*)(PB + krn * N_IN1 + 1792 + hn_ * 64));
                    }
                }
                if (DBGZ & 24) { for (int row = F.gw; row < MT; row += F.NGW) { v4u z = {0u, 0u, 0u, 0u};
                    if (DBGZ & 8) *(v4u*)(XN + (size_t)row * DM + 8 * F.lane) = z;
                    if (DBGZ & 16) *(v4u*)(XN + (size_t)row * DM + 512 + 8 * F.lane) = z; } }
            }
            SEAM(pb + 4);
        }
        if (ENAB(5) && IN(pb + 5)) {
            pg8::Gemm g{XN, W_out, MT, DM, DM};
            pg8::EpiRes E{XS, args.in[0], args.in[2], mod + 2048, layer == 0 ? 1 : 0};
            if (layer == 0) { pg8::StaticOrder S; S.init(MT, DM, F.G, (int)blockIdx.x); pg8::gemm_phase<pg8::EpiRes, pg8::StaticOrder, true, true>(F.lds, g, S, E); }
            else { pg8::LatOrder S; S.init(DM, F.G, (int)blockIdx.x); pg8::gemm_phase<pg8::EpiRes, pg8::LatOrder, true, true>(F.lds, g, S, E); }
            SEAM(pb + 5);
        }
        if (ENAB(6) && IN(pb + 6)) { norm_mod_phase<false>(F, args.in[0], args.in[2], XS, norm2, mod + 3072, mod + 4096, XN, lat_only); SEAM(pb + 6); }
        if (ENAB(7) && IN(pb + 7)) {
            pg8::Gemm g{XN, W_q, MT, N_WQ, DM};
            pg8::EpiBf16<0> E{PB, N_WQ, nullptr, 0, 0, 1.f};
            if (layer == 0) { pg8::StaticOrder S; S.init(MT, N_WQ, F.G, (int)blockIdx.x); pg8::gemm_phase<pg8::EpiBf16<0>, pg8::StaticOrder, true, true>(F.lds, g, S, E); }
            else { pg8::LatOrder S; S.init(N_WQ, F.G, (int)blockIdx.x); pg8::gemm_phase<pg8::EpiBf16<0>, pg8::LatOrder, true, true>(F.lds, g, S, E); }
            SEAM(pb + 7);
        }
        if (ENAB(8) && IN(pb + 8)) { peer_topk_phase(F, PB, KEYS, EI, EG, lat_only); SEAM(pb + 8); }
        if (ENAB(9) && IN(pb + 9)) {
            if (layer == 0) peer_gather7_phase<false>(F, XN, PU, EI, EG, mod + 5120, XS, args.out, false, args.in[25], MOD + (size_t)9 * 6144, XN);
            else {
#if defined(PROBE_G6)
                if (args.pad) peer_gather7_phase<true, PROBE_G6>(F, XN, PU, EI, EG, mod + 5120, XS, (float*)(ws + WS_PB), true, nullptr, nullptr, nullptr); else
#endif
                peer_gather7_phase<true>(F, XN, PU, EI, EG, mod + 5120, XS, args.out, true, nullptr, nullptr, nullptr);
            }
            SEAM(pb + 9);
        }
}
__global__ void __launch_bounds__(NWAVES * 64, 2) mk_fwd(Args args) {
    extern __shared__ __attribute__((aligned(16))) unsigned char lds[];
    Frame F;
    F.lds = (LAS unsigned char*)lds;
    F.tid = threadIdx.x; F.lane = F.tid & 63; F.wave = __builtin_amdgcn_readfirstlane(F.tid >> 6);
    F.G = gridDim.x; { const int bx = blockIdx.x; F.vcu = (F.G % 8 == 0) ? (bx % 8) * (F.G / 8) + bx / 8 : bx; }
    F.gw = F.vcu * NWAVES + F.wave; F.NGW = F.G * NWAVES;
    unsigned char* ws = args.ws;
    F.ctl = (gu32*)(ws + WS_CTL);
    for (int u = F.tid; u < (LDS_BYTES - LDSCTL_OFF) / 4; u += NWAVES * 64) ((LAS unsigned*)(F.lds + LDSCTL_OFF))[u] = 0u;
    __syncthreads();
    XcdBarrier bar; bar.bar = (unsigned*)(F.ctl + CW_BAR) + args.li * XCD_BAR_WORDS; bar.x = 0; bar.st = nullptr;
    if (!MK_PER_PHASE) bar = xcd_barrier_post((unsigned*)(F.ctl + CW_BAR) + args.li * XCD_BAR_WORDS, (volatile LAS unsigned*)(F.lds + MISC_OFF) + 8);
    const int lo = args.ph_lo, hi = args.ph_hi;
    if (ENAB(10) && IN(0)) { p0_prologue(F, args); SEAM(0); }
    run_layer<0>(F, args, bar, lo, hi, lds);
    run_layer<1>(F, args, bar, lo, hi, lds);
#if defined(EXTRA_BARRIERS)
    if (hi == N_PHASES) { for (int i = 0; i < EXTRA_BARRIERS; ++i) xcd_barrier(bar); }
#endif
}


extern "C" void kernel_launch(void* const* d_in, const int* in_sizes, int n_in, void* d_out, int out_size, void* d_ws, size_t ws_size, hipStream_t stream) {
    static int grid = 0;
    if (grid == 0) {
        if (n_in != 38 || in_sizes[0] != NB * TL * DM || out_size != NB * TL * DM || ws_size < WS_END) {
            fprintf(stderr, "kernel_launch: unexpected problem shape (n_in %d, in0 %d, out %d, ws %zu; need ws >= %zu); nothing launched\n", n_in, n_in > 0 ? in_sizes[0] : -1, out_size, ws_size, (size_t)WS_END); grid = -1; return; }
        int dev = 0, cus = 0, per_cu = 0;
        if (hipGetDevice(&dev) != hipSuccess || hipDeviceGetAttribute(&cus, hipDeviceAttributeMultiprocessorCount, dev) != hipSuccess) { grid = -1; return; }
        if (hipFuncSetAttribute((const void*)mk_fwd, hipFuncAttributeMaxDynamicSharedMemorySize, LDS_BYTES) != hipSuccess) { fprintf(stderr, "kernel_launch: hipFuncSetAttribute failed\n"); grid = -1; return; }
        if (hipOccupancyMaxActiveBlocksPerMultiprocessor(&per_cu, (const void*)mk_fwd, NWAVES * 64, LDS_BYTES) != hipSuccess || per_cu < 1) { fprintf(stderr, "kernel_launch: occupancy query says %d blocks per CU\n", per_cu); }
        (void)hipGetLastError();
        grid = cus;
    }
    if (grid < 0) return;
    if (hipMemsetAsync((char*)d_ws + WS_CTL, 0, CTL_ZERO_BYTES, stream) != hipSuccess) return;
    Args a{};
    for (int i = 0; i < 38; ++i) a.in[i] = (const float*)d_in[i];
    a.out = (float*)d_out; a.ws = (unsigned char*)d_ws;
#if MK_PER_PHASE
    for (int p = 0; p < N_PHASES; ++p) { a.ph_lo = p; a.ph_hi = p + 1; hipLaunchKernelGGL(mk_fwd, dim3(grid), dim3(NWAVES * 64), LDS_BYTES, stream, a); }
#else
    a.ph_lo = 0; a.ph_hi = N_PHASES;
    hipLaunchKernelGGL(mk_fwd, dim3(grid), dim3(NWAVES * 64), LDS_BYTES, stream, a);
#if defined(EXTRA_PHASE)
#ifndef EXTRA_HI
#define EXTRA_HI (EXTRA_PHASE + 1)
#endif
    a.ph_lo = EXTRA_PHASE; a.ph_hi = EXTRA_HI; a.li = 1;
#if defined(PROBE_G6)
    a.pad = 1;
#endif
    hipLaunchKernelGGL(mk_fwd, dim3(grid), dim3(NWAVES * 64), LDS_BYTES, stream, a);
#endif
#endif
    const hipError_t le = hipPeekAtLastError();
    if (le != hipSuccess) fprintf(stderr, "kernel_launch: launch failed: %s\n", hipGetErrorName(le));
}
```

```cpp
#define HIONLY 1
#include <hip/hip_runtime.h>
#include <hip/hip_bf16.h>
#include <cstdio>
#include <cstdint>
#include <cmath>
namespace pg8 {
#define PG8_LAS __attribute__((address_space(3)))
typedef unsigned short bf16_t;
typedef short bf16x8 __attribute__((ext_vector_type(8)));
typedef float f32x4 __attribute__((ext_vector_type(4)));
typedef unsigned u32x4 __attribute__((ext_vector_type(4)));
constexpr int BM = 256, BK = 64, HALF = 128, HTB = HALF * BK * 2  , STAGE_BYTES = 8 * HTB, NXCD = 8, WGM = 8;

__host__ __device__ __forceinline__ int lds_byte(int r, int c) { const int st = (r >> 4) * 2 + (c >> 5), rr = r & 15, cc = c & 31, ob = rr * 64 + cc * 2; return st * 1024 + (ob ^ (((ob >> 9) & 1) << 5)); }
__host__ __device__ __forceinline__ void stage_rc(int b, int& R, int& C) { const int st = b / 1024, sb = b % 1024, swz = sb ^ (((sb >> 9) & 1) << 5); R = (st >> 1) * 16 + swz / 64; C = (st & 1) * 32 + (swz % 64) / 2; }
__host__ __device__ __forceinline__ int perm32(int rho) { const int n = rho >> 4, i = rho & 15; return 8 * (i >> 2) + 4 * n + (i & 3); }

struct Unit { int pm, pn; };
struct Gemm { const bf16_t* A; const bf16_t* Bt; int M, N, K; };

struct StaticOrder {
    int nM, nN, nwg, G, c;
    __host__ __device__ void init(int M, int N, int G_, int c_) { nM = M / BM; nN = N / BM; nwg = nM * nN; G = G_; c = c_; }
    __host__ __device__ bool next(int i, Unit& u) const {
        const long L = (long)i * G + c; if (L >= nwg) return false;
        int wgid = (int)L; { const int q = nwg / NXCD, r = nwg % NXCD, xcd = wgid % NXCD, off = wgid / NXCD; wgid = (xcd < r ? xcd * (q + 1) : r * (q + 1) + (xcd - r) * q) + off; }
        const int nig = WGM * nN, gid = wgid / nig, fm = gid * WGM, gsz = (nM - fm) < WGM ? (nM - fm) : WGM;
        u.pm = fm + ((wgid % nig) % gsz); u.pn = (wgid % nig) / gsz; return true;
    }
    __device__ __forceinline__ void a_ready(const Unit&) const {}
    __device__ __forceinline__ void done(const Unit&) const {}
};

__device__ __forceinline__ unsigned cvt_pk_bf16(float lo, float hi) { unsigned r; asm volatile("v_cvt_pk_bf16_f32 %0, %1, %2" : "=v"(r) : "v"(lo), "v"(hi)); return r; }
typedef float f32x2 __attribute__((ext_vector_type(2)));
__device__ __forceinline__ f32x2 gelu_pk(f32x2 v) {
    const f32x2 av = __builtin_elementwise_abs(v), d = av * 0.2316418882f + 1.0f;
    f32x2 t; t.x = __builtin_amdgcn_rcpf(d.x); t.y = __builtin_amdgcn_rcpf(d.y);
    f32x2 q = t * 0.5307027145f + (-0.7265760135f); q = q * t + 0.7107068705f; q = q * t + (-0.142248368f); q = q * t + 0.127414796f; q = q * t;
    const f32x2 s = (v * v) * (-0.72134752044f);
    f32x2 e; e.x = __builtin_amdgcn_exp2f(s.x); e.y = __builtin_amdgcn_exp2f(s.y);
    const f32x2 m = v * (q * e), r = v - m;
    f32x2 o; o.x = v.x < 0.f ? m.x : r.x; o.y = v.y < 0.f ? m.y : r.y; return o;
}

template <int ACT  > struct EpiBf16 {
    static constexpr bool PERM = true, AFTER_DRAIN = false; static_assert(ACT == 0 || ACT == 1, "EpiBf16: ACT is 0 (none) or 1 (gelu_pk)");
    bf16_t* O; int ldc; const float* bias; int split_cols; size_t split_stride; float scale0;
    __device__ __forceinline__ void operator()(const f32x4 (&acc)[2][2][4][2], const Unit& u, int wr, int wc, int fr, int fq) const {
        const int row0 = u.pm * BM + wr * 64 + fr; int colt = u.pn * BM; bf16_t* base = O;
        float sc = 1.f; if (split_cols) { const int t = colt / split_cols; base += (size_t)t * split_stride; colt -= t * split_cols; if (t == 0) sc = scale0; }
        const int col0 = colt + wc * 32 + 8 * fq, bcol0 = u.pn * BM + wc * 32 + 8 * fq;
        f32x4 bv[2][2];
#pragma unroll
        for (int bj = 0; bj < 2; ++bj)
#pragma unroll
            for (int n = 0; n < 2; ++n) bv[bj][n] = bias ? *(const f32x4*)(bias + bcol0 + bj * HALF + 4 * n) : (f32x4){0.f, 0.f, 0.f, 0.f};
#pragma unroll
        for (int ai = 0; ai < 2; ++ai)
#pragma unroll
            for (int m = 0; m < 4; ++m) { bf16_t* rowp = base + (size_t)(row0 + ai * HALF + m * 16) * ldc + col0;
#pragma unroll
                for (int bj = 0; bj < 2; ++bj) { f32x4 v0 = acc[ai][bj][m][0] + bv[bj][0], v1 = acc[ai][bj][m][1] + bv[bj][1];
                    if (ACT == 1) { f32x2 a = gelu_pk((f32x2){v0[0], v0[1]}), b = gelu_pk((f32x2){v0[2], v0[3]}), c = gelu_pk((f32x2){v1[0], v1[1]}), d = gelu_pk((f32x2){v1[2], v1[3]});
                        v0 = (f32x4){a.x, a.y, b.x, b.y}; v1 = (f32x4){c.x, c.y, d.x, d.y}; }
                    v0 = v0 * sc; v1 = v1 * sc; u32x4 w; w.x = cvt_pk_bf16(v0[0], v0[1]); w.y = cvt_pk_bf16(v0[2], v0[3]); w.z = cvt_pk_bf16(v1[0], v1[1]); w.w = cvt_pk_bf16(v1[2], v1[3]);
                    *(u32x4*)(rowp + bj * HALF) = w; } }
    }
};

struct EpiRes {
    static constexpr bool PERM = true, AFTER_DRAIN = false;
    bf16_t* out; const float* xlat; const float* xctx; const float* g1; int from_input;
    __device__ __forceinline__ void operator()(const f32x4 (&acc)[2][2][4][2], const Unit& u, int wr, int wc, int fr, int fq) const {
        const int b = u.pm / 33, seg = u.pm % 33, mr = seg == 0 ? 8 : b;
        const int rt0 = wr * 64 + fr, col0 = u.pn * BM + wc * 32 + 8 * fq;
        const float* gp = g1 + (size_t)mr * 6144 + col0;
        const float* xbase = seg == 0 ? xctx + (size_t)b * 256 * 1024 : xlat + ((size_t)b * 8192 + (size_t)(seg - 1) * 256) * 1024;
        bf16_t* obase = out + (size_t)u.pm * BM * 1024;
#pragma unroll
        for (int bj = 0; bj < 2; ++bj) { const f32x4 g0 = *(const f32x4*)(gp + bj * HALF), g1v = *(const f32x4*)(gp + bj * HALF + 4);
#pragma unroll
            for (int ai = 0; ai < 2; ++ai)
#pragma unroll
                for (int m = 0; m < 4; ++m) { const unsigned ro = (unsigned)(rt0 * 1024 + col0) + (unsigned)((ai * HALF + m * 16) * 1024 + bj * HALF);
                    f32x4 x0, x1;
                    if (from_input) { x0 = *(const f32x4*)(xbase + ro); x1 = *(const f32x4*)(xbase + ro + 4); }
                    else { const u32x4 w = *(const u32x4*)(obase + ro);
                        x0 = (f32x4){__builtin_bit_cast(float, w.x << 16), __builtin_bit_cast(float, w.x & 0xffff0000u), __builtin_bit_cast(float, w.y << 16), __builtin_bit_cast(float, w.y & 0xffff0000u)};
                        x1 = (f32x4){__builtin_bit_cast(float, w.z << 16), __builtin_bit_cast(float, w.z & 0xffff0000u), __builtin_bit_cast(float, w.w << 16), __builtin_bit_cast(float, w.w & 0xffff0000u)}; }
                    const f32x4 v0 = x0 + g0 * acc[ai][bj][m][0], v1 = x1 + g1v * acc[ai][bj][m][1];
                    u32x4 o; o.x = cvt_pk_bf16(v0[0], v0[1]); o.y = cvt_pk_bf16(v0[2], v0[3]); o.z = cvt_pk_bf16(v1[0], v1[1]); o.w = cvt_pk_bf16(v1[2], v1[3]);
                    *(u32x4*)(obase + ro) = o; }
            asm volatile("" ::: "memory"); }
    }
};

template <int LAYER> struct EpiHeadNorm {
    static constexpr bool PERM = true, AFTER_DRAIN = false;
    bf16_t* O; int ldc; const float* gains; const float* RT; PG8_LAS float* xch; float qscale;
    __device__ __forceinline__ static int kind_of(int pn, int hh) {
        if (LAYER == 0) return (pn >= 1 && pn <= 3) ? 1 : (pn >= 4 && pn <= 6) ? 2 : 0;
        return pn <= 1 ? 1 : pn == 2 ? (hh < 2 ? 2 : 0) : pn <= 4 ? 1 : pn <= 6 ? 2 : 0;
    }
    __device__ __forceinline__ void operator()(const f32x4 (&acc)[2][2][4][2], const Unit& u, int wr, int wc, int fr, int fq) const {
        asm volatile("" : "+v"(fr), "+v"(fq));
        const int pn = u.pn, wid = wr * 4 + wc;
        const int row0 = u.pm * BM + wr * 64 + fr, col0 = pn * BM + wc * 32 + 8 * fq;
        const bool any = LAYER == 0 ? (pn >= 1 && pn <= 6) : (pn <= 6);
        if (any) {
#pragma unroll
            for (int ai = 0; ai < 2; ++ai)
#pragma unroll
                for (int m = 0; m < 4; ++m)
#pragma unroll
                    for (int bj = 0; bj < 2; ++bj) { const f32x4 a = acc[ai][bj][m][0], b = acc[ai][bj][m][1];
                        float s = (a[0] * a[0] + a[1] * a[1]) + (a[2] * a[2] + a[3] * a[3]) + (b[0] * b[0] + b[1] * b[1]) + (b[2] * b[2] + b[3] * b[3]);
                        s += __shfl_xor(s, 16); s += __shfl_xor(s, 32);
                        if (fq == 0) xch[wid * 256 + ((ai * 4 + m) * 2 + bj) * 16 + fr] = s; }
            asm volatile("s_waitcnt lgkmcnt(0)" ::: "memory");
            __builtin_amdgcn_s_barrier();
        }
        const int seg = u.pm % 33; const bool lat = seg != 0;
#pragma unroll
        for (int ai = 0; ai < 2; ++ai)
#pragma unroll
            for (int m = 0; m < 4; ++m) { const int rt = wr * 64 + fr + ai * HALF + m * 16; bf16_t* rowp = O + (size_t)(u.pm * BM + rt) * ldc + col0;
                const int t = (seg - 1) * 256 + rt;
#pragma unroll
                for (int bj = 0; bj < 2; ++bj) {
                    const int hh = 2 * bj + (wc >> 1); const int kind = kind_of(pn, hh);
                    float rs = 1.f; const bool rope = kind != 0 && lat && (LAYER == 0 || pn <= 2);
                    if (kind != 0) {
                        const float tot = xch[wid * 256 + ((ai * 4 + m) * 2 + bj) * 16 + fr] + xch[(wid ^ 1) * 256 + ((ai * 4 + m) * 2 + bj) * 16 + fr];
                        rs = __builtin_amdgcn_rsqf(tot * (1.f / 64) + 1e-6f) * (kind == 1 ? qscale : 1.f); }
                    const bool fam2 = LAYER == 1 && pn >= 3;
                    const float* gp = gains + ((kind == 1 ? 0 : 1) + (fam2 ? 2 : 0)) * 64 + 32 * (wc & 1) + 8 * fq;
                    const int pos = (wc & 1) == 0 ? (t >> 6) : (t & 63);
                    const float* cp = RT + pos * 16 + 8 * (fq & 1);
                    unsigned wv[4];
#pragma unroll
                    for (int n = 0; n < 2; ++n) { f32x4 v = acc[ai][bj][m][n];
                        if (kind != 0) { v = v * rs * *(const f32x4*)(gp + 4 * n);
                            if (rope) { const f32x4 c = *(const f32x4*)(cp + 4 * n), sn = *(const f32x4*)(cp + 2048 + 4 * n); f32x4 p;
#pragma unroll
                                for (int e = 0; e < 4; ++e) p[e] = __shfl_xor(v[e], 32);
                                v = ((fq >> 1) == 0) ? v * c - p * sn : v * c + p * sn; } }
                        wv[2 * n] = cvt_pk_bf16(v[0], v[1]); wv[2 * n + 1] = cvt_pk_bf16(v[2], v[3]); }
                    u32x4 w; w.x = wv[0]; w.y = wv[1]; w.z = wv[2]; w.w = wv[3];
                    *(u32x4*)(rowp + bj * HALF) = w; }
                asm volatile("" ::: "memory"); }
    }
};
struct LatOrder {
    StaticOrder S;
    __host__ __device__ void init(int N, int G_, int c_) { S.init(65536, N, G_, c_); }
    __host__ __device__ bool next(int i, Unit& u) const { if (!S.next(i, u)) return false; u.pm = u.pm + u.pm / 32 + 1; return true; }
    __device__ __forceinline__ void a_ready(const Unit&) const {}
    __device__ __forceinline__ void done(const Unit&) const {}
};
template <class Epi, class Sched, bool ALIGN_EPI = false, bool SP2 = false>
__device__ __forceinline__ void gemm_phase(PG8_LAS unsigned char* lds, const Gemm g, const Sched& S, const Epi& E) {
    const int tid = threadIdx.x, wid = __builtin_amdgcn_readfirstlane(tid >> 6), lane = tid & 63, wr = wid >> 2, wc = wid & 3, fr = lane & 15, fq = lane >> 4;
    const int K = g.K, nt = K / BK;
    unsigned voffA[2], voffB[2];
#pragma unroll
    for (int i = 0; i < 2; ++i) { int R, C; stage_rc(tid * 16 + i * 8192, R, C); const int Rb = Epi::PERM ? ((R & ~31) + perm32(R & 31)) : R;
        voffA[i] = (unsigned)(R * K + C) * 2u; voffB[i] = (unsigned)(Rb * K + C) * 2u; }
    const size_t kstep = (size_t)(BK * 2);
    const size_t hstep = (size_t)HALF * K * 2;
    const size_t tstep = 2 * hstep;
    const unsigned ldsw = (unsigned)wid * 1024u;
    const int aoff = lds_byte(wr * 64 + fr, fq * 8), boff = lds_byte(wc * 32 + fr, fq * 8);
#define PG8_SA(b, h) (((b) * 2 + (h)) * HTB)
#define PG8_SB(b, h) ((4 + (b) * 2 + (h)) * HTB)
#define PG8_STAGE(bufoff, gbase, voff) do { _Pragma("unroll") for (int _i = 0; _i < 2; ++_i) \
        __builtin_amdgcn_global_load_lds((const unsigned*)((const char*)(gbase) + (voff)[_i]), (PG8_LAS unsigned*)(lds + (bufoff) + ldsw + _i * 8192), 16, 0, 0); } while (0)
#define PG8_LDA(dst, b, h) do { _Pragma("unroll") for (int m = 0; m < 4; ++m) _Pragma("unroll") for (int k = 0; k < 2; ++k) dst[m][k] = *(const PG8_LAS bf16x8*)(lds + PG8_SA(b, h) + aoff + m * 2048 + k * 1024); } while (0)
#define PG8_LDB(dst, b, h) do { _Pragma("unroll") for (int n = 0; n < 2; ++n) _Pragma("unroll") for (int k = 0; k < 2; ++k) dst[n][k] = *(const PG8_LAS bf16x8*)(lds + PG8_SB(b, h) + boff + n * 2048 + k * 1024); } while (0)
#define PG8_MMA(ai, bj, At, Bt) do { __builtin_amdgcn_s_setprio(1); _Pragma("unroll") for (int m = 0; m < 4; ++m) _Pragma("unroll") for (int n = 0; n < 2; ++n) _Pragma("unroll") for (int k = 0; k < 2; ++k) \
        acc[ai][bj][m][n] = __builtin_amdgcn_mfma_f32_16x16x32_bf16(Bt[n][k], At[m][k], acc[ai][bj][m][n], 0, 0, 0); __builtin_amdgcn_s_setprio(0); } while (0)
#define PG8_WAIT_V(n) asm volatile("s_waitcnt vmcnt(" #n ")" ::: "memory")
#define PG8_WAIT_L(n) asm volatile("s_waitcnt lgkmcnt(" #n ")" ::: "memory")
#define PG8_BAR __builtin_amdgcn_s_barrier()
#define PG8_SCHED __builtin_amdgcn_sched_barrier(0)
    Unit cur, nxt; int ui = 0;
    if (!S.next(0, cur)) return;
    f32x4 acc[2][2][4][2];
#pragma unroll
    for (int a = 0; a < 2; ++a)
#pragma unroll
        for (int b = 0; b < 2; ++b)
#pragma unroll
            for (int m = 0; m < 4; ++m)
#pragma unroll
                for (int n = 0; n < 2; ++n) acc[a][b][m][n] = (f32x4){0.f, 0.f, 0.f, 0.f};
    bf16x8 At[4][2], B0[2][2], B1[2][2];
    const char* cA = (const char*)g.A + (size_t)cur.pm * tstep; const char* cB = (const char*)g.Bt + (size_t)cur.pn * tstep;
    S.a_ready(cur);
    if constexpr (SP2) {
        PG8_STAGE(PG8_SB(0, 0), cB, voffB); PG8_STAGE(PG8_SB(0, 1), cB + hstep, voffB); PG8_STAGE(PG8_SA(0, 0), cA, voffA); PG8_STAGE(PG8_SA(0, 1), cA + hstep, voffA);
        if (wr == 1) PG8_BAR;
        PG8_WAIT_V(2); PG8_BAR;
        PG8_STAGE(PG8_SB(1, 0), cB + kstep, voffB); PG8_STAGE(PG8_SA(1, 0), cA + kstep, voffA); PG8_STAGE(PG8_SB(1, 1), cB + hstep + kstep, voffB);
        PG8_WAIT_V(6); PG8_BAR;
    } else {
        PG8_STAGE(PG8_SB(0, 0), cB, voffB); PG8_STAGE(PG8_SA(0, 0), cA, voffA); PG8_STAGE(PG8_SB(0, 1), cB + hstep, voffB); PG8_STAGE(PG8_SA(0, 1), cA + hstep, voffA);
        if (wr == 1) PG8_BAR;
        PG8_WAIT_V(4); PG8_BAR;
        PG8_STAGE(PG8_SB(1, 0), cB + kstep, voffB); PG8_STAGE(PG8_SA(1, 0), cA + kstep, voffA); PG8_STAGE(PG8_SB(1, 1), cB + hstep + kstep, voffB);
        PG8_WAIT_V(6); PG8_BAR;
    }
    for (;;) {
        const bool has_next = S.next(ui + 1, nxt);
        const char* nA = has_next ? (const char*)g.A + (size_t)nxt.pm * tstep : cA; const char* nB = has_next ? (const char*)g.Bt + (size_t)nxt.pn * tstep : cB;
        for (int t = 0; t < nt; t += 2) {
            const bool last = (t == nt - 2);
            const char* a1 = cA + (size_t)(t + 1) * kstep;
            const char* a2 = last ? nA : cA + (size_t)(t + 2) * kstep; const char* b2 = last ? nB : cB + (size_t)(t + 2) * kstep;
            const char* a3 = a2 + kstep; const char* b3 = b2 + kstep;
            if (last && has_next) S.a_ready(nxt);
            if constexpr (SP2) {
            PG8_LDB(B0, 0, 0); PG8_LDB(B1, 0, 1); PG8_SCHED; PG8_LDA(At, 0, 0); PG8_STAGE(PG8_SA(1, 1), a1 + hstep, voffA);
            PG8_WAIT_V(8); PG8_WAIT_L(0); PG8_BAR; PG8_MMA(0, 0, At, B0); PG8_MMA(0, 1, At, B1); PG8_BAR; PG8_SCHED;
            PG8_LDA(At, 0, 1); PG8_STAGE(PG8_SB(0, 0), b2, voffB); PG8_STAGE(PG8_SB(0, 1), b2 + hstep, voffB); PG8_STAGE(PG8_SA(0, 0), a2, voffA);
            PG8_WAIT_V(8); PG8_WAIT_L(0); PG8_BAR; PG8_MMA(1, 0, At, B0); PG8_MMA(1, 1, At, B1); PG8_BAR; PG8_SCHED;
            PG8_LDB(B0, 1, 0); PG8_LDB(B1, 1, 1); PG8_SCHED; PG8_LDA(At, 1, 0); PG8_STAGE(PG8_SA(0, 1), a2 + hstep, voffA);
            PG8_WAIT_V(8); PG8_WAIT_L(0); PG8_BAR; PG8_MMA(0, 0, At, B0); PG8_MMA(0, 1, At, B1); PG8_BAR; PG8_SCHED;
            PG8_LDA(At, 1, 1); PG8_STAGE(PG8_SB(1, 0), b3, voffB); PG8_STAGE(PG8_SB(1, 1), b3 + hstep, voffB); PG8_STAGE(PG8_SA(1, 0), a3, voffA);
            PG8_WAIT_V(8); PG8_WAIT_L(0); PG8_BAR; PG8_MMA(1, 0, At, B0); PG8_MMA(1, 1, At, B1); PG8_BAR; PG8_SCHED;
            } else {
            PG8_LDB(B0, 0, 0); PG8_SCHED; PG8_LDA(At, 0, 0); PG8_STAGE(PG8_SA(1, 1), a1 + hstep, voffA);
            PG8_WAIT_L(8); PG8_BAR; PG8_WAIT_L(0); PG8_MMA(0, 0, At, B0); PG8_BAR; PG8_SCHED;
            PG8_LDB(B1, 0, 1); PG8_STAGE(PG8_SB(0, 0), b2, voffB);
            PG8_BAR; PG8_WAIT_L(0); PG8_MMA(0, 1, At, B1); PG8_BAR;
            PG8_LDA(At, 0, 1); PG8_STAGE(PG8_SA(0, 0), a2, voffA);
            PG8_BAR; PG8_WAIT_L(0); PG8_MMA(1, 0, At, B0); PG8_BAR; PG8_SCHED;
            PG8_STAGE(PG8_SB(0, 1), b2 + hstep, voffB);
            PG8_WAIT_V(6); PG8_BAR; PG8_MMA(1, 1, At, B1); PG8_BAR;
            PG8_LDB(B0, 1, 0); PG8_SCHED; PG8_LDA(At, 1, 0); PG8_STAGE(PG8_SA(0, 1), a2 + hstep, voffA);
            PG8_WAIT_L(8); PG8_BAR; PG8_WAIT_L(0); PG8_MMA(0, 0, At, B0); PG8_BAR; PG8_SCHED;
            PG8_LDB(B1, 1, 1); PG8_STAGE(PG8_SB(1, 0), b3, voffB);
            PG8_BAR; PG8_WAIT_L(0); PG8_MMA(0, 1, At, B1); PG8_BAR;
            PG8_LDA(At, 1, 1); PG8_STAGE(PG8_SA(1, 0), a3, voffA);
            PG8_BAR; PG8_WAIT_L(0); PG8_MMA(1, 0, At, B0); PG8_BAR; PG8_SCHED;
            PG8_STAGE(PG8_SB(1, 1), b3 + hstep, voffB);
            PG8_WAIT_V(6); PG8_BAR; PG8_MMA(1, 1, At, B1); PG8_BAR;
            }
        }
        if constexpr (ALIGN_EPI) { if (wr == 0) PG8_BAR; }
        if constexpr (!Epi::AFTER_DRAIN) { E(acc, cur, wr, wc, fr, fq); S.done(cur); }
        if (!has_next) break;
#pragma unroll
        for (int a = 0; a < 2; ++a)
#pragma unroll
            for (int b = 0; b < 2; ++b)
#pragma unroll
                for (int m = 0; m < 4; ++m)
#pragma unroll
                    for (int n = 0; n < 2; ++n) acc[a][b][m][n] = (f32x4){0.f, 0.f, 0.f, 0.f};
        cur = nxt; cA = nA; cB = nB; ++ui;
        if constexpr (ALIGN_EPI) { if (wr == 1) PG8_BAR; }
    }
    PG8_WAIT_V(0);
    if constexpr (!ALIGN_EPI) { if (wr == 0) PG8_BAR; }
    PG8_BAR;
    if constexpr (Epi::AFTER_DRAIN) { E.fused(acc, cur, wr, wc, fr, fq, lds, wid, lane); S.done(cur); }
#undef PG8_SA
#undef PG8_SB
#undef PG8_STAGE
#undef PG8_LDA
#undef PG8_LDB
#undef PG8_MMA
#undef PG8_WAIT_V
#undef PG8_WAIT_L
#undef PG8_BAR
#undef PG8_SCHED
}
}

namespace attn_body {
using bf16=__hip_bfloat16;
using bf16x8=__attribute__((ext_vector_type(8)))short;
using s16x4=__attribute__((ext_vector_type(4)))short;
using f32x16=__attribute__((ext_vector_type(16)))float;
using u32x4=__attribute__((ext_vector_type(4)))unsigned;
constexpr int D=64;
constexpr int NW=8,QBLK=32,QB=QBLK*NW,KVBLK=64;
__device__ __forceinline__ int crow(int r,int hi){return (r&3)+8*(r>>2)+4*hi;}
#define SBAR() __builtin_amdgcn_sched_barrier(0)
__device__ __forceinline__ void cmask(f32x16&p0,f32x16&p1,int jb,int qrel,int hi){
  const float NEG=-INFINITY; int kb=64*jb+4*hi;
  #pragma unroll
  for(int r=0;r<16;++r){int kv=kb+(r&3)+8*(r>>2); if(kv>qrel)p0[r]=NEG; if(kv+32>qrel)p1[r]=NEG;}
}

constexpr int NSLOT=3, SLOTB=8192;
constexpr int LDS_K=0, LDS_V=NSLOT*SLOTB, LDS_WS=2*NSLOT*SLOTB, LDS_OST=LDS_WS+NW*64*4, LDS_BYTES=LDS_OST+NW*4096;
constexpr float C2=0.125f*1.4426950408889634f;
__device__ __forceinline__ void glds16(const void*gsrc,unsigned lds_dst){unsigned keep;
  asm volatile("s_mov_b32 %0, m0\n\ts_mov_b32 m0, %2\n\ts_nop 0\n\tglobal_load_lds_dwordx4 %1, off\n\ts_mov_b32 m0, %0":"=&s"(keep):"v"(gsrc),"s"(lds_dst):"memory");}
__device__ __forceinline__ float max3f(float a,float b,float c){float r;asm("v_max3_f32 %0, %1, %2, %3":"=v"(r):"v"(a),"v"(b),"v"(c));return r;}
__device__ __forceinline__ float max2f(float a,float b){float r;asm("v_max_f32_e32 %0, %1, %2":"=v"(r):"v"(a),"v"(b));return r;}
__device__ __forceinline__ float fadd_s(float a,float b){float r;asm("v_add_f32_e32 %0, %1, %2":"=v"(r):"v"(a),"v"(b));return r;}
__device__ __forceinline__ float fsub_s(float a,float b){float r;asm("v_sub_f32_e32 %0, %1, %2":"=v"(r):"v"(a),"v"(b));return r;}
typedef float f32x2_t __attribute__((ext_vector_type(2))); typedef __bf16 bf16x2_t __attribute__((ext_vector_type(2)));
__device__ __forceinline__ unsigned cvtpk_s(float lo,float hi){f32x2_t v={lo,hi};bf16x2_t b=__builtin_convertvector(v,bf16x2_t);return __builtin_bit_cast(unsigned,b);}
#define WAIT_BAR(N) asm volatile("s_waitcnt vmcnt(" #N ") lgkmcnt(0)\n\ts_barrier":::"memory")

__device__ __forceinline__ void qkt(f32x16&p0,f32x16&p1,const char*Kslot,const bf16x8*qr,const f32x16&negm,int r32,int hi){
  const char*kb=Kslot+hi*1024+r32*16;
  #pragma unroll
  for(int d0=0;d0<4;++d0){
    const bf16x8 b0=*reinterpret_cast<const bf16x8*>(kb+d0*2048);
    const bf16x8 b1=*reinterpret_cast<const bf16x8*>(kb+d0*2048+512);
    if(d0==0){p0=__builtin_amdgcn_mfma_f32_32x32x16_bf16(b0,qr[0],negm,0,0,0);p1=__builtin_amdgcn_mfma_f32_32x32x16_bf16(b1,qr[0],negm,0,0,0);}
    else{p0=__builtin_amdgcn_mfma_f32_32x32x16_bf16(b0,qr[d0],p0,0,0,0);p1=__builtin_amdgcn_mfma_f32_32x32x16_bf16(b1,qr[d0],p1,0,0,0);}}
}
typedef __attribute__((address_space(3))) const char* lds_cptr;
typedef short v4i16_t __attribute__((ext_vector_type(4)));
__device__ __forceinline__ void kload8(bf16x8*kf,lds_cptr kp){
  kf[0]=*(const __attribute__((address_space(3))) bf16x8*)(kp);      kf[1]=*(const __attribute__((address_space(3))) bf16x8*)(kp+512);
  kf[2]=*(const __attribute__((address_space(3))) bf16x8*)(kp+2048); kf[3]=*(const __attribute__((address_space(3))) bf16x8*)(kp+2560);
  kf[4]=*(const __attribute__((address_space(3))) bf16x8*)(kp+4096); kf[5]=*(const __attribute__((address_space(3))) bf16x8*)(kp+4608);
  kf[6]=*(const __attribute__((address_space(3))) bf16x8*)(kp+6144); kf[7]=*(const __attribute__((address_space(3))) bf16x8*)(kp+6656);
}
__device__ __forceinline__ void kload2(bf16x8*kf,lds_cptr kp,int j){ kf[2*j]=*(const __attribute__((address_space(3))) bf16x8*)(kp+j*2048); kf[2*j+1]=*(const __attribute__((address_space(3))) bf16x8*)(kp+j*2048+512); }
__device__ __forceinline__ s16x4 vtr(lds_cptr p){ return __builtin_bit_cast(s16x4,__builtin_amdgcn_ds_read_tr16_b64_v4i16((__attribute__((address_space(3))) v4i16_t*)p)); }
__device__ __forceinline__ float rowmax(const f32x16&p0,const f32x16&p1){
  float a=max3f(p0[0],p0[1],p1[0]),b=max3f(p0[2],p0[3],p1[1]);a=max3f(a,p1[2],p1[3]);
  #pragma unroll
  for(int r=4;r<16;r+=4){a=max3f(a,p0[r],p0[r+1]);b=max3f(b,p0[r+2],p0[r+3]);a=max3f(a,p1[r],p1[r+1]);b=max3f(b,p1[r+2],p1[r+3]);}
  const float m=max2f(a,b);
  auto rr=__builtin_amdgcn_permlane32_swap(__float_as_uint(m),__float_as_uint(m),false,false);
  return max2f(__uint_as_float(rr[0]),__uint_as_float(rr[1]));
}
__device__ __forceinline__ void pv(f32x16*o,int vb,bf16x8 pa0,bf16x8 pa1,bf16x8 pa2,bf16x8 pa3){
  #pragma unroll
  for(int d0=0;d0<2;++d0){s16x4 lo[4],hi[4];
    #pragma unroll
    for(int ks=0;ks<4;++ks){
      asm volatile("ds_read_b64_tr_b16 %0,%1 offset:%c2":"=&v"(lo[ks]):"v"(vb),"i"(d0*4096+ks*1024):"memory");
      asm volatile("ds_read_b64_tr_b16 %0,%1 offset:%c2":"=&v"(hi[ks]):"v"(vb),"i"(d0*4096+ks*1024+512):"memory");}
    asm volatile("s_waitcnt lgkmcnt(0)":::"memory");SBAR();
    #define PK(k) (bf16x8){lo[k][0],lo[k][1],lo[k][2],lo[k][3],hi[k][0],hi[k][1],hi[k][2],hi[k][3]}
    o[d0]=__builtin_amdgcn_mfma_f32_32x32x16_bf16(pa0,PK(0),o[d0],0,0,0);
    o[d0]=__builtin_amdgcn_mfma_f32_32x32x16_bf16(pa1,PK(1),o[d0],0,0,0);
    o[d0]=__builtin_amdgcn_mfma_f32_32x32x16_bf16(pa2,PK(2),o[d0],0,0,0);
    o[d0]=__builtin_amdgcn_mfma_f32_32x32x16_bf16(pa3,PK(3),o[d0],0,0,0);
    #undef PK
  }
}

#ifndef ATTN_STORE16
#define ATTN_STORE16(p,v) (*(u32x4*)(p)=(v))
#endif
template<int DV2,int P,int OP,int MODE> __device__ __forceinline__ void attn_unit2(const bf16*Q0,const bf16*__restrict__ Kh,const bf16*__restrict__ Vh,bf16*O0,const int NT,char*shm,const float*rpbh,const int gr0,
    const bool pre,const bool has_next,const bf16*__restrict__ Khn,const bf16*__restrict__ Vhn){
  const int tid=threadIdx.x,lane=tid&63,r32=lane&31,hi=lane>>5; const int wid=__builtin_amdgcn_readfirstlane(tid>>6);
  const bf16*Qw=Q0+(long)(wid*QBLK)*P;
  constexpr int VSL=DV2, LWS_=LDS_V+NSLOT*SLOTB*DV2, LOST_=LWS_+NW*64*4;
  const unsigned lds0=(unsigned)(uintptr_t)shm;
  float*wsf=(float*)(shm+LWS_)+wid*64;
  const bf16*ksrc=Kh+(long)lane*P+wid*8;
  const bf16*vsrc=Vh+(long)(16*(wid&3)+(lane>>2))*P+(wid>>2)*32+(lane&3)*8;
  const unsigned kdst=lds0+LDS_K+wid*1024, vdst=lds0+LDS_V+wid*1024;
  #define TROW(t) (MODE==1?((t)<4?(t)*64:nb0+(t)*64):(t)*64)
  #define DMA_K(t,slot) glds16(ksrc+(long)TROW(t)*P,(unsigned)__builtin_amdgcn_readfirstlane(kdst+(slot)))
  #define DMA_V(t,slot) do{ glds16(vsrc+(long)TROW(t)*P,(unsigned)__builtin_amdgcn_readfirstlane(vdst+(slot)*VSL)); \
    if constexpr(DV2==2) glds16(vsrc+64+(long)TROW(t)*P,(unsigned)__builtin_amdgcn_readfirstlane(vdst+(slot)*VSL+8192)); }while(0)
  const int vb0=(int)(lds0+LDS_V)+((lane>>4)&1)*32+(lane&3)*8+(4*hi+((lane&15)>>2))*64;
  const char*Kbase=shm+LDS_K; bf16x8 kf[8];
  const lds_cptr shm3=(lds_cptr)shm; const lds_cptr kp0=shm3+LDS_K+hi*1024+r32*16; const lds_cptr vp0=shm3+LDS_V+((lane>>4)&1)*32+(lane&3)*8+(4*hi+((lane&15)>>2))*64;
  const int rbase=min(max(gr0-4,0),116), nb0=256+rbase*64-256;
  const int qrow=gr0+(wid>>1), r0q=min(max(qrow-4,0),120), qc=32*(wid&1)+r32, c0q=min(max(qc-8,0),48);
  const int cb=15-qc+4*hi, kvb=4*hi-c0q;
  typedef __attribute__((address_space(3))) float* lds_fptr;
  const lds_fptr btab=(lds_fptr)(shm3+LOST_+NW*4096);
  if constexpr(MODE==1){ if(tid<465) btab[tid]=rpbh[tid]*1.4426950408889634f; }
  if(!pre){DMA_K(0,0);DMA_V(0,0);DMA_K(1,SLOTB);}
  bf16x8 qr[4];
  #pragma unroll
  for(int d0=0;d0<4;++d0)qr[d0]=*reinterpret_cast<const bf16x8*>(&Qw[(long)r32*P+d0*16+hi*8]);
  float l_reg=0.f;f32x16 o[2*DV2];
  #pragma unroll
  for(int i=0;i<2*DV2;++i)o[i]=f32x16{};
  const f32x16 zero16=f32x16{};
  #define CMASK(P0,P1,t) do{ if constexpr(MODE==1){ if((t)>=4){ const int kr_=rbase+(t)-4; const bool rv_=(unsigned)(kr_-r0q)<8u; const lds_fptr bt_=btab+(rv_?(kr_-qrow+7):0)*31+cb; \
      _Pragma("unroll") for(int r=0;r<16;++r){ const int kv_=(r&3)+8*(r>>2); const bool v0_=rv_&&((unsigned)(kv_+kvb)<16u), v1_=rv_&&((unsigned)(kv_+32+kvb)<16u); \
        const float b0_=bt_[kv_], b1_=bt_[kv_+32]; P0[r]=v0_?P0[r]+b0_:-INFINITY; P1[r]=v1_?P1[r]+b1_:-INFINITY; } } } }while(0)
  #define START(P0,P1) do{ _Pragma("unroll") for(int r=0;r<16;++r)P0[r]=__builtin_amdgcn_exp2f(P0[r]); }while(0)
  #define RESC() do{}while(0)
  f32x16 pA0,pA1,pB0,pB1;
  #define WAIT_K1V() do{ if constexpr(DV2==2){WAIT_BAR(3);} else {WAIT_BAR(2);} }while(0)
  #define WAIT_V1() do{ if constexpr(DV2==2){WAIT_BAR(2);} else {WAIT_BAR(1);} }while(0)
  int sl_prev=0,sl_cur=0,sl_next=SLOTB;
  #define ROT() do{sl_prev=sl_cur;sl_cur=sl_next;sl_next=(sl_next==(NSLOT-1)*SLOTB)?0:sl_next+SLOTB;}while(0)
  if(!pre)DMA_K(2,2*SLOTB);
  WAIT_BAR(3);
  qkt(pA0,pA1,Kbase,qr,zero16,r32,hi);asm volatile("s_nop 15\n\ts_nop 7":"+v"(pA0),"+v"(pA1));CMASK(pA0,pA1,0);
  START(pA0,pA1);
  _Pragma("unroll") for(int r=0;r<16;++r)pA1[r]=__builtin_amdgcn_exp2f(pA1[r]);
  WAIT_BAR(0);
  DMA_K(3,0);DMA_V(1,SLOTB);
  ROT();
  kload8(kf,kp0+sl_cur);
  WAIT_K1V();
  s16x4 vlo[8],vhi[8]; u32x4 pw0,pw1,pw2,pw3;
  #define PKW(P,B) cvtpk_s(P[B],P[B+1])
  #define PAF(k) __builtin_bit_cast(bf16x8,pw##k)
  #define VFR(i) (bf16x8){vlo[i][0],vlo[i][1],vlo[i][2],vlo[i][3],vhi[i][0],vhi[i][1],vhi[i][2],vhi[i][3]}
  #define PIN(x) asm volatile("":"+v"(x))
  #define MX3(a,b,c) __builtin_fmaxf(__builtin_fmaxf((a),(b)),(c))
  #define GAPA(MF,A0,A1,A2,A3,W0,W1,PW) do{ MF; sacc+=A0; sacc+=A1; sacc+=A2; sacc+=A3; PIN(sacc); W0; W1; PIN(PW); SBAR(); }while(0)
  #define EX(v) __builtin_amdgcn_exp2f(v)
  #define GAPB(MF,X,B) do{ MF; X[B]=EX(X[B]); X[B+1]=EX(X[B+1]); X[B+2]=EX(X[B+2]); X[B+3]=EX(X[B+3]); PIN(X); SBAR(); }while(0)
  #define VRD(i) do{ vlo[i]=vtr(vp_+(((i)>>2)*4096+((i)&3)*1024)); vhi[i]=vtr(vp_+(((i)>>2)*4096+((i)&3)*1024+512)); }while(0)
  #define KRD(G,j) do{ if(G){ kload2(kf,kp0+sl_next,j); SBAR(); } }while(0)
  #define H1MF(oi,k,i) do{ if constexpr(DV2==2){ o[oi]=__builtin_amdgcn_mfma_f32_32x32x16_bf16(PAF(k),VFR(i),o[oi],0,0,0); } }while(0)
  #define VRDH(i) do{ if constexpr(DV2==2){ vlo[i]=vtr(vp_+(8192+((i)>>2)*4096+((i)&3)*1024)); vhi[i]=vtr(vp_+(8192+((i)>>2)*4096+((i)&3)*1024+512)); } }while(0)
  #define STEP(C0,C1,P0,P1,t,GK,GV,GL) do{ SBAR(); \
    const lds_cptr vp_=vp0+sl_prev*VSL; \
    VRD(0); SBAR(); float sacc=(P0[0]+P0[1]); \
    GAPA(C0=__builtin_amdgcn_mfma_f32_32x32x16_bf16(kf[0],qr[0],zero16,0,0,0), P0[2],P0[3],P0[4],P0[5],     pw0[0]=PKW(P0,0), pw0[1]=PKW(P0,2), pw0); \
    VRD(4); SBAR(); GAPA(C1=__builtin_amdgcn_mfma_f32_32x32x16_bf16(kf[1],qr[0],zero16,0,0,0), P0[6],P0[7],P0[8],P0[9],     pw0[2]=PKW(P0,4), pw0[3]=PKW(P0,6), pw0); \
    VRD(1); SBAR(); GAPA(C0=__builtin_amdgcn_mfma_f32_32x32x16_bf16(kf[2],qr[1],C0,0,0,0),   P0[10],P0[11],P0[12],P0[13], pw1[0]=PKW(P0,8), pw1[1]=PKW(P0,10), pw1); \
    VRD(5); SBAR(); GAPA(C1=__builtin_amdgcn_mfma_f32_32x32x16_bf16(kf[3],qr[1],C1,0,0,0),   P0[14],P0[15],P1[0],P1[1],   pw1[2]=PKW(P0,12),pw1[3]=PKW(P0,14), pw1); \
    VRD(2); SBAR(); GAPA(C0=__builtin_amdgcn_mfma_f32_32x32x16_bf16(kf[4],qr[2],C0,0,0,0),   P1[2],P1[3],P1[4],P1[5],     pw2[0]=PKW(P1,0), pw2[1]=PKW(P1,2), pw2); \
    VRD(6); SBAR(); GAPA(C1=__builtin_amdgcn_mfma_f32_32x32x16_bf16(kf[5],qr[2],C1,0,0,0),   P1[6],P1[7],P1[8],P1[9],     pw2[2]=PKW(P1,4), pw2[3]=PKW(P1,6), pw2); \
    VRD(3); SBAR(); GAPA(C0=__builtin_amdgcn_mfma_f32_32x32x16_bf16(kf[6],qr[3],C0,0,0,0),   P1[10],P1[11],P1[12],P1[13], pw3[0]=PKW(P1,8), pw3[1]=PKW(P1,10), pw3); \
    VRD(7); SBAR(); GAPA(C1=__builtin_amdgcn_mfma_f32_32x32x16_bf16(kf[7],qr[3],C1,0,0,0),   P1[14],P1[15],0.f,0.f,       pw3[2]=PKW(P1,12),pw3[3]=PKW(P1,14), pw3); \
    l_reg+=sacc; \
    if(GK){DMA_K((t)+3,sl_cur);} if(GV){DMA_V((t)+1,sl_next);} \
    CMASK(C0,C1,t); \
    SBAR(); \
    GAPB(o[0]=__builtin_amdgcn_mfma_f32_32x32x16_bf16(PAF(0),VFR(0),o[0],0,0,0); VRDH(0), C0,0); \
    GAPB(o[1]=__builtin_amdgcn_mfma_f32_32x32x16_bf16(PAF(0),VFR(4),o[1],0,0,0); VRDH(4), C0,4); \
    KRD(GL,0); GAPB(o[0]=__builtin_amdgcn_mfma_f32_32x32x16_bf16(PAF(1),VFR(1),o[0],0,0,0); H1MF(2,0,0); VRDH(1), C0,8); \
    KRD(GL,1); GAPB(o[1]=__builtin_amdgcn_mfma_f32_32x32x16_bf16(PAF(1),VFR(5),o[1],0,0,0); H1MF(3,0,4); VRDH(5), C0,12); \
    KRD(GL,2); GAPB(o[0]=__builtin_amdgcn_mfma_f32_32x32x16_bf16(PAF(2),VFR(2),o[0],0,0,0); H1MF(2,1,1); VRDH(2), C1,0); \
    KRD(GL,3); GAPB(o[1]=__builtin_amdgcn_mfma_f32_32x32x16_bf16(PAF(2),VFR(6),o[1],0,0,0); H1MF(3,1,5); VRDH(6), C1,4); \
    GAPB(o[0]=__builtin_amdgcn_mfma_f32_32x32x16_bf16(PAF(3),VFR(3),o[0],0,0,0); H1MF(2,2,2); VRDH(3), C1,8); \
    GAPB(o[1]=__builtin_amdgcn_mfma_f32_32x32x16_bf16(PAF(3),VFR(7),o[1],0,0,0); H1MF(3,2,6); VRDH(7), C1,12); \
    if constexpr(DV2==2){ H1MF(2,3,3); H1MF(3,3,7); SBAR(); } \
    }while(0)
  int t=1;
  for(;t+5<NT;t+=2){
    STEP(pB0,pB1,pA0,pA1,t,true,true,true);     WAIT_K1V(); RESC(); ROT();
    STEP(pA0,pA1,pB0,pB1,t+1,true,true,true);   WAIT_K1V(); RESC(); ROT();
  }
  #define ENDW(tt) do{ if((tt)+3<NT){WAIT_K1V();} else if((tt)+2<NT){WAIT_V1();} else {WAIT_BAR(0);} }while(0)
  for(;t+1<NT;t+=2){
    STEP(pB0,pB1,pA0,pA1,t,(t+3<NT),(t+1<NT),(t+1<NT));       ENDW(t);   RESC(); ROT();
    STEP(pA0,pA1,pB0,pB1,t+1,(t+4<NT),(t+2<NT),(t+2<NT));     ENDW(t+1); RESC(); ROT();
  }
  STEP(pB0,pB1,pA0,pA1,NT-1,false,false,false); RESC();
  { float sacc=pB0[0]+pB0[1]; _Pragma("unroll") for(int r=2;r<16;++r)sacc+=pB0[r]; _Pragma("unroll") for(int r=0;r<16;++r)sacc+=pB1[r]; l_reg+=sacc;
    pw0=(u32x4){PKW(pB0,0),PKW(pB0,2),PKW(pB0,4),PKW(pB0,6)};pw1=(u32x4){PKW(pB0,8),PKW(pB0,10),PKW(pB0,12),PKW(pB0,14)};pw2=(u32x4){PKW(pB1,0),PKW(pB1,2),PKW(pB1,4),PKW(pB1,6)};pw3=(u32x4){PKW(pB1,8),PKW(pB1,10),PKW(pB1,12),PKW(pB1,14)};
    SBAR(); pv(o,vb0+sl_cur*VSL,PAF(0),PAF(1),PAF(2),PAF(3)); if constexpr(DV2==2) pv(o+2,vb0+sl_cur*VSL+8192,PAF(0),PAF(1),PAF(2),PAF(3)); }
  #undef PKW
  #undef PAF
  #undef VFR
  #undef PIN
  #undef MX3
  #undef GAPA
  #undef GAPB
  #undef EX
  #undef VRD
  #undef KRD
  #undef STEP
  #undef ENDW
  asm volatile("s_waitcnt lgkmcnt(0)\n\ts_barrier":::"memory");
  if(has_next){ const bf16*ksn=Khn+(long)lane*P+wid*8; const bf16*vsn=Vhn+(long)(16*(wid&3)+(lane>>2))*P+(wid>>2)*32+(lane&3)*8;
    glds16(ksn,(unsigned)__builtin_amdgcn_readfirstlane(kdst)); glds16(vsn,(unsigned)__builtin_amdgcn_readfirstlane(vdst));
    if constexpr(DV2==2) glds16(vsn+64,(unsigned)__builtin_amdgcn_readfirstlane(vdst+8192));
    glds16(ksn+(long)64*P,(unsigned)__builtin_amdgcn_readfirstlane(kdst+SLOTB)); glds16(ksn+(long)128*P,(unsigned)__builtin_amdgcn_readfirstlane(kdst+2*SLOTB)); }
  {auto rr=__builtin_amdgcn_permlane32_swap(__float_as_uint(l_reg),__float_as_uint(l_reg),false,false);l_reg=__uint_as_float(rr[0])+__uint_as_float(rr[1]);}
  if(hi==0)wsf[32+r32]=l_reg;asm volatile("s_waitcnt lgkmcnt(0)":::"memory");
  float rli[16];
  #pragma unroll
  for(int r=0;r<16;++r)rli[r]=__builtin_amdgcn_rcpf(wsf[32+crow(r,hi)]);
  bf16*Ow=O0+(long)(wid*QBLK)*OP;
  { bf16*stg=(bf16*)(shm+LOST_)+wid*2048;
    #pragma unroll
    for(int hh=0;hh<DV2;++hh){
      #pragma unroll
      for(int r=0;r<16;++r){const int orow=crow(r,hi);
        #pragma unroll
        for(int d0=0;d0<2;++d0)stg[orow*64+d0*32+r32]=__float2bfloat16(o[2*hh+d0][r]*rli[r]);}
      asm volatile("s_waitcnt lgkmcnt(0)":::"memory");
      #pragma unroll
      for(int i=0;i<4;++i){const int row=i*8+(lane>>3),ch=lane&7; const u32x4 v=*(const u32x4*)(stg+row*64+ch*8); ATTN_STORE16(Ow+(long)row*OP+hh*64+ch*8,v);}
      asm volatile("s_waitcnt lgkmcnt(0)":::"memory"); } }
  asm volatile("s_waitcnt lgkmcnt(0)\n\ts_barrier":::"memory");
  #undef DMA_K
  #undef DMA_V
  #undef CMASK
  #undef START
  #undef RESC
  #undef ROT
  #undef TROW
  #undef WAIT_K1V
  #undef WAIT_V1
  #undef VRDH
  #undef H1MF
}

#undef SBAR
#undef WAIT_BAR
}

constexpr int NWAVES = 8;
#ifndef DBGZ
#define DBGZ 0
#endif
#ifndef MK_PER_PHASE
#define MK_PER_PHASE 0
#endif

constexpr int NB = 8, TL = 8192, CL = 256, RPB = TL + CL  , MT = NB * RPB  , DM = 1024;
constexpr int N_IN0 = 2560, N_IN1 = 2304, N_WQ = 2048, OD_P = 1536;
constexpr float EPS = 1e-6f, LOG2E = 1.4426950408889634f, QSCALE = 0.125f * 1.4426950408889634f;
constexpr int PH_PER_LAYER = 10, N_PHASES = 1 + 2 * PH_PER_LAYER;

constexpr size_t MiB = 1u << 20;
constexpr size_t WS_CTL = 0, CTL_ZERO_BYTES = 1 * MiB;
constexpr size_t WS_MOD = 1 * MiB;
constexpr size_t WS_ROPE = 2 * MiB;
constexpr size_t WS_WIN0 = 3 * MiB, WS_WOUT0 = 8 * MiB, WS_WQ0 = 10 * MiB, WS_WIN1 = 14 * MiB, WS_WOUT1 = 19 * MiB, WS_WQ1 = 21 * MiB;
constexpr size_t WS_KEYS0 = 25 * MiB, WS_KEYS1 = 25 * MiB + 512 * 1024;
constexpr size_t WS_U0 = 32 * MiB, WS_U1 = 64 * MiB;
constexpr float U_SCALE = 64.f, V_SCALE = 4.f;
constexpr size_t WS_XS = 160 * MiB;
constexpr size_t WS_XN = 424 * MiB;
constexpr size_t WS_PB = 556 * MiB;
constexpr size_t WS_EI = WS_PB + 264 * MiB, WS_EG = WS_EI + 33 * MiB;
constexpr size_t WS_END = 886 * MiB;
static_assert((size_t)MT * 1024 * 4 == 264 * MiB && (size_t)MT * 2560 * 2 == 330 * MiB && (size_t)MT * 128 * 4 == 33 * MiB, "ws map");
constexpr int CW_TMO = 0, CW_BAR = 4096;

constexpr int RING_BYTES = 131072, LDSCTL_OFF = RING_BYTES, MISC_OFF = LDSCTL_OFF + 320, LDS_BYTES = 147456;

#define GAS __attribute__((address_space(1)))
#define LAS __attribute__((address_space(3)))
typedef unsigned short bf16;
typedef unsigned v4u __attribute__((ext_vector_type(4)));
typedef unsigned v2u __attribute__((ext_vector_type(2)));
typedef float f32x4 __attribute__((ext_vector_type(4)));
typedef float f32x16 __attribute__((ext_vector_type(16)));
typedef short bf16x8 __attribute__((ext_vector_type(8)));
typedef __bf16 bf16x2v __attribute__((ext_vector_type(2)));
typedef GAS unsigned gu32;
#define RLX_AGENT __ATOMIC_RELAXED, __HIP_MEMORY_SCOPE_AGENT
__device__ __forceinline__ unsigned f2bf(float f) { unsigned u = __builtin_bit_cast(unsigned, f); return (u + 0x7fffu + ((u >> 16) & 1u)) >> 16; }
__device__ __forceinline__ unsigned pk2(float lo, float hi) { return f2bf(lo) | (f2bf(hi) << 16); }
__device__ __forceinline__ float bflo(unsigned u) { return __builtin_bit_cast(float, u << 16); }
__device__ __forceinline__ float bfhi(unsigned u) { return __builtin_bit_cast(float, u & 0xffff0000u); }
__device__ __forceinline__ float bf1(bf16 h) { return __builtin_bit_cast(float, (unsigned)h << 16); }
__device__ __forceinline__ float wave_sum(float v) {
#pragma unroll
    for (int o = 1; o < 64; o <<= 1) v += __shfl_xor(v, o);
    return v;
}
__device__ __forceinline__ float dot2bf(unsigned w, unsigned x, float acc) { return __builtin_amdgcn_fdot2_f32_bf16(__builtin_bit_cast(bf16x2v, w), __builtin_bit_cast(bf16x2v, x), acc, false); }
__device__ __forceinline__ float fast_exp2(float x) { return __builtin_amdgcn_exp2f(x); }
__device__ __forceinline__ float gelu_erf(float v) {
    const float av = fabsf(v), t = __builtin_amdgcn_rcpf(av * 0.2316418882f + 1.0f);
    float q = t * 0.5307027145f + (-0.7265760135f); q = q * t + 0.7107068705f; q = q * t + (-0.142248368f); q = q * t + 0.127414796f; q = q * t;
    const float e = __builtin_amdgcn_exp2f((v * v) * (-0.72134752044f));
    const float m = v * (q * e);
    return v < 0.f ? m : v - m;
}

#define XB_TMO      128
#define XB_XCNT(j)  (256  + 64 * (j))
#define XB_XSUB(j)  (1280 + 64 * (j))
#define XB_XGEN(j)  (2304 + 64 * (j))
#define XB_TOP      3328
#define XB_TOPGEN   3392
#define XCD_BAR_WORDS 3456
#define XB_SPIN_CAP (1u << 18)

__device__ __forceinline__ unsigned xb_ld(unsigned* p)              { return __hip_atomic_load(p, __ATOMIC_RELAXED, __HIP_MEMORY_SCOPE_AGENT); }
__device__ __forceinline__ unsigned xb_add(unsigned* p, unsigned v) { return __hip_atomic_fetch_add(p, v, __ATOMIC_RELAXED, __HIP_MEMORY_SCOPE_AGENT); }
__device__ __forceinline__ unsigned xb_xcc_id() { return (unsigned)__builtin_amdgcn_s_getreg((3 << 11) | 20) & 0xFu; }
#define XB_SPIN(cond, bar) do { unsigned _sp = 0; while (cond) { __builtin_amdgcn_s_sleep(1); \
    if ((++_sp & 255u) == 0u) { if (xb_ld(&(bar)[XB_TMO])) break; if (_sp > XB_SPIN_CAP) { atomicAdd(&(bar)[XB_TMO], 1u); break; } } } } while (0)

struct XcdBarrier {
    unsigned* bar; unsigned x;
    volatile LAS unsigned* st;
};

__device__ __forceinline__ XcdBarrier xcd_barrier_post(unsigned* bar, volatile LAS unsigned* st) {
    XcdBarrier b; b.bar = bar; b.x = xb_xcc_id(); b.st = st;
    if (threadIdx.x == 0) (void)xb_add(&bar[XB_XCNT(b.x)], 1u);
    return b;
}
__device__ __forceinline__ void xcd_barrier_complete(unsigned* bar, unsigned x, unsigned& nloc, unsigned& nx) {
    const unsigned G = gridDim.x * gridDim.y * gridDim.z;
    unsigned sum, cnt, mine, sp = 0u;
    for (;;) {
        sum = 0u; cnt = 0u; mine = 0u;
#pragma unroll
        for (unsigned j = 0; j < 16; ++j) { const unsigned c = xb_ld(&bar[XB_XCNT(j)]); sum += c; cnt += (c > 0u) ? 1u : 0u; mine = (j == x) ? c : mine; }
        if (sum == G) break;
        __builtin_amdgcn_s_sleep(1);
        if ((++sp & 255u) == 0u) { if (xb_ld(&bar[XB_TMO])) break; if (sp > XB_SPIN_CAP) { atomicAdd(&bar[XB_TMO], 1u); break; } }
    }
    nloc = mine > 0u ? mine : 1u; nx = cnt > 0u ? cnt : 1u;
}

__device__ __forceinline__ void xcd_barrier(const XcdBarrier& b) {
    asm volatile("s_waitcnt vmcnt(0)" ::: "memory");
    __syncthreads();
    if (threadIdx.x == 0) {
        unsigned* bar = b.bar;
        __builtin_amdgcn_s_waitcnt(0);
        unsigned nloc = b.st[0], nx = b.st[1];
        if (nloc == 0u) { xcd_barrier_complete(bar, b.x, nloc, nx); b.st[0] = nloc; b.st[1] = nx; }
        const unsigned old = xb_add(&bar[XB_XSUB(b.x)], 1u);
        const unsigned gen = old / nloc;
        if (old + 1u == (gen + 1u) * nloc) {
            __builtin_amdgcn_fence(__ATOMIC_RELEASE, "agent");
            asm volatile("s_waitcnt vmcnt(0)" ::: "memory");
            const unsigned og = xb_add(&bar[XB_TOP], 1u);
            const unsigned tg = og / nx;
            if (og + 1u == (tg + 1u) * nx) xb_add(&bar[XB_TOPGEN], 1u);
            else XB_SPIN(xb_ld(&bar[XB_TOPGEN]) == tg, bar);
            __builtin_amdgcn_fence(__ATOMIC_ACQUIRE, "agent");
            xb_add(&bar[XB_XGEN(b.x)], 1u);
            asm volatile("s_waitcnt vmcnt(0)" ::: "memory");
        } else {
            XB_SPIN(xb_ld(&bar[XB_XGEN(b.x)]) == gen, bar);
            __builtin_amdgcn_fence(__ATOMIC_ACQUIRE, "agent");
            asm volatile("s_waitcnt vmcnt(0)" ::: "memory");
        }
    }
    __syncthreads();
}


struct Frame {
    LAS unsigned char* lds;
    gu32* ctl;
    int tid, lane, wave, vcu, G, gw, NGW;
};

struct Args { const float* in[38]; float* out; unsigned char* ws; int ph_lo, ph_hi, li, pad; };

__device__ __forceinline__ void p0_transpose_item(const float* W, int K, int N, bf16* WT, LAS float* scr, int item, int lane) {
    const int nblk = N / 32, kb = item / nblk, nb = item % nblk, k0 = 64 * kb, n0 = 32 * nb;
#pragma unroll 8
    for (int i = 0; i < 32; ++i) { const int kk = 2 * i + (lane >> 5); scr[kk * 33 + (lane & 31)] = W[(size_t)(k0 + kk) * N + n0 + (lane & 31)]; }
    asm volatile("s_waitcnt lgkmcnt(0)" ::: "memory");
    const int c = lane & 7;
#pragma unroll
    for (int j = 0; j < 4; ++j) { const int n = (lane >> 3) + 8 * j; const LAS float* s = scr + (8 * c) * 33 + n;
        v4u o; o.x = pk2(s[0 * 33], s[1 * 33]); o.y = pk2(s[2 * 33], s[3 * 33]); o.z = pk2(s[4 * 33], s[5 * 33]); o.w = pk2(s[6 * 33], s[7 * 33]);
        *(v4u*)(WT + (size_t)(n0 + n) * K + k0 + 8 * c) = o; }
    asm volatile("s_waitcnt lgkmcnt(0)" ::: "memory");
}
__device__ __forceinline__ void cvt_bf16_stream(const float* src, bf16* dst, size_t n, int gtid, int nthr) {
    for (size_t i = (size_t)gtid * 8; i < n; i += (size_t)nthr * 8) {
        const f32x4 a = *(const f32x4*)(src + i), b = *(const f32x4*)(src + i + 4);
        v4u o; o.x = pk2(a.x, a.y); o.y = pk2(a.z, a.w); o.z = pk2(b.x, b.y); o.w = pk2(b.z, b.w);
        *(v4u*)(dst + i) = o; }
}
__device__ __forceinline__ unsigned enc8_fp4(const float* p, float sc) {
    const f32x4 a = *(const f32x4*)p, b = *(const f32x4*)(p + 4);
    unsigned r = 0;
    r = __builtin_amdgcn_cvt_scalef32_pk_fp4_f32(r, a.x * sc, a.y * sc, 1.0f, 0); r = __builtin_amdgcn_cvt_scalef32_pk_fp4_f32(r, a.z * sc, a.w * sc, 1.0f, 1);
    r = __builtin_amdgcn_cvt_scalef32_pk_fp4_f32(r, b.x * sc, b.y * sc, 1.0f, 2); r = __builtin_amdgcn_cvt_scalef32_pk_fp4_f32(r, b.z * sc, b.w * sc, 1.0f, 3);
    return r; }
__device__ __forceinline__ void cvt_fp4_uv(const float* u, const float* v, unsigned char* dst, int gtid, int nthr) {
#pragma unroll 4
    for (size_t i = (size_t)gtid * 8; i < (size_t)16384 * 1024; i += (size_t)nthr * 8) {
        unsigned char* rowp = dst + (i >> 10) * 1024 + ((i & 1023) >> 1);
        *(unsigned*)rowp = enc8_fp4(u + i, U_SCALE); *(unsigned*)(rowp + 512) = enc8_fp4(v + i, V_SCALE); }
}
__device__ __forceinline__ void sincos_small(double x, double& s, double& c) {
    const double n = __builtin_rint(x * 0.63661977236758134308);
    double r = __builtin_fma(-n, 1.57079632679489655800e+00, x); r = __builtin_fma(-n, 6.12323399573676603587e-17, r);
    const int q = (int)n & 3; const double r2 = r * r;
    const double sp = r * (1.0 + r2 * (-1.0 / 6 + r2 * (1.0 / 120 + r2 * (-1.0 / 5040 + r2 * (1.0 / 362880 + r2 * (-1.0 / 39916800 + r2 * (1.0 / 6227020800.0)))))));
    const double cp = 1.0 + r2 * (-0.5 + r2 * (1.0 / 24 + r2 * (-1.0 / 720 + r2 * (1.0 / 40320 + r2 * (-1.0 / 3628800 + r2 * (1.0 / 479001600 + r2 * (-1.0 / 87178291200.0)))))));
    s = (q == 0) ? sp : (q == 1) ? cp : (q == 2) ? -sp : -cp;
    c = (q == 0) ? cp : (q == 1) ? -sp : (q == 2) ? -cp : sp;
}
__device__ __forceinline__ float inv_freq(int i) {
    const float t[16] = {1.0f, 0.5623413251903491f, 0.31622776601683794f, 0.17782794100389228f, 0.1f, 0.05623413251903491f, 0.031622776601683794f, 0.017782794100389228f,
                         0.01f, 0.005623413251903491f, 0.0031622776601683794f, 0.0017782794100389228f, 0.001f, 0.0005623413251903491f, 0.00031622776601683794f, 0.00017782794100389228f};
    float r = t[0];
#pragma unroll
    for (int k = 1; k < 16; ++k) r = (i == k) ? t[k] : r;
    return r;
}
__device__ __forceinline__ void p0_prologue(const Frame& F, const Args& A) {
    unsigned char* ws = A.ws;
    LAS float* sil = (LAS float*)F.lds;
    for (int i = F.tid; i < 9 * 1024; i += NWAVES * 64) { const int r = i >> 10, k = i & 1023; const float cv = r < 8 ? A.in[1][r * 1024 + k] : A.in[3][k]; sil[i] = cv / (1.0f + fast_exp2(-cv * LOG2E)); }
    __syncthreads();
    LAS float* part = (LAS float*)(F.lds + 110592);
    if (F.vcu < 192) {
        const int layer = F.vcu / 96, col = (F.vcu % 96) * 64 + F.lane;
        const float* W = A.in[layer ? 23 : 4];
        float acc[9];
#pragma unroll
        for (int r = 0; r < 9; ++r) acc[r] = 0.f;
#pragma unroll 1
        for (int k = F.wave * 128; k < F.wave * 128 + 128; k += 16) {
            const float* wk = W + (size_t)k * 6144;
            float w[16];
#pragma unroll
            for (int i = 0; i < 16; ++i) w[i] = wk[(unsigned)(col + i * 6144)];
#pragma unroll
            for (int i = 0; i < 16; i += 4) {
#pragma unroll
                for (int r = 0; r < 9; ++r) { const f32x4 s4 = *(const LAS f32x4*)(sil + r * 1024 + k + i); acc[r] += (s4.x * w[i] + s4.y * w[i + 1]) + (s4.z * w[i + 2] + s4.w * w[i + 3]); }
                __builtin_amdgcn_sched_barrier(0); }
        }
#pragma unroll
        for (int r = 0; r < 9; ++r) part[(F.wave * 9 + r) * 64 + F.lane] = acc[r];
    }
    __syncthreads();
    if (F.vcu < 192 && F.wave == 0) {
        const int layer = F.vcu / 96, col = (F.vcu % 96) * 64 + F.lane;
        const float* bb = A.in[layer ? 24 : 5];
        float* MOD = (float*)(ws + WS_MOD);
#pragma unroll
        for (int r = 0; r < 9; ++r) { float t = bb[col];
#pragma unroll
            for (int w = 0; w < 8; ++w) t += part[(w * 9 + r) * 64 + F.lane];
            MOD[(size_t)(layer * 9 + r) * 6144 + col] = t; }
    }
    { const int g = F.vcu * (NWAVES * 64) + F.tid;
      if (g < 2048) { const int pos = g >> 4, i = g & 15; const float ang = (float)pos * inv_freq(i); double s, c; sincos_small((double)ang, s, c);
          float* RT = (float*)(ws + WS_ROPE); RT[g] = (float)c; RT[2048 + g] = (float)s; } }
    { const int g = F.vcu * (NWAVES * 64) + F.tid;
      if (g < 512) { const int layer = g >> 8, j = (g >> 6) & 3, i = g & 63; const int src = layer ? 29 + j : (j == 0 ? 12 : 13);
          ((float*)(ws + WS_ROPE))[4096 + g] = (layer == 0 && j >= 2) ? 1.0f : A.in[src][i]; } }
    { LAS float* scr = (LAS float*)(F.lds + 40960 + F.wave * 8704);
      constexpr int I0 = 16 * (N_IN0 / 32), I1 = 16 * 32, I2 = 16 * (N_WQ / 32), I3 = 16 * (N_IN1 / 32);
      constexpr int NIT = I0 + I1 + I2 + I3 + I1 + I2;
      for (int it = F.gw; it < NIT; it += F.NGW) {
          int r = it;
          if (r < I0) { p0_transpose_item(A.in[8], 1024, N_IN0, (bf16*)(ws + WS_WIN0), scr, r, F.lane); continue; } r -= I0;
          if (r < I1) { p0_transpose_item(A.in[9], 1024, 1024, (bf16*)(ws + WS_WOUT0), scr, r, F.lane); continue; } r -= I1;
          if (r < I2) { p0_transpose_item(A.in[19], 1024, N_WQ, (bf16*)(ws + WS_WQ0), scr, r, F.lane); continue; } r -= I2;
          if (r < I3) { p0_transpose_item(A.in[27], 1024, N_IN1, (bf16*)(ws + WS_WIN1), scr, r, F.lane); continue; } r -= I3;
          if (r < I1) { p0_transpose_item(A.in[28], 1024, 1024, (bf16*)(ws + WS_WOUT1), scr, r, F.lane); continue; } r -= I1;
          p0_transpose_item(A.in[34], 1024, N_WQ, (bf16*)(ws + WS_WQ1), scr, r, F.lane);
      } }
    { const int gt = F.vcu * (NWAVES * 64) + F.tid, nt = F.G * NWAVES * 64;
      cvt_bf16_stream(A.in[20], (bf16*)(ws + WS_KEYS0), (size_t)8 * 2 * 128 * 128, gt, nt);
      cvt_bf16_stream(A.in[35], (bf16*)(ws + WS_KEYS1), (size_t)8 * 2 * 128 * 128, gt, nt);
      cvt_fp4_uv(A.in[21], A.in[22], ws + WS_U0, gt, nt);
      cvt_fp4_uv(A.in[36], A.in[37], ws + WS_U1, gt, nt); }
}

template <bool FROM_INPUT> __device__ __forceinline__ void norm_mod_phase(const Frame& F, const float* x, const float* ctx, const bf16* XS, const float* gain, const float* sh, const float* sc, bf16* dst, bool lat_only) {
    for (int row = F.gw; row < MT; row += F.NGW) {
        const int b = row / RPB, r = row - b * RPB; const bool cr = r < CL; if (lat_only && cr) continue;
        const int mr = cr ? 8 : b;
        const float* xr = cr ? ctx + ((size_t)b * CL + r) * DM : x + ((size_t)b * TL + (r - CL)) * DM;
        f32x4 v[4]; float s = 0.f;
#pragma unroll
        for (int j = 0; j < 4; ++j) {
            if (FROM_INPUT) v[j] = *(const f32x4*)(xr + 4 * F.lane + 256 * j);
            else { const v2u w = *(const v2u*)(XS + (size_t)row * DM + 4 * F.lane + 256 * j); v[j] = (f32x4){bflo(w.x), bfhi(w.x), bflo(w.y), bfhi(w.y)}; }
            s += (v[j].x * v[j].x + v[j].y * v[j].y) + (v[j].z * v[j].z + v[j].w * v[j].w); }
        const float rs = __builtin_amdgcn_rsqf(wave_sum(s) * (1.f / DM) + EPS);
#pragma unroll
        for (int j = 0; j < 4; ++j) { const int col = 4 * F.lane + 256 * j;
            const f32x4 g = *(const f32x4*)(gain + col), a = *(const f32x4*)(sc + (size_t)mr * 6144 + col), h = *(const f32x4*)(sh + (size_t)mr * 6144 + col);
            const f32x4 y = v[j] * rs * g * (a + 1.0f) + h;
            v2u o; o.x = pk2(y.x, y.y); o.y = pk2(y.z, y.w);
            *(v2u*)(dst + (size_t)row * DM + col) = o; }
    }
}

__device__ __forceinline__ void l0_headnorm_pool_phase(const Frame& F, const Args& A, bf16* PB, bf16* Y, const float* RT) {
    LAS float* wl = (LAS float*)F.lds;
    for (int i = F.tid; i < 4 * 64 * 64; i += NWAVES * 64) wl[i] = A.in[10][i];
    __syncthreads();
    const float* pscale = A.in[11];
    {
        const int l = F.lane, g = l >> 4, hw = 1 << g, d0 = 4 * (l & 15);
        LAS float* ps = (LAS float*)(F.lds + 65536) + F.wave * 256;
        const f32x4 sc4 = *(const f32x4*)(pscale + 4 * l);
        for (int row = F.gw; row < MT; row += F.NGW) {
            const int b = row / RPB, r = row - b * RPB; const bool lat = r >= CL;
            const int pos = lat ? r - CL : r, L = lat ? TL : CL; const size_t segbase = (size_t)b * RPB + (lat ? CL : 0);
            v2u raw[16];
#pragma unroll
            for (int k = 0; k < 16; ++k) { const int p = pos + k - 8; const int pc = min(max(p, 0), L - 1); raw[k] = *(const v2u*)(PB + (segbase + pc) * N_IN0 + 4 * l); }
            f32x4 sum = {0.f, 0.f, 0.f, 0.f};
#pragma unroll
            for (int k = 0; k < 16; ++k) { const int dp = k - 8, p = pos + dp; const bool use = dp >= -hw && dp < hw && p >= 0 && p < L;
                const f32x4 v = {bflo(raw[k].x), bfhi(raw[k].x), bflo(raw[k].y), bfhi(raw[k].y)}; sum = use ? sum + v : sum; }
            const f32x4 self = {bflo(raw[8].x), bfhi(raw[8].x), bflo(raw[8].y), bfhi(raw[8].y)};
            const float rc = 1.0f / (float)(min(pos + hw, L) - max(pos - hw, 0));
            const f32x4 pv = sum * rc - self;
            *(LAS f32x4*)(ps + 4 * l) = pv;
            f32x4 y = {0.f, 0.f, 0.f, 0.f};
#pragma unroll 4
            for (int c = 0; c < 64; c += 4) { const f32x4 p4 = *(const LAS f32x4*)(ps + g * 64 + c);
                const LAS float* wp = wl + (g * 64 + c) * 64 + d0;
                y += p4.x * *(const LAS f32x4*)(wp) + p4.y * *(const LAS f32x4*)(wp + 64) + p4.z * *(const LAS f32x4*)(wp + 128) + p4.w * *(const LAS f32x4*)(wp + 192); }
            y = y * sc4;
            v2u o; o.x = pk2(y.x, y.y); o.y = pk2(y.z, y.w);
            if (DBGZ & 1) { o.x = 0u; o.y = 0u; }
            *(v2u*)(Y + (size_t)row * DM + 4 * l) = o;
        }
    }
    __syncthreads();
}

__device__ __forceinline__ void l0_diff_combine_phase(const Frame& F, const Args& A, const bf16* OD, bf16* Y) {
    const float s1 = wave_sum(A.in[14][F.lane] * A.in[15][F.lane]), s2 = wave_sum(A.in[16][F.lane] * A.in[17][F.lane]);
    const float lam = fast_exp2(s1 * LOG2E) - fast_exp2(s2 * LOG2E) + 0.2f;
    const int l32 = F.lane & 31;
    const f32x4 sub = *(const f32x4*)(A.in[18] + 4 * l32);
    for (int row = F.gw; row < MT; row += F.NGW) {
#pragma unroll
        for (int pass = 0; pass < 3; ++pass) { const int h = pass * 2 + (F.lane >> 5);
            const v2u a = *(const v2u*)(OD + (size_t)row * OD_P + (2 * h) * 128 + 4 * l32), c = *(const v2u*)(OD + (size_t)row * OD_P + (2 * h + 1) * 128 + 4 * l32);
            f32x4 o; o.x = bflo(a.x) - lam * bflo(c.x); o.y = bfhi(a.x) - lam * bfhi(c.x); o.z = bflo(a.y) - lam * bflo(c.y); o.w = bfhi(a.y) - lam * bfhi(c.y);
            float ss = (o.x * o.x + o.y * o.y) + (o.z * o.z + o.w * o.w);
            ss += __shfl_xor(ss, 1); ss += __shfl_xor(ss, 2); ss += __shfl_xor(ss, 4); ss += __shfl_xor(ss, 8); ss += __shfl_xor(ss, 16);
            const float rs = __builtin_amdgcn_rsqf(ss * (1.f / 128) + EPS) * 0.8f;
            v2u w; w.x = pk2(o.x * rs * sub.x, o.y * rs * sub.y); w.y = pk2(o.z * rs * sub.z, o.w * rs * sub.w);
            if (DBGZ & 2) { w.x = 0u; w.y = 0u; }
            *(v2u*)(Y + (size_t)row * DM + 256 + h * 128 + 4 * l32) = w; }
    }
}

constexpr int NCAND = 50;
__device__ __forceinline__ void ce_desc(float& a, float& b) {
    float hi_, lo_; asm("v_max_f32 %0, %2, %3\n\tv_min_f32 %1, %2, %3" : "=&v"(hi_), "=&v"(lo_) : "v"(a), "v"(b)); a = hi_; b = lo_; }
__device__ __forceinline__ float fmax_raw(float a, float b) { float r; asm("v_max_f32 %0, %1, %2" : "=v"(r) : "v"(a), "v"(b)); return r; }
template <int N, int OFF, int NTOT> __device__ __forceinline__ void bitonic_sort_desc(float (&v)[NTOT]) {
#pragma unroll
    for (int k = 2; k <= N; k <<= 1)
#pragma unroll
        for (int j = k >> 1; j > 0; j >>= 1)
#pragma unroll
            for (int i = 0; i < N; ++i) { const int l = i ^ j; if (l > i) { if ((i & k) == 0) ce_desc(v[OFF + i], v[OFF + l]); else ce_desc(v[OFF + l], v[OFF + i]); } }
}
template <int OFF, int NTOT> __device__ __forceinline__ void bitonic_merge16_desc(float (&v)[NTOT]) {
#pragma unroll
    for (int j = 8; j > 0; j >>= 1)
#pragma unroll
        for (int i = 0; i < 16; ++i) { const int l = i ^ j; if (l > i) ce_desc(v[OFF + i], v[OFF + l]); }
}
template <int A, int B, int NTOT> __device__ __forceinline__ void top16_merge(float (&v)[NTOT]) {
#pragma unroll
    for (int i = 0; i < 16; ++i) v[A + i] = fmax_raw(v[A + i], v[B + 15 - i]);
    bitonic_merge16_desc<A, NTOT>(v);
}
__device__ __forceinline__ void partner_top16(float (&t)[16], bool hi) {
    float a[16];
#pragma unroll
    for (int i = 0; i < 16; ++i) a[i] = hi ? t[15 - i] : t[i];
#pragma unroll
    for (int i = 0; i < 16; ++i) { const auto rr = __builtin_amdgcn_permlane32_swap(__builtin_bit_cast(unsigned, a[i]), __builtin_bit_cast(unsigned, a[i]), false, false);
        const unsigned r0_ = rr[0], r1_ = rr[1];
        t[i] = fmax_raw(__builtin_bit_cast(float, r0_), __builtin_bit_cast(float, r1_)); }
    bitonic_merge16_desc<0, 16>(t);
}
template <bool KL> __device__ __forceinline__ void topk_task(const Frame& F, const bf16* QP, const bf16* KEYS, const LAS unsigned char* klds, LAS unsigned short* kt, int* EI, float* EG, const int R0, const int h) {
    const int tk = F.lane & 31, hi = F.lane >> 5;
    const float neg_inf = -INFINITY;
    {
        float sv[2][16];
        unsigned koff = (unsigned)(tk * 128 + hi * 8), qoff = (unsigned)(tk * N_WQ + hi * 8);
        asm volatile("" : "+v"(koff), "+v"(qoff));
        const bf16* qp0 = QP + (size_t)R0 * N_WQ + (2 * h) * 128 + qoff;
        const bf16* kp0 = KEYS + ((size_t)(h * 2) * 128) * 128 + koff;
        const LAS unsigned char* kl0 = klds + tk * 272 + hi * 16;
        bf16x8 qf[8], kf[2][8];
#pragma unroll
        for (int ks = 0; ks < 8; ++ks) qf[ks] = *(const bf16x8*)(qp0 + ks * 16);
#pragma unroll
        for (int ks = 0; ks < 8; ++ks) kf[0][ks] = KL ? *(const LAS bf16x8*)(kl0 + ks * 32) : *(const bf16x8*)(kp0 + ks * 16);
        float v[64];
#pragma unroll
        for (int st = 0; st < 8; ++st) { const int p = st >> 2, kb = st & 3;
            if (st < 7) {
#pragma unroll
                for (int ks = 0; ks < 8; ++ks) kf[(st + 1) & 1][ks] = KL ? *(const LAS bf16x8*)(kl0 + (st + 1) * 32 * 272 + ks * 32) : *(const bf16x8*)(kp0 + (size_t)(st + 1) * 32 * 128 + ks * 16); }
            if (!KL) asm volatile("" ::: "memory");
            f32x16 acc = {};
#pragma unroll
            for (int ks = 0; ks < 8; ++ks) acc = __builtin_amdgcn_mfma_f32_32x32x16_bf16(kf[st & 1][ks], qf[ks], acc, 0, 0, 0);
#pragma unroll
            for (int rg = 0; rg < 16; ++rg) { const unsigned key = (unsigned)(kb * 32 + (rg & 3) + 8 * (rg >> 2)) + 4u * (unsigned)hi;
                const float av = acc[rg];
                v[kb * 16 + rg] = __builtin_bit_cast(float, (__builtin_bit_cast(unsigned, av) & ~127u) | key); }
            if (st == 3) {
#pragma unroll
                for (int ks = 0; ks < 8; ++ks) qf[ks] = *(const bf16x8*)(qp0 + 128 + ks * 16); }
            __builtin_amdgcn_sched_barrier(0);
            if (kb == 0) bitonic_sort_desc<16, 0, 64>(v); else if (kb == 1) bitonic_sort_desc<16, 16, 64>(v); else if (kb == 2) bitonic_sort_desc<16, 32, 64>(v); else bitonic_sort_desc<16, 48, 64>(v);
            if (kb == 3) {
                top16_merge<0, 16, 64>(v); top16_merge<32, 48, 64>(v); top16_merge<0, 32, 64>(v);
                float t[16];
#pragma unroll
                for (int i = 0; i < 16; ++i) t[i] = v[i];
                partner_top16(t, hi != 0);
#pragma unroll
                for (int i = 0; i < 16; ++i) sv[p][i] = t[i];
                __builtin_amdgcn_sched_barrier(0);
            }
        }
        float cv[32];
        {
            int n = 0;
#pragma unroll
            for (int i = 0; i < 16; ++i)
#pragma unroll
                for (int j = 0; j < 16; ++j) if ((i + 1) * (j + 1) <= 16) {
                    const float sum = sv[0][i] + sv[1][j];
                    const float c = __builtin_bit_cast(float, (__builtin_bit_cast(unsigned, sum) & ~255u) | (unsigned)(i * 16 + j));
                    if (n < 25) cv[n] = c; else cv[n - 25] = hi ? c : cv[n - 25];
                    ++n; }
#pragma unroll
            for (int k = 25; k < 32; ++k) cv[k] = neg_inf;
        }
#pragma unroll
        for (int p = 0; p < 2; ++p)
#pragma unroll
            for (int i = 0; i < 16; ++i) kt[(p * 16 + i) * 64 + F.lane] = (unsigned short)(__builtin_bit_cast(unsigned, sv[p][i]) & 127u);
        bitonic_sort_desc<16, 0, 32>(cv); bitonic_sort_desc<16, 16, 32>(cv); top16_merge<0, 16, 32>(cv);
        float tv[16]; int te[16];
#pragma unroll
        for (int i = 0; i < 16; ++i) tv[i] = cv[i];
        partner_top16(tv, hi != 0);
#pragma unroll
        for (int rd = 0; rd < 16; ++rd) { const unsigned id = __builtin_bit_cast(unsigned, tv[rd]) & 255u;
            te[rd] = (int)kt[(id >> 4) * 64 + F.lane] * 128 + (int)kt[(16 + (id & 15u)) * 64 + F.lane]; }
        float den = 0.f; const float tmax = tv[0];
#pragma unroll
        for (int rd = 0; rd < 16; ++rd) { tv[rd] = fast_exp2((tv[rd] - tmax) * LOG2E); den += tv[rd]; }
        const float rden = 1.0f / den;
        const size_t off = (size_t)(R0 + tk) * 128 + h * 16;
        if (hi == 0) {
#pragma unroll
            for (int q = 0; q < 4; ++q) { v4u o; o.x = (unsigned)te[4 * q]; o.y = (unsigned)te[4 * q + 1]; o.z = (unsigned)te[4 * q + 2]; o.w = (unsigned)te[4 * q + 3]; *(v4u*)(EI + off + 4 * q) = o; }
        } else {
#pragma unroll
            for (int q = 0; q < 4; ++q) { f32x4 o; o.x = tv[4 * q] * rden; o.y = tv[4 * q + 1] * rden; o.z = tv[4 * q + 2] * rden; o.w = tv[4 * q + 3] * rden; *(f32x4*)(EG + off + 4 * q) = o; }
        }
    }
}
__device__ __forceinline__ void peer_topk_phase(const Frame& F, const bf16* QP, const bf16* KEYS, int* EI, float* EG, bool lat_only) {
    LAS unsigned char* klds = F.lds;
    LAS unsigned short* kt = (LAS unsigned short*)(F.lds + 69632) + F.wave * 2048;
    for (int h = 0; h < 8; ++h) {
        __syncthreads();
#pragma unroll
        for (int i = 0; i < 8; ++i) { const int ch = F.tid + i * 512, row = ch >> 4, c16 = ch & 15;
            *(LAS v4u*)(klds + row * 272 + c16 * 16) = *(const v4u*)(KEYS + ((size_t)(h * 2) * 128 + row) * 128 + c16 * 8); }
        __syncthreads();
        for (int tgl = F.gw; tgl < NB * (TL / 32); tgl += F.NGW) { const int b = tgl >> 8, j = tgl & 255;
            topk_task<true>(F, QP, KEYS, klds, kt, EI, EG, b * RPB + CL + j * 32, h); }
    }
    __syncthreads();
    if (!lat_only) {
        for (int task = F.gw; task < NB * (CL / 32) * 8; task += F.NGW) { const int tgc = task >> 3, h = task & 7, b = tgc >> 3, j = tgc & 7;
            topk_task<false>(F, QP, KEYS, klds, kt, EI, EG, b * RPB + j * 32, h); }
    }
}

typedef float f32x2v __attribute__((ext_vector_type(2)));
typedef int v8i __attribute__((ext_vector_type(8)));
typedef int v2i_t __attribute__((ext_vector_type(2)));
template <int IMM> __device__ __forceinline__ void glds16_s(const unsigned char* sbase, unsigned voff, unsigned lds_dst) { unsigned keep;
    asm volatile("s_mov_b32 %0, m0\n\ts_mov_b32 m0, %3\n\ts_nop 0\n\tglobal_load_lds_dwordx4 %1, %2 offset:%4\n\ts_mov_b32 m0, %0" : "=&s"(keep) : "v"(voff), "s"(sbase), "s"(lds_dst), "n"(IMM) : "memory"); }
__device__ __forceinline__ v2i_t tr4(const LAS unsigned char* p) { return __builtin_amdgcn_ds_read_tr4_b64_v2i32((LAS v2i_t*)p); }
constexpr int G6_WF = 133120, G6_CF = 137216, G6_HB = 139264;
#define PG6_WAITV(n) do { if (GP == 6) asm volatile("s_waitcnt vmcnt(40)" ::: "memory"); else asm volatile("s_waitcnt vmcnt(" #n ")" ::: "memory"); } while (0)
#define PG6_WAITL() asm volatile("s_waitcnt lgkmcnt(0)" ::: "memory")
#define PG7_DMAU(VO, bt, slot) do { if (GP == 2 || GP == 3) break; _Pragma("unroll") for (int k_ = 0; k_ < 8; ++k_) glds16_s<0>(T + 64 * k_, VO[bt], (unsigned)__builtin_amdgcn_readfirstlane(vsm0 + (slot) * 8192 + k_ * 1024)); } while (0)
#define PG7_UREAD(slot) do { if (GP == 5 || GP == 6 || GP == 7 || GP == 8) break; _Pragma("unroll") for (int s_ = 0; s_ < 8; ++s_) ur[s_] = *(const LAS v4u*)(vsl + ua + ((slot) * 8192 + 1024 * s_)); } while (0)
#define PG7_UMFMA(bt) do { if (GP == 5 || GP == 6 || GP == 7 || GP == 8) break; f32x4 d_ = {0.f, 0.f, 0.f, 0.f}; \
    _Pragma("unroll") for (int s_ = 0; s_ < 8; ++s_) { v8i a_; a_[0] = (int)ur[s_].x; a_[1] = (int)ur[s_].y; a_[2] = (int)ur[s_].z; a_[3] = (int)ur[s_].w; a_[4] = 0; a_[5] = 0; a_[6] = 0; a_[7] = 0; \
        d_ = __builtin_amdgcn_mfma_scale_f32_16x16x128_f8f6f4(a_, bh[s_], d_, 4, 0, 0, 0, 0, 0); } \
    if (l15 == 0) *(LAS f32x4*)(wf + 4 * (16 * (bt) + 4 * q4)) = d_; } while (0)
#define PG7_DMAV2(c, h) do { if (GP == 1 || GP == 3 || GP == 8) break; _Pragma("unroll") for (int k_ = 0; k_ < 8; ++k_) \
    glds16_s<0>(T + 512 + 128 * (c) + 64 * (k_ & 1), voff[(k_ >> 1) + 4 * (h)], (unsigned)__builtin_amdgcn_readfirstlane(vsm0 + (h) * 8192 + k_ * 1024)); } while (0)
#define PG7_VREAD2() do { if (GP >= 5) break; _Pragma("unroll") for (int cg_ = 0; cg_ < 16; ++cg_) { const LAS unsigned char* ap_ = vsl + trp2[(cg_ >> 1) & 3] + (1024 * (cg_ >> 3) + 8 * (cg_ & 1)); vb0[cg_] = tr4(ap_); vb1[cg_] = tr4(ap_ + 2048); } } while (0)
#define PG7_SEL2(D, c, cg) do { const bool m_ = l15 == (cg); _Pragma("unroll") for (int i_ = 0; i_ < 4; ++i_) R[c][i_] = m_ ? D[i_] : R[c][i_]; \
    asm volatile("" : "+v"(R[c][0]), "+v"(R[c][1]), "+v"(R[c][2]), "+v"(R[c][3])); } while (0)
#define PG7_VMFMA2(c) do { if (GP >= 5) break; _Pragma("unroll") for (int cg_ = 0; cg_ < 16; ++cg_) { v8i a_; a_[0] = vb0[cg_].x; a_[1] = vb0[cg_].y; a_[2] = vb1[cg_].x; a_[3] = vb1[cg_].y; a_[4] = 0; a_[5] = 0; a_[6] = 0; a_[7] = 0; \
        f32x4 d_ = {0.f, 0.f, 0.f, 0.f}; \
        d_ = __builtin_amdgcn_mfma_scale_f32_16x16x128_f8f6f4(a_, bhi, d_, 4, 0, 0, 0, 0, 0); if (!HIONLY) d_ = __builtin_amdgcn_mfma_scale_f32_16x16x128_f8f6f4(a_, blo, d_, 4, 0, 0, 0, 0, 0); \
        PG7_SEL2(d_, c, cg_); } } while (0)
#ifndef HIONLY
#define HIONLY 0
#endif
#define PG7_VCHUNK(c, ISSUE) do { PG7_VREAD2(); PG6_WAITL(); ISSUE; __builtin_amdgcn_sched_barrier(0); PG7_VMFMA2(c); } while (0)
#define PG7_USTEP(bt, slot, ISSUE) do { PG7_UREAD(slot); PG6_WAITL(); ISSUE; __builtin_amdgcn_sched_barrier(0); PG7_UMFMA(bt); } while (0)
#define PG7_VOFF(VO, EL, EH) do { _Pragma("unroll") for (int k_ = 0; k_ < 8; ++k_) VO[k_] = (unsigned)__shfl(k_ < 4 ? EL : EH, ((16 * k_) & 63) + (lane >> 2)) * 1024u + vlane; } while (0)
#define PG7_H8(HA, HC, O) do { int p_; \
    p_ = __builtin_amdgcn_cvt_pk_fp8_f32(bflo(HA.x), bfhi(HA.x), 0, false); p_ = __builtin_amdgcn_cvt_pk_fp8_f32(bflo(HA.y), bfhi(HA.y), p_, true); O.x = (unsigned)p_; \
    p_ = __builtin_amdgcn_cvt_pk_fp8_f32(bflo(HA.z), bfhi(HA.z), 0, false); p_ = __builtin_amdgcn_cvt_pk_fp8_f32(bflo(HA.w), bfhi(HA.w), p_, true); O.y = (unsigned)p_; \
    p_ = __builtin_amdgcn_cvt_pk_fp8_f32(bflo(HC.x), bfhi(HC.x), 0, false); p_ = __builtin_amdgcn_cvt_pk_fp8_f32(bflo(HC.y), bfhi(HC.y), p_, true); O.z = (unsigned)p_; \
    p_ = __builtin_amdgcn_cvt_pk_fp8_f32(bflo(HC.z), bfhi(HC.z), 0, false); p_ = __builtin_amdgcn_cvt_pk_fp8_f32(bflo(HC.w), bfhi(HC.w), p_, true); O.w = (unsigned)p_; } while (0)
template <bool FINAL, int GP = 0> __device__ __forceinline__ void peer_gather7_phase(const Frame& F, const bf16* HN, const unsigned char* T, const int* EI, const float* EG, const float* g2, bf16* XS, float* out, bool lat_only, const float* gain_n, const float* mod_n, bf16* XNn) {
    const int lane = F.lane, l15 = lane & 15, q4 = lane >> 4, half = lane >> 5, c32 = lane & 31;
    LAS unsigned char* hb = F.lds + G6_HB + F.wave * 1024;
    LAS unsigned char* wf = F.lds + G6_WF + F.wave * 512;
    LAS unsigned char* cf = F.lds + G6_CF + F.wave * 256;
    const LAS unsigned char* vsl = F.lds + F.wave * 16384;
    const unsigned vsm0 = (unsigned)(uintptr_t)F.lds + (unsigned)F.wave * 16384u;
    unsigned trp[4];
#pragma unroll
    for (int p = 0; p < 4; ++p) trp[p] = 2048u * q4 + 64u * l15 + 16u * ((p + (l15 >> 2)) & 3);
    unsigned trp2[4];
#pragma unroll
    for (int p = 0; p < 4; ++p) trp2[p] = 4096u * q4 + 64u * l15 + 16u * ((p + (l15 >> 2)) & 3);
    const unsigned ua = 64u * l15 + 16u * ((q4 + (l15 >> 2)) & 3);
    const unsigned hoff = (unsigned)(32 * c32 + 16 * half);
    const unsigned coff = (unsigned)(16 * l15 + 4 * q4);
    const unsigned vlane = 16u * (unsigned)(((lane & 3) - (lane >> 4)) & 3);
    const int NV = lat_only ? NB * TL : MT;
    int it = F.gw; if (it >= NV) return;
    int row = lat_only ? (it >> 13) * RPB + CL + (it & 8191) : it;
    int e_lo = EI[(size_t)row * 128 + lane], e_hi = EI[(size_t)row * 128 + 64 + lane];
    float g_lo = EG[(size_t)row * 128 + lane], g_hi = EG[(size_t)row * 128 + 64 + lane];
    unsigned voff[8];
    PG7_VOFF(voff, e_lo, e_hi);
    { const v4u ha = *(const v4u*)(HN + (size_t)row * DM + hoff), hc = *(const v4u*)(HN + (size_t)row * DM + hoff + 8); v4u o; PG7_H8(ha, hc, o); *(LAS v4u*)(hb + hoff) = o; }
    v2u xa[4]; f32x4 gv[4];
    { const int b0 = row / RPB, r0 = row - b0 * RPB; const int mr0 = r0 < CL ? 8 : b0;
      const float* gp = g2 + (size_t)mr0 * 6144 + coff; const bf16* xr = XS + (size_t)row * DM + coff;
#pragma unroll
      for (int ch = 0; ch < 4; ++ch) { xa[ch] = *(const v2u*)(xr + 256 * ch); gv[ch] = *(const f32x4*)(gp + 256 * ch); } }
    PG7_DMAU(voff, 0, 0); PG7_DMAU(voff, 1, 1);
    bool first = true;
    for (;;) {
        const int itn = it + F.NGW; const bool hn = itn < NV; const int rown = hn ? (lat_only ? (itn >> 13) * RPB + CL + (itn & 8191) : itn) : row;
        const int b = row / RPB, r = row - b * RPB; const bool cr = r < CL;
        const int mr = cr ? 8 : b;
        v8i bh[8];
#pragma unroll
        for (int s_ = 0; s_ < 8; ++s_) { const v4u b0 = *(const LAS v4u*)(hb + 128 * s_ + 16 * q4), b1 = *(const LAS v4u*)(hb + 128 * s_ + 64 + 16 * q4);
            bh[s_][0] = (int)b0.x; bh[s_][1] = (int)b0.y; bh[s_][2] = (int)b0.z; bh[s_][3] = (int)b0.w; bh[s_][4] = (int)b1.x; bh[s_][5] = (int)b1.y; bh[s_][6] = (int)b1.z; bh[s_][7] = (int)b1.w; }
        asm volatile("" : "+v"(bh[0]), "+v"(bh[1]), "+v"(bh[2]), "+v"(bh[3]), "+v"(bh[4]), "+v"(bh[5]), "+v"(bh[6]), "+v"(bh[7]));
        if (first) { PG6_WAITV(8); } else { PG6_WAITV(12); }
        v4u ur[8];
        PG7_USTEP(0, 0, PG7_DMAU(voff, 2, 0)); if (first) { PG6_WAITV(8); } else { PG6_WAITV(12); }
        first = false;
        PG7_USTEP(1, 1, PG7_DMAU(voff, 3, 1)); PG6_WAITV(8);
        PG7_USTEP(2, 0, PG7_DMAU(voff, 4, 0)); PG6_WAITV(8);
        PG7_USTEP(3, 1, PG7_DMAU(voff, 5, 1)); PG6_WAITV(8);
        PG7_USTEP(4, 0, PG7_DMAU(voff, 6, 0)); PG6_WAITV(8);
        PG7_USTEP(5, 1, PG7_DMAU(voff, 7, 1)); PG6_WAITV(8);
        int e_lo_n = __builtin_nontemporal_load(EI + (size_t)rown * 128 + lane), e_hi_n = __builtin_nontemporal_load(EI + (size_t)rown * 128 + 64 + lane);
        float g_lo_n = __builtin_nontemporal_load(EG + (size_t)rown * 128 + lane), g_hi_n = __builtin_nontemporal_load(EG + (size_t)rown * 128 + 64 + lane);
        v4u hna = __builtin_nontemporal_load((const v4u*)(HN + (size_t)rown * DM + hoff)), hnc = __builtin_nontemporal_load((const v4u*)(HN + (size_t)rown * DM + hoff + 8));
        v2u xan[4]; f32x4 gvn[4];
        { const int bn = rown / RPB, rn = rown - bn * RPB; const int mrn = rn < CL ? 8 : bn;
          const float* gp = g2 + (size_t)mrn * 6144 + coff; const bf16* xr = XS + (size_t)rown * DM + coff;
#pragma unroll
          for (int ch = 0; ch < 4; ++ch) { xan[ch] = __builtin_nontemporal_load((const v2u*)(xr + 256 * ch)); gvn[ch] = *(const f32x4*)(gp + 256 * ch); } }
        PG7_USTEP(6, 0, PG7_DMAV2(0, 0)); PG6_WAITV(8);
        PG7_USTEP(7, 1, PG7_DMAV2(0, 1)); PG6_WAITV(0);
        asm volatile("" : "+v"(e_lo_n), "+v"(e_hi_n), "+v"(g_lo_n), "+v"(g_hi_n), "+v"(hna), "+v"(hnc));
        asm volatile("" : "+v"(xan[0]), "+v"(xan[1]), "+v"(xan[2]), "+v"(xan[3]), "+v"(gvn[0]), "+v"(gvn[1]), "+v"(gvn[2]), "+v"(gvn[3]));
        { v4u o; PG7_H8(hna, hnc, o); *(LAS v4u*)(hb + hoff) = o; }
        unsigned voffn[8];
        PG7_VOFF(voffn, e_lo_n, e_hi_n);
        f32x2v w2; w2.x = gelu_erf(*(const LAS float*)(wf + 4 * lane) * (1.0f / U_SCALE)) * g_lo; w2.y = gelu_erf(*(const LAS float*)(wf + 256 + 4 * lane) * (1.0f / U_SCALE)) * g_hi;
        float mx = __builtin_fmaxf(__builtin_fabsf(w2.x), __builtin_fabsf(w2.y));
#pragma unroll
        for (int o = 1; o < 64; o <<= 1) mx = __builtin_fmaxf(mx, __shfl_xor(mx, o));
        const float csc = 384.0f / __builtin_fmaxf(mx, 1e-30f);
        { const float s0 = w2.x * csc, s1 = w2.y * csc;
          const int hi8 = __builtin_amdgcn_cvt_pk_fp8_f32(s0, s1, 0, false); const f32x2v hf = __builtin_amdgcn_cvt_pk_f32_fp8(hi8, false);
          const int lo8 = __builtin_amdgcn_cvt_pk_fp8_f32(s0 - hf.x, s1 - hf.y, 0, false);
          cf[lane] = (unsigned char)(hi8 & 0xff); cf[64 + lane] = (unsigned char)((hi8 >> 8) & 0xff); cf[128 + lane] = (unsigned char)(lo8 & 0xff); cf[192 + lane] = (unsigned char)((lo8 >> 8) & 0xff); }
        v8i bhi, blo;
        { const v4u h0 = *(const LAS v4u*)(cf + 16 * q4), h1 = *(const LAS v4u*)(cf + 64 + 16 * q4), l0 = *(const LAS v4u*)(cf + 128 + 16 * q4), l1 = *(const LAS v4u*)(cf + 192 + 16 * q4);
          bhi[0] = (int)h0.x; bhi[1] = (int)h0.y; bhi[2] = (int)h0.z; bhi[3] = (int)h0.w; bhi[4] = (int)h1.x; bhi[5] = (int)h1.y; bhi[6] = (int)h1.z; bhi[7] = (int)h1.w;
          blo[0] = (int)l0.x; blo[1] = (int)l0.y; blo[2] = (int)l0.z; blo[3] = (int)l0.w; blo[4] = (int)l1.x; blo[5] = (int)l1.y; blo[6] = (int)l1.z; blo[7] = (int)l1.w; }
        float R[4][4];
#pragma unroll
        for (int i = 0; i < 4; ++i) { R[i][0] = 0.f; R[i][1] = 0.f; R[i][2] = 0.f; R[i][3] = 0.f; }
        v2i_t vb0[16], vb1[16];
        PG7_VCHUNK(0, PG7_DMAV2(1, 0); PG7_DMAV2(1, 1)); PG6_WAITV(0);
        PG7_VCHUNK(1, PG7_DMAV2(2, 0); PG7_DMAV2(2, 1)); PG6_WAITV(0);
        PG7_VCHUNK(2, PG7_DMAV2(3, 0); PG7_DMAV2(3, 1)); PG6_WAITV(0);
        PG7_VCHUNK(3, if (hn) { PG7_DMAU(voffn, 0, 0); PG7_DMAU(voffn, 1, 1); });
        const float osc = 1.0f / (V_SCALE * csc);
        float xn[16];
#pragma unroll
        for (int ch = 0; ch < 4; ++ch) {
            xn[4 * ch] = bflo(xa[ch].x) + gv[ch].x * (R[ch][0] * osc); xn[4 * ch + 1] = bfhi(xa[ch].x) + gv[ch].y * (R[ch][1] * osc); xn[4 * ch + 2] = bflo(xa[ch].y) + gv[ch].z * (R[ch][2] * osc); xn[4 * ch + 3] = bfhi(xa[ch].y) + gv[ch].w * (R[ch][3] * osc); }
        if (FINAL) {
            float* orow = out + ((size_t)b * TL + (r - CL)) * DM + coff;
#pragma unroll
            for (int ch = 0; ch < 4; ++ch) { f32x4 o; o.x = xn[4 * ch]; o.y = xn[4 * ch + 1]; o.z = xn[4 * ch + 2]; o.w = xn[4 * ch + 3]; __builtin_nontemporal_store(o, (f32x4*)(orow + 256 * ch)); }
        } else {
            bf16* orow = XS + (size_t)row * DM + coff;
#pragma unroll
            for (int ch = 0; ch < 4; ++ch) { v2u o; o.x = pk2(xn[4 * ch], xn[4 * ch + 1]); o.y = pk2(xn[4 * ch + 2], xn[4 * ch + 3]); *(v2u*)(orow + 256 * ch) = o; }
            float ss = 0.f;
#pragma unroll
            for (int i = 0; i < 16; ++i) ss += xn[i] * xn[i];
            const float rs = __builtin_amdgcn_rsqf(wave_sum(ss) * (1.f / DM) + EPS);
            const float* gn = gain_n + coff; const float* shp = mod_n + (size_t)mr * 6144 + coff; const float* scp = shp + 1024;
            bf16* nxp = XNn + (size_t)row * DM + coff;
#pragma unroll
            for (int ch = 0; ch < 4; ++ch) { const f32x4 g = *(const f32x4*)(gn + 256 * ch), sh = *(const f32x4*)(shp + 256 * ch), sc = *(const f32x4*)(scp + 256 * ch);
                const float y0 = xn[4 * ch] * rs * g.x * (sc.x + 1.0f) + sh.x, y1 = xn[4 * ch + 1] * rs * g.y * (sc.y + 1.0f) + sh.y, y2 = xn[4 * ch + 2] * rs * g.z * (sc.z + 1.0f) + sh.z, y3 = xn[4 * ch + 3] * rs * g.w * (sc.w + 1.0f) + sh.w;
                v2u o; o.x = pk2(y0, y1); o.y = pk2(y2, y3); *(v2u*)(nxp + 256 * ch) = o; }
        }
        if (!hn) break;
        it = itn; row = rown; e_lo = e_lo_n; e_hi = e_hi_n; g_lo = g_lo_n; g_hi = g_hi_n;
#pragma unroll
        for (int k = 0; k < 8; ++k) voff[k] = voffn[k];
#pragma unroll
        for (int ch = 0; ch < 4; ++ch) { xa[ch] = xan[ch]; gv[ch] = gvn[ch]; }
    }
}

#ifndef MK_MASK
#define MK_MASK 0x7ff
#endif
#define ENAB(r) (((MK_MASK) >> (r)) & 1)
#define IN(k) (lo <= (k) && (k) < hi)
#define SEAM(k) do { if ((k) + 1 < hi) { if (MK_PER_PHASE) { if (F.tid == 0) __hip_atomic_store(F.ctl + CW_TMO, 0xBADBA0u, RLX_AGENT); } else xcd_barrier(bar); } } while (0)

template <int layer> __device__ __forceinline__ void run_layer(const Frame& F, const Args& args, const XcdBarrier& bar, const int lo, const int hi, unsigned char* lds) {
    unsigned char* ws = args.ws;
    float* MOD = (float*)(ws + WS_MOD);
    const float* RT = (const float*)(ws + WS_ROPE);
    bf16* XS = (bf16*)(ws + WS_XS);
    bf16* OD = (bf16*)(ws + WS_XS);
    bf16* XN = (bf16*)(ws + WS_XN);
    bf16* PB = (bf16*)(ws + WS_PB);
    int* EI = (int*)(ws + WS_EI); float* EG = (float*)(ws + WS_EG);
        const int pb = 1 + layer * PH_PER_LAYER;
        const float* mod = MOD + (size_t)layer * 9 * 6144;
        const float* norm1 = args.in[layer ? 25 : 6]; const float* norm2 = args.in[layer ? 26 : 7];
        const bf16* W_in = (const bf16*)(ws + (layer ? WS_WIN1 : WS_WIN0)); const bf16* W_out = (const bf16*)(ws + (layer ? WS_WOUT1 : WS_WOUT0)); const bf16* W_q = (const bf16*)(ws + (layer ? WS_WQ1 : WS_WQ0));
        const bf16* KEYS = (const bf16*)(ws + (layer ? WS_KEYS1 : WS_KEYS0)); const unsigned char* PU = ws + (layer ? WS_U1 : WS_U0); const unsigned char* PV = PU;
        const int n_in = layer ? N_IN1 : N_IN0;
        const bool lat_only = layer == 1;

        if (ENAB(0) && IN(pb + 0)) {
            if (layer == 0) { norm_mod_phase<true>(F, args.in[0], args.in[2], XS, norm1, mod + 0, mod + 1024, XN, false); SEAM(pb + 0); }
        }
        if (ENAB(1) && IN(pb + 1)) {
            pg8::Gemm g{XN, W_in, MT, n_in, DM}; pg8::StaticOrder S; S.init(MT, n_in, F.G, (int)blockIdx.x);
            PG8_LAS float* xch = (PG8_LAS float*)(F.lds + 132096);
            pg8::EpiHeadNorm<layer> E{PB, n_in, RT + 4096 + layer * 256, RT, xch, QSCALE};
            pg8::gemm_phase<pg8::EpiHeadNorm<layer>, pg8::StaticOrder, true, true>(F.lds, g, S, E);
            SEAM(pb + 1);
        }
        if (ENAB(2) && IN(pb + 2)) {
            if (layer == 0) { l0_headnorm_pool_phase(F, args, PB, XN, RT); SEAM(pb + 2); }
        }
        if (ENAB(3) && IN(pb + 3)) {
            using abf = attn_body::bf16;
            if (layer == 0) {
                for (int u = F.vcu, first = 1; u < NB * 12 * 32; u += F.G, first = 0) {
                    const int combo = u >> 5, qb = u & 31, b = combo / 12, s = combo % 12;
                    const size_t kr0 = (size_t)b * RPB, qr0 = kr0 + CL + (size_t)qb * 256;
                    const int un = u + F.G; const bool hn = un < NB * 12 * 32; const int cn = (hn ? un : u) >> 5, bn = cn / 12, sn = cn % 12; const size_t krn = (size_t)bn * RPB;
                    attn_body::attn_unit2<2, N_IN0, OD_P, 0>((const abf*)(PB + qr0 * N_IN0 + 256 + s * 64), (const abf*)(PB + kr0 * N_IN0 + 1024 + s * 64), (const abf*)(PB + kr0 * N_IN0 + 1792 + (s >> 1) * 128),
                                                         (abf*)(OD + qr0 * OD_P + s * 128), (RPB / 64), (char*)lds, nullptr, 0,
                                                         !first, hn, (const abf*)(PB + krn * N_IN0 + 1024 + sn * 64), (const abf*)(PB + krn * N_IN0 + 1792 + (sn >> 1) * 128));
                }
                for (int u = F.vcu; u < NB * 12; u += F.G) {
                    const int b = u / 12, s = u % 12; const size_t kr0 = (size_t)b * RPB;
                    attn_body::attn_unit2<2, N_IN0, OD_P, 0>((const abf*)(PB + kr0 * N_IN0 + 256 + s * 64), (const abf*)(PB + kr0 * N_IN0 + 1024 + s * 64), (const abf*)(PB + kr0 * N_IN0 + 1792 + (s >> 1) * 128),
                                                         (abf*)(OD + kr0 * OD_P + s * 128), (CL / 64), (char*)lds, nullptr, 0, false, false, nullptr, nullptr);
                }
            } else {
                for (int u = F.vcu, first = 1; u < NB * 8 * 32; u += F.G, first = 0) {
                    const int combo = u >> 5, qb = u & 31, b = combo >> 3, h = combo & 7;
                    const size_t kr0 = (size_t)b * RPB, qr0 = kr0 + CL + (size_t)qb * 256;
                    const int un = u + F.G; const bool hn = un < NB * 8 * 32; const int cn = (hn ? un : u) >> 5, bn = cn >> 3, hn_ = cn & 7; const size_t krn = (size_t)bn * RPB;
                    attn_body::attn_unit2<1, N_IN1, DM, 0>((const abf*)(PB + qr0 * N_IN1 + h * 64), (const abf*)(PB + kr0 * N_IN1 + 512 + (h >> 2) * 64), (const abf*)(PB + kr0 * N_IN1 + 640 + (h >> 2) * 64),
                                                       (abf*)(XN + qr0 * DM + h * 64), (RPB / 64), (char*)lds, nullptr, 0,
                                                       !first, hn, (const abf*)(PB + krn * N_IN1 + 512 + (hn_ >> 2) * 64), (const abf*)(PB + krn * N_IN1 + 640 + (hn_ >> 2) * 64));
                }
            }
            if (layer == 0) SEAM(pb + 3);
        }
        if (ENAB(4) && IN(pb + 4)) {
            if (layer == 0) l0_diff_combine_phase(F, args, OD, XN);
            else {
                if (!(DBGZ & 16)) {
                    using abf = attn_body::bf16;
                    for (int u = F.vcu, first = 1; u < NB * 8 * 32; u += F.G, first = 0) {
                        const int combo = u >> 5, qb = u & 31, b = combo >> 3, h = combo & 7;
                        const size_t kr0 = (size_t)b * RPB, qr0 = kr0 + CL + (size_t)qb * 256;
                        const int un = u + F.G; const bool hn = un < NB * 8 * 32; const int cn = (hn ? un : u) >> 5, bn = cn >> 3, hn_ = cn & 7; const size_t krn = (size_t)bn * RPB;
                        attn_body::attn_unit2<1, N_IN1, DM, 1>((const abf*)(PB + qr0 * N_IN1 + 768 + h * 64), (const abf*)(PB + kr0 * N_IN1 + 1280 + h * 64), (const abf*)(PB + kr0 * N_IN1 + 1792 + h * 64),
                                                              (abf*)(XN + qr0 * DM + 512 + h * 64), 16, (char*)lds, args.in[33] + h * 465, qb * 4,
                                                              !first, hn, (const abf*)(PB + krn * N_IN1 + 1280 + hn_ * 64), (const abf*)(PB + krn * N_IN1 + 1792 + hn_ * 64));
                    }
                }
                if (DBGZ & 24) { for (int row = F.gw; row < MT; row += F.NGW) { v4u z = {0u, 0u, 0u, 0u};
                    if (DBGZ & 8) *(v4u*)(XN + (size_t)row * DM + 8 * F.lane) = z;
                    if (DBGZ & 16) *(v4u*)(XN + (size_t)row * DM + 512 + 8 * F.lane) = z; } }
            }
            SEAM(pb + 4);
        }
        if (ENAB(5) && IN(pb + 5)) {
            pg8::Gemm g{XN, W_out, MT, DM, DM};
            pg8::EpiRes E{XS, args.in[0], args.in[2], mod + 2048, layer == 0 ? 1 : 0};
            if (layer == 0) { pg8::StaticOrder S; S.init(MT, DM, F.G, (int)blockIdx.x); pg8::gemm_phase<pg8::EpiRes, pg8::StaticOrder, true, true>(F.lds, g, S, E); }
            else { pg8::LatOrder S; S.init(DM, F.G, (int)blockIdx.x); pg8::gemm_phase<pg8::EpiRes, pg8::LatOrder, true, true>(F.lds, g, S, E); }
            SEAM(pb + 5);
        }
        if (ENAB(6) && IN(pb + 6)) { norm_mod_phase<false>(F, args.in[0], args.in[2], XS, norm2, mod + 3072, mod + 4096, XN, lat_only); SEAM(pb + 6); }
        if (ENAB(7) && IN(pb + 7)) {
            pg8::Gemm g{XN, W_q, MT, N_WQ, DM};
            pg8::EpiBf16<0> E{PB, N_WQ, nullptr, 0, 0, 1.f};
            if (layer == 0) { pg8::StaticOrder S; S.init(MT, N_WQ, F.G, (int)blockIdx.x); pg8::gemm_phase<pg8::EpiBf16<0>, pg8::StaticOrder, true, true>(F.lds, g, S, E); }
            else { pg8::LatOrder S; S.init(N_WQ, F.G, (int)blockIdx.x); pg8::gemm_phase<pg8::EpiBf16<0>, pg8::LatOrder, true, true>(F.lds, g, S, E); }
            SEAM(pb + 7);
        }
        if (ENAB(8) && IN(pb + 8)) { peer_topk_phase(F, PB, KEYS, EI, EG, lat_only); SEAM(pb + 8); }
        if (ENAB(9) && IN(pb + 9)) {
            if (layer == 0) peer_gather7_phase<false>(F, XN, PU, EI, EG, mod + 5120, XS, args.out, false, args.in[25], MOD + (size_t)9 * 6144, XN);
            else {
#if defined(PROBE_G6)
                if (args.pad) peer_gather7_phase<true, PROBE_G6>(F, XN, PU, EI, EG, mod + 5120, XS, (float*)(ws + WS_PB), true, nullptr, nullptr, nullptr); else
#endif
                peer_gather7_phase<true>(F, XN, PU, EI, EG, mod + 5120, XS, args.out, true, nullptr, nullptr, nullptr);
            }
            SEAM(pb + 9);
        }
}
__global__ void __launch_bounds__(NWAVES * 64, 2) mk_fwd(Args args) {
    extern __shared__ __attribute__((aligned(16))) unsigned char lds[];
    Frame F;
    F.lds = (LAS unsigned char*)lds;
    F.tid = threadIdx.x; F.lane = F.tid & 63; F.wave = __builtin_amdgcn_readfirstlane(F.tid >> 6);
    F.G = gridDim.x; { const int bx = blockIdx.x; F.vcu = (F.G % 8 == 0) ? (bx % 8) * (F.G / 8) + bx / 8 : bx; }
    F.gw = F.vcu * NWAVES + F.wave; F.NGW = F.G * NWAVES;
    unsigned char* ws = args.ws;
    F.ctl = (gu32*)(ws + WS_CTL);
    for (int u = F.tid; u < (LDS_BYTES - LDSCTL_OFF) / 4; u += NWAVES * 64) ((LAS unsigned*)(F.lds + LDSCTL_OFF))[u] = 0u;
    __syncthreads();
    XcdBarrier bar; bar.bar = (unsigned*)(F.ctl + CW_BAR) + args.li * XCD_BAR_WORDS; bar.x = 0; bar.st = nullptr;
    if (!MK_PER_PHASE) bar = xcd_barrier_post((unsigned*)(F.ctl + CW_BAR) + args.li * XCD_BAR_WORDS, (volatile LAS unsigned*)(F.lds + MISC_OFF) + 8);
    const int lo = args.ph_lo, hi = args.ph_hi;
    if (ENAB(10) && IN(0)) { p0_prologue(F, args); SEAM(0); }
    run_layer<0>(F, args, bar, lo, hi, lds);
    run_layer<1>(F, args, bar, lo, hi, lds);
#if defined(EXTRA_BARRIERS)
    if (hi == N_PHASES) { for (int i = 0; i < EXTRA_BARRIERS; ++i) xcd_barrier(bar); }
#endif
}


extern "C" void kernel_launch(void* const* d_in, const int* in_sizes, int n_in, void* d_out, int out_size, void* d_ws, size_t ws_size, hipStream_t stream) {
    static int grid = 0;
    if (grid == 0) {
        if (n_in != 38 || in_sizes[0] != NB * TL * DM || out_size != NB * TL * DM || ws_size < WS_END) {
            fprintf(stderr, "kernel_launch: unexpected problem shape (n_in %d, in0 %d, out %d, ws %zu; need ws >= %zu); nothing launched\n", n_in, n_in > 0 ? in_sizes[0] : -1, out_size, ws_size, (size_t)WS_END); grid = -1; return; }
        int dev = 0, cus = 0, per_cu = 0;
        if (hipGetDevice(&dev) != hipSuccess || hipDeviceGetAttribute(&cus, hipDeviceAttributeMultiprocessorCount, dev) != hipSuccess) { grid = -1; return; }
        if (hipFuncSetAttribute((const void*)mk_fwd, hipFuncAttributeMaxDynamicSharedMemorySize, LDS_BYTES) != hipSuccess) { fprintf(stderr, "kernel_launch: hipFuncSetAttribute failed\n"); grid = -1; return; }
        if (hipOccupancyMaxActiveBlocksPerMultiprocessor(&per_cu, (const void*)mk_fwd, NWAVES * 64, LDS_BYTES) != hipSuccess || per_cu < 1) { fprintf(stderr, "kernel_launch: occupancy query says %d blocks per CU\n", per_cu); }
        (void)hipGetLastError();
        grid = cus;
    }
    if (grid < 0) return;
    if (hipMemsetAsync((char*)d_ws + WS_CTL, 0, CTL_ZERO_BYTES, stream) != hipSuccess) return;
    Args a{};
    for (int i = 0; i < 38; ++i) a.in[i] = (const float*)d_in[i];
    a.out = (float*)d_out; a.ws = (unsigned char*)d_ws;
#if MK_PER_PHASE
    for (int p = 0; p < N_PHASES; ++p) { a.ph_lo = p; a.ph_hi = p + 1; hipLaunchKernelGGL(mk_fwd, dim3(grid), dim3(NWAVES * 64), LDS_BYTES, stream, a); }
#else
    a.ph_lo = 0; a.ph_hi = N_PHASES;
    hipLaunchKernelGGL(mk_fwd, dim3(grid), dim3(NWAVES * 64), LDS_BYTES, stream, a);
#if defined(EXTRA_PHASE)
#ifndef EXTRA_HI
#define EXTRA_HI (EXTRA_PHASE + 1)
#endif
    a.ph_lo = EXTRA_PHASE; a.ph_hi = EXTRA_HI; a.li = 1;
#if defined(PROBE_G6)
    a.pad = 1;
#endif
    hipLaunchKernelGGL(mk_fwd, dim3(grid), dim3(NWAVES * 64), LDS_BYTES, stream, a);
#endif
#endif
    const hipError_t le = hipPeekAtLastError();
    if (le != hipSuccess) fprintf(stderr, "kernel_launch: launch failed: %s\n", hipGetErrorName(le));
}
```

```cpp
#include <hip/hip_runtime.h>
#include <hip/hip_bf16.h>
#include <cstdio>
#include <cstdint>
#include <cmath>
namespace pg8 {
#define PG8_LAS __attribute__((address_space(3)))
typedef unsigned short bf16_t;
typedef short bf16x8 __attribute__((ext_vector_type(8)));
typedef float f32x4 __attribute__((ext_vector_type(4)));
typedef unsigned u32x4 __attribute__((ext_vector_type(4)));
constexpr int BM = 256, BK = 64, HALF = 128, HTB = HALF * BK * 2  , STAGE_BYTES = 8 * HTB, NXCD = 8, WGM = 8;

__host__ __device__ __forceinline__ int lds_byte(int r, int c) { const int st = (r >> 4) * 2 + (c >> 5), rr = r & 15, cc = c & 31, ob = rr * 64 + cc * 2; return st * 1024 + (ob ^ (((ob >> 9) & 1) << 5)); }
__host__ __device__ __forceinline__ void stage_rc(int b, int& R, int& C) { const int st = b / 1024, sb = b % 1024, swz = sb ^ (((sb >> 9) & 1) << 5); R = (st >> 1) * 16 + swz / 64; C = (st & 1) * 32 + (swz % 64) / 2; }
__host__ __device__ __forceinline__ int perm32(int rho) { const int n = rho >> 4, i = rho & 15; return 8 * (i >> 2) + 4 * n + (i & 3); }

struct Unit { int pm, pn; };
struct Gemm { const bf16_t* A; const bf16_t* Bt; int M, N, K; };

struct StaticOrder {
    int nM, nN, nwg, G, c;
    __host__ __device__ void init(int M, int N, int G_, int c_) { nM = M / BM; nN = N / BM; nwg = nM * nN; G = G_; c = c_; }
    __host__ __device__ bool next(int i, Unit& u) const {
        const long L = (long)i * G + c; if (L >= nwg) return false;
        int wgid = (int)L; { const int q = nwg / NXCD, r = nwg % NXCD, xcd = wgid % NXCD, off = wgid / NXCD; wgid = (xcd < r ? xcd * (q + 1) : r * (q + 1) + (xcd - r) * q) + off; }
        const int nig = WGM * nN, gid = wgid / nig, fm = gid * WGM, gsz = (nM - fm) < WGM ? (nM - fm) : WGM;
        u.pm = fm + ((wgid % nig) % gsz); u.pn = (wgid % nig) / gsz; return true;
    }
    __device__ __forceinline__ void a_ready(const Unit&) const {}
    __device__ __forceinline__ void done(const Unit&) const {}
};

__device__ __forceinline__ unsigned cvt_pk_bf16(float lo, float hi) { unsigned r; asm volatile("v_cvt_pk_bf16_f32 %0, %1, %2" : "=v"(r) : "v"(lo), "v"(hi)); return r; }
typedef float f32x2 __attribute__((ext_vector_type(2)));
__device__ __forceinline__ f32x2 gelu_pk(f32x2 v) {
    const f32x2 av = __builtin_elementwise_abs(v), d = av * 0.2316418882f + 1.0f;
    f32x2 t; t.x = __builtin_amdgcn_rcpf(d.x); t.y = __builtin_amdgcn_rcpf(d.y);
    f32x2 q = t * 0.5307027145f + (-0.7265760135f); q = q * t + 0.7107068705f; q = q * t + (-0.142248368f); q = q * t + 0.127414796f; q = q * t;
    const f32x2 s = (v * v) * (-0.72134752044f);
    f32x2 e; e.x = __builtin_amdgcn_exp2f(s.x); e.y = __builtin_amdgcn_exp2f(s.y);
    const f32x2 m = v * (q * e), r = v - m;
    f32x2 o; o.x = v.x < 0.f ? m.x : r.x; o.y = v.y < 0.f ? m.y : r.y; return o;
}

template <int ACT  > struct EpiBf16 {
    static constexpr bool PERM = true, AFTER_DRAIN = false; static_assert(ACT == 0 || ACT == 1, "EpiBf16: ACT is 0 (none) or 1 (gelu_pk)");
    bf16_t* O; int ldc; const float* bias; int split_cols; size_t split_stride; float scale0;
    __device__ __forceinline__ void operator()(const f32x4 (&acc)[2][2][4][2], const Unit& u, int wr, int wc, int fr, int fq) const {
        const int row0 = u.pm * BM + wr * 64 + fr; int colt = u.pn * BM; bf16_t* base = O;
        float sc = 1.f; if (split_cols) { const int t = colt / split_cols; base += (size_t)t * split_stride; colt -= t * split_cols; if (t == 0) sc = scale0; }
        const int col0 = colt + wc * 32 + 8 * fq, bcol0 = u.pn * BM + wc * 32 + 8 * fq;
        f32x4 bv[2][2];
#pragma unroll
        for (int bj = 0; bj < 2; ++bj)
#pragma unroll
            for (int n = 0; n < 2; ++n) bv[bj][n] = bias ? *(const f32x4*)(bias + bcol0 + bj * HALF + 4 * n) : (f32x4){0.f, 0.f, 0.f, 0.f};
#pragma unroll
        for (int ai = 0; ai < 2; ++ai)
#pragma unroll
            for (int m = 0; m < 4; ++m) { bf16_t* rowp = base + (size_t)(row0 + ai * HALF + m * 16) * ldc + col0;
#pragma unroll
                for (int bj = 0; bj < 2; ++bj) { f32x4 v0 = acc[ai][bj][m][0] + bv[bj][0], v1 = acc[ai][bj][m][1] + bv[bj][1];
                    if (ACT == 1) { f32x2 a = gelu_pk((f32x2){v0[0], v0[1]}), b = gelu_pk((f32x2){v0[2], v0[3]}), c = gelu_pk((f32x2){v1[0], v1[1]}), d = gelu_pk((f32x2){v1[2], v1[3]});
                        v0 = (f32x4){a.x, a.y, b.x, b.y}; v1 = (f32x4){c.x, c.y, d.x, d.y}; }
                    v0 = v0 * sc; v1 = v1 * sc; u32x4 w; w.x = cvt_pk_bf16(v0[0], v0[1]); w.y = cvt_pk_bf16(v0[2], v0[3]); w.z = cvt_pk_bf16(v1[0], v1[1]); w.w = cvt_pk_bf16(v1[2], v1[3]);
                    *(u32x4*)(rowp + bj * HALF) = w; } }
    }
};

struct EpiRes {
    static constexpr bool PERM = true, AFTER_DRAIN = false;
    bf16_t* out; const float* xlat; const float* xctx; const float* g1; int from_input;
    __device__ __forceinline__ void operator()(const f32x4 (&acc)[2][2][4][2], const Unit& u, int wr, int wc, int fr, int fq) const {
        const int b = u.pm / 33, seg = u.pm % 33, mr = seg == 0 ? 8 : b;
        const int rt0 = wr * 64 + fr, col0 = u.pn * BM + wc * 32 + 8 * fq;
        const float* gp = g1 + (size_t)mr * 6144 + col0;
        const float* xbase = seg == 0 ? xctx + (size_t)b * 256 * 1024 : xlat + ((size_t)b * 8192 + (size_t)(seg - 1) * 256) * 1024;
        bf16_t* obase = out + (size_t)u.pm * BM * 1024;
#pragma unroll
        for (int bj = 0; bj < 2; ++bj) { const f32x4 g0 = *(const f32x4*)(gp + bj * HALF), g1v = *(const f32x4*)(gp + bj * HALF + 4);
#pragma unroll
            for (int ai = 0; ai < 2; ++ai)
#pragma unroll
                for (int m = 0; m < 4; ++m) { const unsigned ro = (unsigned)(rt0 * 1024 + col0) + (unsigned)((ai * HALF + m * 16) * 1024 + bj * HALF);
                    f32x4 x0, x1;
                    if (from_input) { x0 = *(const f32x4*)(xbase + ro); x1 = *(const f32x4*)(xbase + ro + 4); }
                    else { const u32x4 w = *(const u32x4*)(obase + ro);
                        x0 = (f32x4){__builtin_bit_cast(float, w.x << 16), __builtin_bit_cast(float, w.x & 0xffff0000u), __builtin_bit_cast(float, w.y << 16), __builtin_bit_cast(float, w.y & 0xffff0000u)};
                        x1 = (f32x4){__builtin_bit_cast(float, w.z << 16), __builtin_bit_cast(float, w.z & 0xffff0000u), __builtin_bit_cast(float, w.w << 16), __builtin_bit_cast(float, w.w & 0xffff0000u)}; }
                    const f32x4 v0 = x0 + g0 * acc[ai][bj][m][0], v1 = x1 + g1v * acc[ai][bj][m][1];
                    u32x4 o; o.x = cvt_pk_bf16(v0[0], v0[1]); o.y = cvt_pk_bf16(v0[2], v0[3]); o.z = cvt_pk_bf16(v1[0], v1[1]); o.w = cvt_pk_bf16(v1[2], v1[3]);
                    *(u32x4*)(obase + ro) = o; }
            asm volatile("" ::: "memory"); }
    }
};

template <int LAYER> struct EpiHeadNorm {
    static constexpr bool PERM = true, AFTER_DRAIN = false;
    bf16_t* O; int ldc; const float* gains; const float* RT; PG8_LAS float* xch; float qscale;
    __device__ __forceinline__ static int kind_of(int pn, int hh) {
        if (LAYER == 0) return (pn >= 1 && pn <= 3) ? 1 : (pn >= 4 && pn <= 6) ? 2 : 0;
        return pn <= 1 ? 1 : pn == 2 ? (hh < 2 ? 2 : 0) : pn <= 4 ? 1 : pn <= 6 ? 2 : 0;
    }
    __device__ __forceinline__ void operator()(const f32x4 (&acc)[2][2][4][2], const Unit& u, int wr, int wc, int fr, int fq) const {
        asm volatile("" : "+v"(fr), "+v"(fq));
        const int pn = u.pn, wid = wr * 4 + wc;
        const int row0 = u.pm * BM + wr * 64 + fr, col0 = pn * BM + wc * 32 + 8 * fq;
        const bool any = LAYER == 0 ? (pn >= 1 && pn <= 6) : (pn <= 6);
        if (any) {
#pragma unroll
            for (int ai = 0; ai < 2; ++ai)
#pragma unroll
                for (int m = 0; m < 4; ++m)
#pragma unroll
                    for (int bj = 0; bj < 2; ++bj) { const f32x4 a = acc[ai][bj][m][0], b = acc[ai][bj][m][1];
                        float s = (a[0] * a[0] + a[1] * a[1]) + (a[2] * a[2] + a[3] * a[3]) + (b[0] * b[0] + b[1] * b[1]) + (b[2] * b[2] + b[3] * b[3]);
                        s += __shfl_xor(s, 16); s += __shfl_xor(s, 32);
                        if (fq == 0) xch[wid * 256 + ((ai * 4 + m) * 2 + bj) * 16 + fr] = s; }
            asm volatile("s_waitcnt lgkmcnt(0)" ::: "memory");
            __builtin_amdgcn_s_barrier();
        }
        const int seg = u.pm % 33; const bool lat = seg != 0;
#pragma unroll
        for (int ai = 0; ai < 2; ++ai)
#pragma unroll
            for (int m = 0; m < 4; ++m) { const int rt = wr * 64 + fr + ai * HALF + m * 16; bf16_t* rowp = O + (size_t)(u.pm * BM + rt) * ldc + col0;
                const int t = (seg - 1) * 256 + rt;
#pragma unroll
                for (int bj = 0; bj < 2; ++bj) {
                    const int hh = 2 * bj + (wc >> 1); const int kind = kind_of(pn, hh);
                    float rs = 1.f; const bool rope = kind != 0 && lat && (LAYER == 0 || pn <= 2);
                    if (kind != 0) {
                        const float tot = xch[wid * 256 + ((ai * 4 + m) * 2 + bj) * 16 + fr] + xch[(wid ^ 1) * 256 + ((ai * 4 + m) * 2 + bj) * 16 + fr];
                        rs = __builtin_amdgcn_rsqf(tot * (1.f / 64) + 1e-6f) * (kind == 1 ? qscale : 1.f); }
                    const bool fam2 = LAYER == 1 && pn >= 3;
                    const float* gp = gains + ((kind == 1 ? 0 : 1) + (fam2 ? 2 : 0)) * 64 + 32 * (wc & 1) + 8 * fq;
                    const int pos = (wc & 1) == 0 ? (t >> 6) : (t & 63);
                    const float* cp = RT + pos * 16 + 8 * (fq & 1);
                    unsigned wv[4];
#pragma unroll
                    for (int n = 0; n < 2; ++n) { f32x4 v = acc[ai][bj][m][n];
                        if (kind != 0) { v = v * rs * *(const f32x4*)(gp + 4 * n);
                            if (rope) { const f32x4 c = *(const f32x4*)(cp + 4 * n), sn = *(const f32x4*)(cp + 2048 + 4 * n); f32x4 p;
#pragma unroll
                                for (int e = 0; e < 4; ++e) p[e] = __shfl_xor(v[e], 32);
                                v = ((fq >> 1) == 0) ? v * c - p * sn : v * c + p * sn; } }
                        wv[2 * n] = cvt_pk_bf16(v[0], v[1]); wv[2 * n + 1] = cvt_pk_bf16(v[2], v[3]); }
                    u32x4 w; w.x = wv[0]; w.y = wv[1]; w.z = wv[2]; w.w = wv[3];
                    *(u32x4*)(rowp + bj * HALF) = w; }
                asm volatile("" ::: "memory"); }
    }
};
struct LatOrder {
    StaticOrder S;
    __host__ __device__ void init(int N, int G_, int c_) { S.init(65536, N, G_, c_); }
    __host__ __device__ bool next(int i, Unit& u) const { if (!S.next(i, u)) return false; u.pm = u.pm + u.pm / 32 + 1; return true; }
    __device__ __forceinline__ void a_ready(const Unit&) const {}
    __device__ __forceinline__ void done(const Unit&) const {}
};
template <class Epi, class Sched, bool ALIGN_EPI = false, bool SP2 = false>
__device__ __forceinline__ void gemm_phase(PG8_LAS unsigned char* lds, const Gemm g, const Sched& S, const Epi& E) {
    const int tid = threadIdx.x, wid = __builtin_amdgcn_readfirstlane(tid >> 6), lane = tid & 63, wr = wid >> 2, wc = wid & 3, fr = lane & 15, fq = lane >> 4;
    const int K = g.K, nt = K / BK;
    unsigned voffA[2], voffB[2];
#pragma unroll
    for (int i = 0; i < 2; ++i) { int R, C; stage_rc(tid * 16 + i * 8192, R, C); const int Rb = Epi::PERM ? ((R & ~31) + perm32(R & 31)) : R;
        voffA[i] = (unsigned)(R * K + C) * 2u; voffB[i] = (unsigned)(Rb * K + C) * 2u; }
    const size_t kstep = (size_t)(BK * 2);
    const size_t hstep = (size_t)HALF * K * 2;
    const size_t tstep = 2 * hstep;
    const unsigned ldsw = (unsigned)wid * 1024u;
    const int aoff = lds_byte(wr * 64 + fr, fq * 8), boff = lds_byte(wc * 32 + fr, fq * 8);
#define PG8_SA(b, h) (((b) * 2 + (h)) * HTB)
#define PG8_SB(b, h) ((4 + (b) * 2 + (h)) * HTB)
#define PG8_STAGE(bufoff, gbase, voff) do { _Pragma("unroll") for (int _i = 0; _i < 2; ++_i) \
        __builtin_amdgcn_global_load_lds((const unsigned*)((const char*)(gbase) + (voff)[_i]), (PG8_LAS unsigned*)(lds + (bufoff) + ldsw + _i * 8192), 16, 0, 0); } while (0)
#define PG8_LDA(dst, b, h) do { _Pragma("unroll") for (int m = 0; m < 4; ++m) _Pragma("unroll") for (int k = 0; k < 2; ++k) dst[m][k] = *(const PG8_LAS bf16x8*)(lds + PG8_SA(b, h) + aoff + m * 2048 + k * 1024); } while (0)
#define PG8_LDB(dst, b, h) do { _Pragma("unroll") for (int n = 0; n < 2; ++n) _Pragma("unroll") for (int k = 0; k < 2; ++k) dst[n][k] = *(const PG8_LAS bf16x8*)(lds + PG8_SB(b, h) + boff + n * 2048 + k * 1024); } while (0)
#define PG8_MMA(ai, bj, At, Bt) do { __builtin_amdgcn_s_setprio(1); _Pragma("unroll") for (int m = 0; m < 4; ++m) _Pragma("unroll") for (int n = 0; n < 2; ++n) _Pragma("unroll") for (int k = 0; k < 2; ++k) \
        acc[ai][bj][m][n] = __builtin_amdgcn_mfma_f32_16x16x32_bf16(Bt[n][k], At[m][k], acc[ai][bj][m][n], 0, 0, 0); __builtin_amdgcn_s_setprio(0); } while (0)
#define PG8_WAIT_V(n) asm volatile("s_waitcnt vmcnt(" #n ")" ::: "memory")
#define PG8_WAIT_L(n) asm volatile("s_waitcnt lgkmcnt(" #n ")" ::: "memory")
#define PG8_BAR __builtin_amdgcn_s_barrier()
#define PG8_SCHED __builtin_amdgcn_sched_barrier(0)
    Unit cur, nxt; int ui = 0;
    if (!S.next(0, cur)) return;
    f32x4 acc[2][2][4][2];
#pragma unroll
    for (int a = 0; a < 2; ++a)
#pragma unroll
        for (int b = 0; b < 2; ++b)
#pragma unroll
            for (int m = 0; m < 4; ++m)
#pragma unroll
                for (int n = 0; n < 2; ++n) acc[a][b][m][n] = (f32x4){0.f, 0.f, 0.f, 0.f};
    bf16x8 At[4][2], B0[2][2], B1[2][2];
    const char* cA = (const char*)g.A + (size_t)cur.pm * tstep; const char* cB = (const char*)g.Bt + (size_t)cur.pn * tstep;
    S.a_ready(cur);
    if constexpr (SP2) {
        PG8_STAGE(PG8_SB(0, 0), cB, voffB); PG8_STAGE(PG8_SB(0, 1), cB + hstep, voffB); PG8_STAGE(PG8_SA(0, 0), cA, voffA); PG8_STAGE(PG8_SA(0, 1), cA + hstep, voffA);
        if (wr == 1) PG8_BAR;
        PG8_WAIT_V(2); PG8_BAR;
        PG8_STAGE(PG8_SB(1, 0), cB + kstep, voffB); PG8_STAGE(PG8_SA(1, 0), cA + kstep, voffA); PG8_STAGE(PG8_SB(1, 1), cB + hstep + kstep, voffB);
        PG8_WAIT_V(6); PG8_BAR;
    } else {
        PG8_STAGE(PG8_SB(0, 0), cB, voffB); PG8_STAGE(PG8_SA(0, 0), cA, voffA); PG8_STAGE(PG8_SB(0, 1), cB + hstep, voffB); PG8_STAGE(PG8_SA(0, 1), cA + hstep, voffA);
        if (wr == 1) PG8_BAR;
        PG8_WAIT_V(4); PG8_BAR;
        PG8_STAGE(PG8_SB(1, 0), cB + kstep, voffB); PG8_STAGE(PG8_SA(1, 0), cA + kstep, voffA); PG8_STAGE(PG8_SB(1, 1), cB + hstep + kstep, voffB);
        PG8_WAIT_V(6); PG8_BAR;
    }
    for (;;) {
        const bool has_next = S.next(ui + 1, nxt);
        const char* nA = has_next ? (const char*)g.A + (size_t)nxt.pm * tstep : cA; const char* nB = has_next ? (const char*)g.Bt + (size_t)nxt.pn * tstep : cB;
        for (int t = 0; t < nt; t += 2) {
            const bool last = (t == nt - 2);
            const char* a1 = cA + (size_t)(t + 1) * kstep;
            const char* a2 = last ? nA : cA + (size_t)(t + 2) * kstep; const char* b2 = last ? nB : cB + (size_t)(t + 2) * kstep;
            const char* a3 = a2 + kstep; const char* b3 = b2 + kstep;
            if (last && has_next) S.a_ready(nxt);
            if constexpr (SP2) {
            PG8_LDB(B0, 0, 0); PG8_LDB(B1, 0, 1); PG8_SCHED; PG8_LDA(At, 0, 0); PG8_STAGE(PG8_SA(1, 1), a1 + hstep, voffA);
            PG8_WAIT_V(8); PG8_WAIT_L(0); PG8_BAR; PG8_MMA(0, 0, At, B0); PG8_MMA(0, 1, At, B1); PG8_BAR; PG8_SCHED;
            PG8_LDA(At, 0, 1); PG8_STAGE(PG8_SB(0, 0), b2, voffB); PG8_STAGE(PG8_SB(0, 1), b2 + hstep, voffB); PG8_STAGE(PG8_SA(0, 0), a2, voffA);
            PG8_WAIT_V(8); PG8_WAIT_L(0); PG8_BAR; PG8_MMA(1, 0, At, B0); PG8_MMA(1, 1, At, B1); PG8_BAR; PG8_SCHED;
            PG8_LDB(B0, 1, 0); PG8_LDB(B1, 1, 1); PG8_SCHED; PG8_LDA(At, 1, 0); PG8_STAGE(PG8_SA(0, 1), a2 + hstep, voffA);
            PG8_WAIT_V(8); PG8_WAIT_L(0); PG8_BAR; PG8_MMA(0, 0, At, B0); PG8_MMA(0, 1, At, B1); PG8_BAR; PG8_SCHED;
            PG8_LDA(At, 1, 1); PG8_STAGE(PG8_SB(1, 0), b3, voffB); PG8_STAGE(PG8_SB(1, 1), b3 + hstep, voffB); PG8_STAGE(PG8_SA(1, 0), a3, voffA);
            PG8_WAIT_V(8); PG8_WAIT_L(0); PG8_BAR; PG8_MMA(1, 0, At, B0); PG8_MMA(1, 1, At, B1); PG8_BAR; PG8_SCHED;
            } else {
            PG8_LDB(B0, 0, 0); PG8_SCHED; PG8_LDA(At, 0, 0); PG8_STAGE(PG8_SA(1, 1), a1 + hstep, voffA);
            PG8_WAIT_L(8); PG8_BAR; PG8_WAIT_L(0); PG8_MMA(0, 0, At, B0); PG8_BAR; PG8_SCHED;
            PG8_LDB(B1, 0, 1); PG8_STAGE(PG8_SB(0, 0), b2, voffB);
            PG8_BAR; PG8_WAIT_L(0); PG8_MMA(0, 1, At, B1); PG8_BAR;
            PG8_LDA(At, 0, 1); PG8_STAGE(PG8_SA(0, 0), a2, voffA);
            PG8_BAR; PG8_WAIT_L(0); PG8_MMA(1, 0, At, B0); PG8_BAR; PG8_SCHED;
            PG8_STAGE(PG8_SB(0, 1), b2 + hstep, voffB);
            PG8_WAIT_V(6); PG8_BAR; PG8_MMA(1, 1, At, B1); PG8_BAR;
            PG8_LDB(B0, 1, 0); PG8_SCHED; PG8_LDA(At, 1, 0); PG8_STAGE(PG8_SA(0, 1), a2 + hstep, voffA);
            PG8_WAIT_L(8); PG8_BAR; PG8_WAIT_L(0); PG8_MMA(0, 0, At, B0); PG8_BAR; PG8_SCHED;
            PG8_LDB(B1, 1, 1); PG8_STAGE(PG8_SB(1, 0), b3, voffB);
            PG8_BAR; PG8_WAIT_L(0); PG8_MMA(0, 1, At, B1); PG8_BAR;
            PG8_LDA(At, 1, 1); PG8_STAGE(PG8_SA(1, 0), a3, voffA);
            PG8_BAR; PG8_WAIT_L(0); PG8_MMA(1, 0, At, B0); PG8_BAR; PG8_SCHED;
            PG8_STAGE(PG8_SB(1, 1), b3 + hstep, voffB);
            PG8_WAIT_V(6); PG8_BAR; PG8_MMA(1, 1, At, B1); PG8_BAR;
            }
        }
        if constexpr (ALIGN_EPI) { if (wr == 0) PG8_BAR; }
        if constexpr (!Epi::AFTER_DRAIN) { E(acc, cur, wr, wc, fr, fq); S.done(cur); }
        if (!has_next) break;
#pragma unroll
        for (int a = 0; a < 2; ++a)
#pragma unroll
            for (int b = 0; b < 2; ++b)
#pragma unroll
                for (int m = 0; m < 4; ++m)
#pragma unroll
                    for (int n = 0; n < 2; ++n) acc[a][b][m][n] = (f32x4){0.f, 0.f, 0.f, 0.f};
        cur = nxt; cA = nA; cB = nB; ++ui;
        if constexpr (ALIGN_EPI) { if (wr == 1) PG8_BAR; }
    }
    PG8_WAIT_V(0);
    if constexpr (!ALIGN_EPI) { if (wr == 0) PG8_BAR; }
    PG8_BAR;
    if constexpr (Epi::AFTER_DRAIN) { E.fused(acc, cur, wr, wc, fr, fq, lds, wid, lane); S.done(cur); }
#undef PG8_SA
#undef PG8_SB
#undef PG8_STAGE
#undef PG8_LDA
#undef PG8_LDB
#undef PG8_MMA
#undef PG8_WAIT_V
#undef PG8_WAIT_L
#undef PG8_BAR
#undef PG8_SCHED
}
}

namespace attn_body {
using bf16=__hip_bfloat16;
using bf16x8=__attribute__((ext_vector_type(8)))short;
using s16x4=__attribute__((ext_vector_type(4)))short;
using f32x16=__attribute__((ext_vector_type(16)))float;
using u32x4=__attribute__((ext_vector_type(4)))unsigned;
constexpr int D=64;
constexpr int NW=8,QBLK=32,QB=QBLK*NW,KVBLK=64;
__device__ __forceinline__ int crow(int r,int hi){return (r&3)+8*(r>>2)+4*hi;}
#define SBAR() __builtin_amdgcn_sched_barrier(0)
__device__ __forceinline__ void cmask(f32x16&p0,f32x16&p1,int jb,int qrel,int hi){
  const float NEG=-INFINITY; int kb=64*jb+4*hi;
  #pragma unroll
  for(int r=0;r<16;++r){int kv=kb+(r&3)+8*(r>>2); if(kv>qrel)p0[r]=NEG; if(kv+32>qrel)p1[r]=NEG;}
}

constexpr int NSLOT=3, SLOTB=8192;
constexpr int LDS_K=0, LDS_V=NSLOT*SLOTB, LDS_WS=2*NSLOT*SLOTB, LDS_OST=LDS_WS+NW*64*4, LDS_BYTES=LDS_OST+NW*4096;
constexpr float C2=0.125f*1.4426950408889634f;
__device__ __forceinline__ void glds16(const void*gsrc,unsigned lds_dst){unsigned keep;
  asm volatile("s_mov_b32 %0, m0\n\ts_mov_b32 m0, %2\n\ts_nop 0\n\tglobal_load_lds_dwordx4 %1, off\n\ts_mov_b32 m0, %0":"=&s"(keep):"v"(gsrc),"s"(lds_dst):"memory");}
__device__ __forceinline__ float max3f(float a,float b,float c){float r;asm("v_max3_f32 %0, %1, %2, %3":"=v"(r):"v"(a),"v"(b),"v"(c));return r;}
__device__ __forceinline__ float max2f(float a,float b){float r;asm("v_max_f32_e32 %0, %1, %2":"=v"(r):"v"(a),"v"(b));return r;}
__device__ __forceinline__ float fadd_s(float a,float b){float r;asm("v_add_f32_e32 %0, %1, %2":"=v"(r):"v"(a),"v"(b));return r;}
__device__ __forceinline__ float fsub_s(float a,float b){float r;asm("v_sub_f32_e32 %0, %1, %2":"=v"(r):"v"(a),"v"(b));return r;}
typedef float f32x2_t __attribute__((ext_vector_type(2))); typedef __bf16 bf16x2_t __attribute__((ext_vector_type(2)));
__device__ __forceinline__ unsigned cvtpk_s(float lo,float hi){f32x2_t v={lo,hi};bf16x2_t b=__builtin_convertvector(v,bf16x2_t);return __builtin_bit_cast(unsigned,b);}
#define WAIT_BAR(N) asm volatile("s_waitcnt vmcnt(" #N ") lgkmcnt(0)\n\ts_barrier":::"memory")

__device__ __forceinline__ void qkt(f32x16&p0,f32x16&p1,const char*Kslot,const bf16x8*qr,const f32x16&negm,int r32,int hi){
  const char*kb=Kslot+hi*1024+r32*16;
  #pragma unroll
  for(int d0=0;d0<4;++d0){
    const bf16x8 b0=*reinterpret_cast<const bf16x8*>(kb+d0*2048);
    const bf16x8 b1=*reinterpret_cast<const bf16x8*>(kb+d0*2048+512);
    if(d0==0){p0=__builtin_amdgcn_mfma_f32_32x32x16_bf16(b0,qr[0],negm,0,0,0);p1=__builtin_amdgcn_mfma_f32_32x32x16_bf16(b1,qr[0],negm,0,0,0);}
    else{p0=__builtin_amdgcn_mfma_f32_32x32x16_bf16(b0,qr[d0],p0,0,0,0);p1=__builtin_amdgcn_mfma_f32_32x32x16_bf16(b1,qr[d0],p1,0,0,0);}}
}
typedef __attribute__((address_space(3))) const char* lds_cptr;
typedef short v4i16_t __attribute__((ext_vector_type(4)));
__device__ __forceinline__ void kload8(bf16x8*kf,lds_cptr kp){
  kf[0]=*(const __attribute__((address_space(3))) bf16x8*)(kp);      kf[1]=*(const __attribute__((address_space(3))) bf16x8*)(kp+512);
  kf[2]=*(const __attribute__((address_space(3))) bf16x8*)(kp+2048); kf[3]=*(const __attribute__((address_space(3))) bf16x8*)(kp+2560);
  kf[4]=*(const __attribute__((address_space(3))) bf16x8*)(kp+4096); kf[5]=*(const __attribute__((address_space(3))) bf16x8*)(kp+4608);
  kf[6]=*(const __attribute__((address_space(3))) bf16x8*)(kp+6144); kf[7]=*(const __attribute__((address_space(3))) bf16x8*)(kp+6656);
}
__device__ __forceinline__ void kload2(bf16x8*kf,lds_cptr kp,int j){ kf[2*j]=*(const __attribute__((address_space(3))) bf16x8*)(kp+j*2048); kf[2*j+1]=*(const __attribute__((address_space(3))) bf16x8*)(kp+j*2048+512); }
__device__ __forceinline__ s16x4 vtr(lds_cptr p){ return __builtin_bit_cast(s16x4,__builtin_amdgcn_ds_read_tr16_b64_v4i16((__attribute__((address_space(3))) v4i16_t*)p)); }
__device__ __forceinline__ float rowmax(const f32x16&p0,const f32x16&p1){
  float a=max3f(p0[0],p0[1],p1[0]),b=max3f(p0[2],p0[3],p1[1]);a=max3f(a,p1[2],p1[3]);
  #pragma unroll
  for(int r=4;r<16;r+=4){a=max3f(a,p0[r],p0[r+1]);b=max3f(b,p0[r+2],p0[r+3]);a=max3f(a,p1[r],p1[r+1]);b=max3f(b,p1[r+2],p1[r+3]);}
  const float m=max2f(a,b);
  auto rr=__builtin_amdgcn_permlane32_swap(__float_as_uint(m),__float_as_uint(m),false,false);
  return max2f(__uint_as_float(rr[0]),__uint_as_float(rr[1]));
}
__device__ __forceinline__ void pv(f32x16*o,int vb,bf16x8 pa0,bf16x8 pa1,bf16x8 pa2,bf16x8 pa3){
  #pragma unroll
  for(int d0=0;d0<2;++d0){s16x4 lo[4],hi[4];
    #pragma unroll
    for(int ks=0;ks<4;++ks){
      asm volatile("ds_read_b64_tr_b16 %0,%1 offset:%c2":"=&v"(lo[ks]):"v"(vb),"i"(d0*4096+ks*1024):"memory");
      asm volatile("ds_read_b64_tr_b16 %0,%1 offset:%c2":"=&v"(hi[ks]):"v"(vb),"i"(d0*4096+ks*1024+512):"memory");}
    asm volatile("s_waitcnt lgkmcnt(0)":::"memory");SBAR();
    #define PK(k) (bf16x8){lo[k][0],lo[k][1],lo[k][2],lo[k][3],hi[k][0],hi[k][1],hi[k][2],hi[k][3]}
    o[d0]=__builtin_amdgcn_mfma_f32_32x32x16_bf16(pa0,PK(0),o[d0],0,0,0);
    o[d0]=__builtin_amdgcn_mfma_f32_32x32x16_bf16(pa1,PK(1),o[d0],0,0,0);
    o[d0]=__builtin_amdgcn_mfma_f32_32x32x16_bf16(pa2,PK(2),o[d0],0,0,0);
    o[d0]=__builtin_amdgcn_mfma_f32_32x32x16_bf16(pa3,PK(3),o[d0],0,0,0);
    #undef PK
  }
}

#ifndef ATTN_STORE16
#define ATTN_STORE16(p,v) (*(u32x4*)(p)=(v))
#endif
template<int DV2,int P,int OP,int MODE> __device__ __forceinline__ void attn_unit2(const bf16*Q0,const bf16*__restrict__ Kh,const bf16*__restrict__ Vh,bf16*O0,const int NT,char*shm,const float*rpbh,const int gr0,
    const bool pre,const bool has_next,const bf16*__restrict__ Khn,const bf16*__restrict__ Vhn){
  const int tid=threadIdx.x,lane=tid&63,r32=lane&31,hi=lane>>5; const int wid=__builtin_amdgcn_readfirstlane(tid>>6);
  const bf16*Qw=Q0+(long)(wid*QBLK)*P;
  constexpr int VSL=DV2, LWS_=LDS_V+NSLOT*SLOTB*DV2, LOST_=LWS_+NW*64*4;
  const unsigned lds0=(unsigned)(uintptr_t)shm;
  float*wsf=(float*)(shm+LWS_)+wid*64;
  const bf16*ksrc=Kh+(long)lane*P+wid*8;
  const bf16*vsrc=Vh+(long)(16*(wid&3)+(lane>>2))*P+(wid>>2)*32+(lane&3)*8;
  const unsigned kdst=lds0+LDS_K+wid*1024, vdst=lds0+LDS_V+wid*1024;
  #define TROW(t) (MODE==1?((t)<4?(t)*64:nb0+(t)*64):(t)*64)
  #define DMA_K(t,slot) glds16(ksrc+(long)TROW(t)*P,(unsigned)__builtin_amdgcn_readfirstlane(kdst+(slot)))
  #define DMA_V(t,slot) do{ glds16(vsrc+(long)TROW(t)*P,(unsigned)__builtin_amdgcn_readfirstlane(vdst+(slot)*VSL)); \
    if constexpr(DV2==2) glds16(vsrc+64+(long)TROW(t)*P,(unsigned)__builtin_amdgcn_readfirstlane(vdst+(slot)*VSL+8192)); }while(0)
  const int vb0=(int)(lds0+LDS_V)+((lane>>4)&1)*32+(lane&3)*8+(4*hi+((lane&15)>>2))*64;
  const char*Kbase=shm+LDS_K; bf16x8 kf[8];
  const lds_cptr shm3=(lds_cptr)shm; const lds_cptr kp0=shm3+LDS_K+hi*1024+r32*16; const lds_cptr vp0=shm3+LDS_V+((lane>>4)&1)*32+(lane&3)*8+(4*hi+((lane&15)>>2))*64;
  const int rbase=min(max(gr0-4,0),116), nb0=256+rbase*64-256;
  const int qrow=gr0+(wid>>1), r0q=min(max(qrow-4,0),120), qc=32*(wid&1)+r32, c0q=min(max(qc-8,0),48);
  const int cb=15-qc+4*hi, kvb=4*hi-c0q;
  typedef __attribute__((address_space(3))) float* lds_fptr;
  const lds_fptr btab=(lds_fptr)(shm3+LOST_+NW*4096);
  if constexpr(MODE==1){ if(tid<465) btab[tid]=rpbh[tid]*1.4426950408889634f; }
  if(!pre){DMA_K(0,0);DMA_V(0,0);DMA_K(1,SLOTB);}
  bf16x8 qr[4];
  #pragma unroll
  for(int d0=0;d0<4;++d0)qr[d0]=*reinterpret_cast<const bf16x8*>(&Qw[(long)r32*P+d0*16+hi*8]);
  float l_reg=0.f;f32x16 o[2*DV2];
  #pragma unroll
  for(int i=0;i<2*DV2;++i)o[i]=f32x16{};
  const f32x16 zero16=f32x16{};
  #define CMASK(P0,P1,t) do{ if constexpr(MODE==1){ if((t)>=4){ const int kr_=rbase+(t)-4; const bool rv_=(unsigned)(kr_-r0q)<8u; const lds_fptr bt_=btab+(rv_?(kr_-qrow+7):0)*31+cb; \
      _Pragma("unroll") for(int r=0;r<16;++r){ const int kv_=(r&3)+8*(r>>2); const bool v0_=rv_&&((unsigned)(kv_+kvb)<16u), v1_=rv_&&((unsigned)(kv_+32+kvb)<16u); \
        const float b0_=bt_[kv_], b1_=bt_[kv_+32]; P0[r]=v0_?P0[r]+b0_:-INFINITY; P1[r]=v1_?P1[r]+b1_:-INFINITY; } } } }while(0)
  #define START(P0,P1) do{ _Pragma("unroll") for(int r=0;r<16;++r)P0[r]=__builtin_amdgcn_exp2f(P0[r]); }while(0)
  #define RESC() do{}while(0)
  f32x16 pA0,pA1,pB0,pB1;
  #define WAIT_K1V() do{ if constexpr(DV2==2){WAIT_BAR(3);} else {WAIT_BAR(2);} }while(0)
  #define WAIT_V1() do{ if constexpr(DV2==2){WAIT_BAR(2);} else {WAIT_BAR(1);} }while(0)
  int sl_prev=0,sl_cur=0,sl_next=SLOTB;
  #define ROT() do{sl_prev=sl_cur;sl_cur=sl_next;sl_next=(sl_next==(NSLOT-1)*SLOTB)?0:sl_next+SLOTB;}while(0)
  if(!pre)DMA_K(2,2*SLOTB);
  WAIT_BAR(3);
  qkt(pA0,pA1,Kbase,qr,zero16,r32,hi);asm volatile("s_nop 15\n\ts_nop 7":"+v"(pA0),"+v"(pA1));CMASK(pA0,pA1,0);
  START(pA0,pA1);
  _Pragma("unroll") for(int r=0;r<16;++r)pA1[r]=__builtin_amdgcn_exp2f(pA1[r]);
  WAIT_BAR(0);
  DMA_K(3,0);DMA_V(1,SLOTB);
  ROT();
  kload8(kf,kp0+sl_cur);
  WAIT_K1V();
  s16x4 vlo[8],vhi[8]; u32x4 pw0,pw1,pw2,pw3;
  #define PKW(P,B) cvtpk_s(P[B],P[B+1])
  #define PAF(k) __builtin_bit_cast(bf16x8,pw##k)
  #define VFR(i) (bf16x8){vlo[i][0],vlo[i][1],vlo[i][2],vlo[i][3],vhi[i][0],vhi[i][1],vhi[i][2],vhi[i][3]}
  #define PIN(x) asm volatile("":"+v"(x))
  #define MX3(a,b,c) __builtin_fmaxf(__builtin_fmaxf((a),(b)),(c))
  #define GAPA(MF,A0,A1,A2,A3,W0,W1,PW) do{ MF; sacc+=A0; sacc+=A1; sacc+=A2; sacc+=A3; PIN(sacc); W0; W1; PIN(PW); SBAR(); }while(0)
  #define EX(v) __builtin_amdgcn_exp2f(v)
  #define GAPB(MF,X,B) do{ MF; X[B]=EX(X[B]); X[B+1]=EX(X[B+1]); X[B+2]=EX(X[B+2]); X[B+3]=EX(X[B+3]); PIN(X); SBAR(); }while(0)
  #define VRD(i) do{ vlo[i]=vtr(vp_+(((i)>>2)*4096+((i)&3)*1024)); vhi[i]=vtr(vp_+(((i)>>2)*4096+((i)&3)*1024+512)); }while(0)
  #define KRD(G,j) do{ if(G){ kload2(kf,kp0+sl_next,j); SBAR(); } }while(0)
  #define H1MF(oi,k,i) do{ if constexpr(DV2==2){ o[oi]=__builtin_amdgcn_mfma_f32_32x32x16_bf16(PAF(k),VFR(i),o[oi],0,0,0); } }while(0)
  #define VRDH(i) do{ if constexpr(DV2==2){ vlo[i]=vtr(vp_+(8192+((i)>>2)*4096+((i)&3)*1024)); vhi[i]=vtr(vp_+(8192+((i)>>2)*4096+((i)&3)*1024+512)); } }while(0)
  #define STEP(C0,C1,P0,P1,t,GK,GV,GL) do{ SBAR(); \
    const lds_cptr vp_=vp0+sl_prev*VSL; \
    VRD(0); SBAR(); float sacc=(P0[0]+P0[1]); \
    GAPA(C0=__builtin_amdgcn_mfma_f32_32x32x16_bf16(kf[0],qr[0],zero16,0,0,0), P0[2],P0[3],P0[4],P0[5],     pw0[0]=PKW(P0,0), pw0[1]=PKW(P0,2), pw0); \
    VRD(4); SBAR(); GAPA(C1=__builtin_amdgcn_mfma_f32_32x32x16_bf16(kf[1],qr[0],zero16,0,0,0), P0[6],P0[7],P0[8],P0[9],     pw0[2]=PKW(P0,4), pw0[3]=PKW(P0,6), pw0); \
    VRD(1); SBAR(); GAPA(C0=__builtin_amdgcn_mfma_f32_32x32x16_bf16(kf[2],qr[1],C0,0,0,0),   P0[10],P0[11],P0[12],P0[13], pw1[0]=PKW(P0,8), pw1[1]=PKW(P0,10), pw1); \
    VRD(5); SBAR(); GAPA(C1=__builtin_amdgcn_mfma_f32_32x32x16_bf16(kf[3],qr[1],C1,0,0,0),   P0[14],P0[15],P1[0],P1[1],   pw1[2]=PKW(P0,12),pw1[3]=PKW(P0,14), pw1); \
    VRD(2); SBAR(); GAPA(C0=__builtin_amdgcn_mfma_f32_32x32x16_bf16(kf[4],qr[2],C0,0,0,0),   P1[2],P1[3],P1[4],P1[5],     pw2[0]=PKW(P1,0), pw2[1]=PKW(P1,2), pw2); \
    VRD(6); SBAR(); GAPA(C1=__builtin_amdgcn_mfma_f32_32x32x16_bf16(kf[5],qr[2],C1,0,0,0),   P1[6],P1[7],P1[8],P1[9],     pw2[2]=PKW(P1,4), pw2[3]=PKW(P1,6), pw2); \
    VRD(3); SBAR(); GAPA(C0=__builtin_amdgcn_mfma_f32_32x32x16_bf16(kf[6],qr[3],C0,0,0,0),   P1[10],P1[11],P1[12],P1[13], pw3[0]=PKW(P1,8), pw3[1]=PKW(P1,10), pw3); \
    VRD(7); SBAR(); GAPA(C1=__builtin_amdgcn_mfma_f32_32x32x16_bf16(kf[7],qr[3],C1,0,0,0),   P1[14],P1[15],0.f,0.f,       pw3[2]=PKW(P1,12),pw3[3]=PKW(P1,14), pw3); \
    l_reg+=sacc; \
    if(GK){DMA_K((t)+3,sl_cur);} if(GV){DMA_V((t)+1,sl_next);} \
    CMASK(C0,C1,t); \
    SBAR(); \
    GAPB(o[0]=__builtin_amdgcn_mfma_f32_32x32x16_bf16(PAF(0),VFR(0),o[0],0,0,0); VRDH(0), C0,0); \
    GAPB(o[1]=__builtin_amdgcn_mfma_f32_32x32x16_bf16(PAF(0),VFR(4),o[1],0,0,0); VRDH(4), C0,4); \
    KRD(GL,0); GAPB(o[0]=__builtin_amdgcn_mfma_f32_32x32x16_bf16(PAF(1),VFR(1),o[0],0,0,0); H1MF(2,0,0); VRDH(1), C0,8); \
    KRD(GL,1); GAPB(o[1]=__builtin_amdgcn_mfma_f32_32x32x16_bf16(PAF(1),VFR(5),o[1],0,0,0); H1MF(3,0,4); VRDH(5), C0,12); \
    KRD(GL,2); GAPB(o[0]=__builtin_amdgcn_mfma_f32_32x32x16_bf16(PAF(2),VFR(2),o[0],0,0,0); H1MF(2,1,1); VRDH(2), C1,0); \
    KRD(GL,3); GAPB(o[1]=__builtin_amdgcn_mfma_f32_32x32x16_bf16(PAF(2),VFR(6),o[1],0,0,0); H1MF(3,1,5); VRDH(6), C1,4); \
    GAPB(o[0]=__builtin_amdgcn_mfma_f32_32x32x16_bf16(PAF(3),VFR(3),o[0],0,0,0); H1MF(2,2,2); VRDH(3), C1,8); \
    GAPB(o[1]=__builtin_amdgcn_mfma_f32_32x32x16_bf16(PAF(3),VFR(7),o[1],0,0,0); H1MF(3,2,6); VRDH(7), C1,12); \
    if constexpr(DV2==2){ H1MF(2,3,3); H1MF(3,3,7); SBAR(); } \
    }while(0)
  int t=1;
  for(;t+5<NT;t+=2){
    STEP(pB0,pB1,pA0,pA1,t,true,true,true);     WAIT_K1V(); RESC(); ROT();
    STEP(pA0,pA1,pB0,pB1,t+1,true,true,true);   WAIT_K1V(); RESC(); ROT();
  }
  #define ENDW(tt) do{ if((tt)+3<NT){WAIT_K1V();} else if((tt)+2<NT){WAIT_V1();} else {WAIT_BAR(0);} }while(0)
  for(;t+1<NT;t+=2){
    STEP(pB0,pB1,pA0,pA1,t,(t+3<NT),(t+1<NT),(t+1<NT));       ENDW(t);   RESC(); ROT();
    STEP(pA0,pA1,pB0,pB1,t+1,(t+4<NT),(t+2<NT),(t+2<NT));     ENDW(t+1); RESC(); ROT();
  }
  STEP(pB0,pB1,pA0,pA1,NT-1,false,false,false); RESC();
  { float sacc=pB0[0]+pB0[1]; _Pragma("unroll") for(int r=2;r<16;++r)sacc+=pB0[r]; _Pragma("unroll") for(int r=0;r<16;++r)sacc+=pB1[r]; l_reg+=sacc;
    pw0=(u32x4){PKW(pB0,0),PKW(pB0,2),PKW(pB0,4),PKW(pB0,6)};pw1=(u32x4){PKW(pB0,8),PKW(pB0,10),PKW(pB0,12),PKW(pB0,14)};pw2=(u32x4){PKW(pB1,0),PKW(pB1,2),PKW(pB1,4),PKW(pB1,6)};pw3=(u32x4){PKW(pB1,8),PKW(pB1,10),PKW(pB1,12),PKW(pB1,14)};
    SBAR(); pv(o,vb0+sl_cur*VSL,PAF(0),PAF(1),PAF(2),PAF(3)); if constexpr(DV2==2) pv(o+2,vb0+sl_cur*VSL+8192,PAF(0),PAF(1),PAF(2),PAF(3)); }
  #undef PKW
  #undef PAF
  #undef VFR
  #undef PIN
  #undef MX3
  #undef GAPA
  #undef GAPB
  #undef EX
  #undef VRD
  #undef KRD
  #undef STEP
  #undef ENDW
  asm volatile("s_waitcnt lgkmcnt(0)\n\ts_barrier":::"memory");
  if(has_next){ const bf16*ksn=Khn+(long)lane*P+wid*8; const bf16*vsn=Vhn+(long)(16*(wid&3)+(lane>>2))*P+(wid>>2)*32+(lane&3)*8;
    glds16(ksn,(unsigned)__builtin_amdgcn_readfirstlane(kdst)); glds16(vsn,(unsigned)__builtin_amdgcn_readfirstlane(vdst));
    if constexpr(DV2==2) glds16(vsn+64,(unsigned)__builtin_amdgcn_readfirstlane(vdst+8192));
    glds16(ksn+(long)64*P,(unsigned)__builtin_amdgcn_readfirstlane(kdst+SLOTB)); glds16(ksn+(long)128*P,(unsigned)__builtin_amdgcn_readfirstlane(kdst+2*SLOTB)); }
  {auto rr=__builtin_amdgcn_permlane32_swap(__float_as_uint(l_reg),__float_as_uint(l_reg),false,false);l_reg=__uint_as_float(rr[0])+__uint_as_float(rr[1]);}
  if(hi==0)wsf[32+r32]=l_reg;asm volatile("s_waitcnt lgkmcnt(0)":::"memory");
  float rli[16];
  #pragma unroll
  for(int r=0;r<16;++r)rli[r]=__builtin_amdgcn_rcpf(wsf[32+crow(r,hi)]);
  bf16*Ow=O0+(long)(wid*QBLK)*OP;
  { bf16*stg=(bf16*)(shm+LOST_)+wid*2048;
    #pragma unroll
    for(int hh=0;hh<DV2;++hh){
      #pragma unroll
      for(int r=0;r<16;++r){const int orow=crow(r,hi);
        #pragma unroll
        for(int d0=0;d0<2;++d0)stg[orow*64+d0*32+r32]=__float2bfloat16(o[2*hh+d0][r]*rli[r]);}
      asm volatile("s_waitcnt lgkmcnt(0)":::"memory");
      #pragma unroll
      for(int i=0;i<4;++i){const int row=i*8+(lane>>3),ch=lane&7; const u32x4 v=*(const u32x4*)(stg+row*64+ch*8); ATTN_STORE16(Ow+(long)row*OP+hh*64+ch*8,v);}
      asm volatile("s_waitcnt lgkmcnt(0)":::"memory"); } }
  asm volatile("s_waitcnt lgkmcnt(0)\n\ts_barrier":::"memory");
  #undef DMA_K
  #undef DMA_V
  #undef CMASK
  #undef START
  #undef RESC
  #undef ROT
  #undef TROW
  #undef WAIT_K1V
  #undef WAIT_V1
  #undef VRDH
  #undef H1MF
}

#undef SBAR
#undef WAIT_BAR
}

constexpr int NWAVES = 8;
#ifndef DBGZ
#define DBGZ 0
#endif
#ifndef MK_PER_PHASE
#define MK_PER_PHASE 0
#endif

constexpr int NB = 8, TL = 8192, CL = 256, RPB = TL + CL  , MT = NB * RPB  , DM = 1024;
constexpr int N_IN0 = 2560, N_IN1 = 2304, N_WQ = 2048, OD_P = 1536;
constexpr float EPS = 1e-6f, LOG2E = 1.4426950408889634f, QSCALE = 0.125f * 1.4426950408889634f;
constexpr int PH_PER_LAYER = 10, N_PHASES = 1 + 2 * PH_PER_LAYER;

constexpr size_t MiB = 1u << 20;
constexpr size_t WS_CTL = 0, CTL_ZERO_BYTES = 1 * MiB;
constexpr size_t WS_MOD = 1 * MiB;
constexpr size_t WS_ROPE = 2 * MiB;
constexpr size_t WS_WIN0 = 3 * MiB, WS_WOUT0 = 8 * MiB, WS_WQ0 = 10 * MiB, WS_WIN1 = 14 * MiB, WS_WOUT1 = 19 * MiB, WS_WQ1 = 21 * MiB;
constexpr size_t WS_KEYS0 = 25 * MiB, WS_KEYS1 = 25 * MiB + 512 * 1024;
constexpr size_t WS_U0 = 32 * MiB, WS_U1 = 64 * MiB;
constexpr float U_SCALE = 64.f, V_SCALE = 4.f;
constexpr size_t WS_XS = 160 * MiB;
constexpr size_t WS_XN = 424 * MiB;
constexpr size_t WS_PB = 556 * MiB;
constexpr size_t WS_EI = WS_PB + 264 * MiB, WS_EG = WS_EI + 33 * MiB;
constexpr size_t WS_END = 886 * MiB;
static_assert((size_t)MT * 1024 * 4 == 264 * MiB && (size_t)MT * 2560 * 2 == 330 * MiB && (size_t)MT * 128 * 4 == 33 * MiB, "ws map");
constexpr int CW_TMO = 0, CW_BAR = 4096;

constexpr int RING_BYTES = 131072, LDSCTL_OFF = RING_BYTES, MISC_OFF = LDSCTL_OFF + 320, LDS_BYTES = 147456;

#define GAS __attribute__((address_space(1)))
#define LAS __attribute__((address_space(3)))
typedef unsigned short bf16;
typedef unsigned v4u __attribute__((ext_vector_type(4)));
typedef unsigned v2u __attribute__((ext_vector_type(2)));
typedef float f32x4 __attribute__((ext_vector_type(4)));
typedef float f32x16 __attribute__((ext_vector_type(16)));
typedef short bf16x8 __attribute__((ext_vector_type(8)));
typedef __bf16 bf16x2v __attribute__((ext_vector_type(2)));
typedef GAS unsigned gu32;
#define RLX_AGENT __ATOMIC_RELAXED, __HIP_MEMORY_SCOPE_AGENT
__device__ __forceinline__ unsigned f2bf(float f) { unsigned u = __builtin_bit_cast(unsigned, f); return (u + 0x7fffu + ((u >> 16) & 1u)) >> 16; }
__device__ __forceinline__ unsigned pk2(float lo, float hi) { return f2bf(lo) | (f2bf(hi) << 16); }
__device__ __forceinline__ float bflo(unsigned u) { return __builtin_bit_cast(float, u << 16); }
__device__ __forceinline__ float bfhi(unsigned u) { return __builtin_bit_cast(float, u & 0xffff0000u); }
__device__ __forceinline__ float bf1(bf16 h) { return __builtin_bit_cast(float, (unsigned)h << 16); }
__device__ __forceinline__ float wave_sum(float v) {
#pragma unroll
    for (int o = 1; o < 64; o <<= 1) v += __shfl_xor(v, o);
    return v;
}
__device__ __forceinline__ float dot2bf(unsigned w, unsigned x, float acc) { return __builtin_amdgcn_fdot2_f32_bf16(__builtin_bit_cast(bf16x2v, w), __builtin_bit_cast(bf16x2v, x), acc, false); }
__device__ __forceinline__ float fast_exp2(float x) { return __builtin_amdgcn_exp2f(x); }
__device__ __forceinline__ float gelu_erf(float v) {
    const float av = fabsf(v), t = __builtin_amdgcn_rcpf(av * 0.2316418882f + 1.0f);
    float q = t * 0.5307027145f + (-0.7265760135f); q = q * t + 0.7107068705f; q = q * t + (-0.142248368f); q = q * t + 0.127414796f; q = q * t;
    const float e = __builtin_amdgcn_exp2f((v * v) * (-0.72134752044f));
    const float m = v * (q * e);
    return v < 0.f ? m : v - m;
}

#define XB_TMO      128
#define XB_XCNT(j)  (256  + 64 * (j))
#define XB_XSUB(j)  (1280 + 64 * (j))
#define XB_XGEN(j)  (2304 + 64 * (j))
#define XB_TOP      3328
#define XB_TOPGEN   3392
#define XCD_BAR_WORDS 3456
#define XB_SPIN_CAP (1u << 18)

__device__ __forceinline__ unsigned xb_ld(unsigned* p)              { return __hip_atomic_load(p, __ATOMIC_RELAXED, __HIP_MEMORY_SCOPE_AGENT); }
__device__ __forceinline__ unsigned xb_add(unsigned* p, unsigned v) { return __hip_atomic_fetch_add(p, v, __ATOMIC_RELAXED, __HIP_MEMORY_SCOPE_AGENT); }
__device__ __forceinline__ unsigned xb_xcc_id() { return (unsigned)__builtin_amdgcn_s_getreg((3 << 11) | 20) & 0xFu; }
#define XB_SPIN(cond, bar) do { unsigned _sp = 0; while (cond) { __builtin_amdgcn_s_sleep(1); \
    if ((++_sp & 255u) == 0u) { if (xb_ld(&(bar)[XB_TMO])) break; if (_sp > XB_SPIN_CAP) { atomicAdd(&(bar)[XB_TMO], 1u); break; } } } } while (0)

struct XcdBarrier {
    unsigned* bar; unsigned x;
    volatile LAS unsigned* st;
};

__device__ __forceinline__ XcdBarrier xcd_barrier_post(unsigned* bar, volatile LAS unsigned* st) {
    XcdBarrier b; b.bar = bar; b.x = xb_xcc_id(); b.st = st;
    if (threadIdx.x == 0) (void)xb_add(&bar[XB_XCNT(b.x)], 1u);
    return b;
}
__device__ __forceinline__ void xcd_barrier_complete(unsigned* bar, unsigned x, unsigned& nloc, unsigned& nx) {
    const unsigned G = gridDim.x * gridDim.y * gridDim.z;
    unsigned sum, cnt, mine, sp = 0u;
    for (;;) {
        sum = 0u; cnt = 0u; mine = 0u;
#pragma unroll
        for (unsigned j = 0; j < 16; ++j) { const unsigned c = xb_ld(&bar[XB_XCNT(j)]); sum += c; cnt += (c > 0u) ? 1u : 0u; mine = (j == x) ? c : mine; }
        if (sum == G) break;
        __builtin_amdgcn_s_sleep(1);
        if ((++sp & 255u) == 0u) { if (xb_ld(&bar[XB_TMO])) break; if (sp > XB_SPIN_CAP) { atomicAdd(&bar[XB_TMO], 1u); break; } }
    }
    nloc = mine > 0u ? mine : 1u; nx = cnt > 0u ? cnt : 1u;
}

__device__ __forceinline__ void xcd_barrier(const XcdBarrier& b) {
    asm volatile("s_waitcnt vmcnt(0)" ::: "memory");
    __syncthreads();
    if (threadIdx.x == 0) {
        unsigned* bar = b.bar;
        __builtin_amdgcn_s_waitcnt(0);
        unsigned nloc = b.st[0], nx = b.st[1];
        if (nloc == 0u) { xcd_barrier_complete(bar, b.x, nloc, nx); b.st[0] = nloc; b.st[1] = nx; }
        const unsigned old = xb_add(&bar[XB_XSUB(b.x)], 1u);
        const unsigned gen = old / nloc;
        if (old + 1u == (gen + 1u) * nloc) {
            __builtin_amdgcn_fence(__ATOMIC_RELEASE, "agent");
            asm volatile("s_waitcnt vmcnt(0)" ::: "memory");
            const unsigned og = xb_add(&bar[XB_TOP], 1u);
            const unsigned tg = og / nx;
            if (og + 1u == (tg + 1u) * nx) xb_add(&bar[XB_TOPGEN], 1u);
            else XB_SPIN(xb_ld(&bar[XB_TOPGEN]) == tg, bar);
            __builtin_amdgcn_fence(__ATOMIC_ACQUIRE, "agent");
            xb_add(&bar[XB_XGEN(b.x)], 1u);
            asm volatile("s_waitcnt vmcnt(0)" ::: "memory");
        } else {
            XB_SPIN(xb_ld(&bar[XB_XGEN(b.x)]) == gen, bar);
            __builtin_amdgcn_fence(__ATOMIC_ACQUIRE, "agent");
            asm volatile("s_waitcnt vmcnt(0)" ::: "memory");
        }
    }
    __syncthreads();
}


struct Frame {
    LAS unsigned char* lds;
    gu32* ctl;
    int tid, lane, wave, vcu, G, gw, NGW;
};

struct Args { const float* in[38]; float* out; unsigned char* ws; int ph_lo, ph_hi, li, pad; };

__device__ __forceinline__ void p0_transpose_item(const float* W, int K, int N, bf16* WT, LAS float* scr, int item, int lane) {
    const int nblk = N / 32, kb = item / nblk, nb = item % nblk, k0 = 64 * kb, n0 = 32 * nb;
#pragma unroll 8
    for (int i = 0; i < 32; ++i) { const int kk = 2 * i + (lane >> 5); scr[kk * 33 + (lane & 31)] = W[(size_t)(k0 + kk) * N + n0 + (lane & 31)]; }
    asm volatile("s_waitcnt lgkmcnt(0)" ::: "memory");
    const int c = lane & 7;
#pragma unroll
    for (int j = 0; j < 4; ++j) { const int n = (lane >> 3) + 8 * j; const LAS float* s = scr + (8 * c) * 33 + n;
        v4u o; o.x = pk2(s[0 * 33], s[1 * 33]); o.y = pk2(s[2 * 33], s[3 * 33]); o.z = pk2(s[4 * 33], s[5 * 33]); o.w = pk2(s[6 * 33], s[7 * 33]);
        *(v4u*)(WT + (size_t)(n0 + n) * K + k0 + 8 * c) = o; }
    asm volatile("s_waitcnt lgkmcnt(0)" ::: "memory");
}
__device__ __forceinline__ void cvt_bf16_stream(const float* src, bf16* dst, size_t n, int gtid, int nthr) {
    for (size_t i = (size_t)gtid * 8; i < n; i += (size_t)nthr * 8) {
        const f32x4 a = *(const f32x4*)(src + i), b = *(const f32x4*)(src + i + 4);
        v4u o; o.x = pk2(a.x, a.y); o.y = pk2(a.z, a.w); o.z = pk2(b.x, b.y); o.w = pk2(b.z, b.w);
        *(v4u*)(dst + i) = o; }
}
__device__ __forceinline__ unsigned enc8_fp4(const float* p, float sc) {
    const f32x4 a = *(const f32x4*)p, b = *(const f32x4*)(p + 4);
    unsigned r = 0;
    r = __builtin_amdgcn_cvt_scalef32_pk_fp4_f32(r, a.x * sc, a.y * sc, 1.0f, 0); r = __builtin_amdgcn_cvt_scalef32_pk_fp4_f32(r, a.z * sc, a.w * sc, 1.0f, 1);
    r = __builtin_amdgcn_cvt_scalef32_pk_fp4_f32(r, b.x * sc, b.y * sc, 1.0f, 2); r = __builtin_amdgcn_cvt_scalef32_pk_fp4_f32(r, b.z * sc, b.w * sc, 1.0f, 3);
    return r; }
__device__ __forceinline__ void cvt_fp4_uv(const float* u, const float* v, unsigned char* dst, int gtid, int nthr) {
#pragma unroll 4
    for (size_t i = (size_t)gtid * 8; i < (size_t)16384 * 1024; i += (size_t)nthr * 8) {
        unsigned char* rowp = dst + (i >> 10) * 1024 + ((i & 1023) >> 1);
        *(unsigned*)rowp = enc8_fp4(u + i, U_SCALE); *(unsigned*)(rowp + 512) = enc8_fp4(v + i, V_SCALE); }
}
__device__ __forceinline__ void sincos_small(double x, double& s, double& c) {
    const double n = __builtin_rint(x * 0.63661977236758134308);
    double r = __builtin_fma(-n, 1.57079632679489655800e+00, x); r = __builtin_fma(-n, 6.12323399573676603587e-17, r);
    const int q = (int)n & 3; const double r2 = r * r;
    const double sp = r * (1.0 + r2 * (-1.0 / 6 + r2 * (1.0 / 120 + r2 * (-1.0 / 5040 + r2 * (1.0 / 362880 + r2 * (-1.0 / 39916800 + r2 * (1.0 / 6227020800.0)))))));
    const double cp = 1.0 + r2 * (-0.5 + r2 * (1.0 / 24 + r2 * (-1.0 / 720 + r2 * (1.0 / 40320 + r2 * (-1.0 / 3628800 + r2 * (1.0 / 479001600 + r2 * (-1.0 / 87178291200.0)))))));
    s = (q == 0) ? sp : (q == 1) ? cp : (q == 2) ? -sp : -cp;
    c = (q == 0) ? cp : (q == 1) ? -sp : (q == 2) ? -cp : sp;
}
__device__ __forceinline__ float inv_freq(int i) {
    const float t[16] = {1.0f, 0.5623413251903491f, 0.31622776601683794f, 0.17782794100389228f, 0.1f, 0.05623413251903491f, 0.031622776601683794f, 0.017782794100389228f,
                         0.01f, 0.005623413251903491f, 0.0031622776601683794f, 0.0017782794100389228f, 0.001f, 0.0005623413251903491f, 0.00031622776601683794f, 0.00017782794100389228f};
    float r = t[0];
#pragma unroll
    for (int k = 1; k < 16; ++k) r = (i == k) ? t[k] : r;
    return r;
}
__device__ __forceinline__ void p0_prologue(const Frame& F, const Args& A) {
    unsigned char* ws = A.ws;
    LAS float* sil = (LAS float*)F.lds;
    for (int i = F.tid; i < 9 * 1024; i += NWAVES * 64) { const int r = i >> 10, k = i & 1023; const float cv = r < 8 ? A.in[1][r * 1024 + k] : A.in[3][k]; sil[i] = cv / (1.0f + fast_exp2(-cv * LOG2E)); }
    __syncthreads();
    LAS float* part = (LAS float*)(F.lds + 110592);
    if (F.vcu < 192) {
        const int layer = F.vcu / 96, col = (F.vcu % 96) * 64 + F.lane;
        const float* W = A.in[layer ? 23 : 4];
        float acc[9];
#pragma unroll
        for (int r = 0; r < 9; ++r) acc[r] = 0.f;
#pragma unroll 1
        for (int k = F.wave * 128; k < F.wave * 128 + 128; k += 16) {
            const float* wk = W + (size_t)k * 6144;
            float w[16];
#pragma unroll
            for (int i = 0; i < 16; ++i) w[i] = wk[(unsigned)(col + i * 6144)];
#pragma unroll
            for (int i = 0; i < 16; i += 4) {
#pragma unroll
                for (int r = 0; r < 9; ++r) { const f32x4 s4 = *(const LAS f32x4*)(sil + r * 1024 + k + i); acc[r] += (s4.x * w[i] + s4.y * w[i + 1]) + (s4.z * w[i + 2] + s4.w * w[i + 3]); }
                __builtin_amdgcn_sched_barrier(0); }
        }
#pragma unroll
        for (int r = 0; r < 9; ++r) part[(F.wave * 9 + r) * 64 + F.lane] = acc[r];
    }
    __syncthreads();
    if (F.vcu < 192 && F.wave == 0) {
        const int layer = F.vcu / 96, col = (F.vcu % 96) * 64 + F.lane;
        const float* bb = A.in[layer ? 24 : 5];
        float* MOD = (float*)(ws + WS_MOD);
#pragma unroll
        for (int r = 0; r < 9; ++r) { float t = bb[col];
#pragma unroll
            for (int w = 0; w < 8; ++w) t += part[(w * 9 + r) * 64 + F.lane];
            MOD[(size_t)(layer * 9 + r) * 6144 + col] = t; }
    }
    { const int g = F.vcu * (NWAVES * 64) + F.tid;
      if (g < 2048) { const int pos = g >> 4, i = g & 15; const float ang = (float)pos * inv_freq(i); double s, c; sincos_small((double)ang, s, c);
          float* RT = (float*)(ws + WS_ROPE); RT[g] = (float)c; RT[2048 + g] = (float)s; } }
    { const int g = F.vcu * (NWAVES * 64) + F.tid;
      if (g < 512) { const int layer = g >> 8, j = (g >> 6) & 3, i = g & 63; const int src = layer ? 29 + j : (j == 0 ? 12 : 13);
          ((float*)(ws + WS_ROPE))[4096 + g] = (layer == 0 && j >= 2) ? 1.0f : A.in[src][i]; } }
    { LAS float* scr = (LAS float*)(F.lds + 40960 + F.wave * 8704);
      constexpr int I0 = 16 * (N_IN0 / 32), I1 = 16 * 32, I2 = 16 * (N_WQ / 32), I3 = 16 * (N_IN1 / 32);
      constexpr int NIT = I0 + I1 + I2 + I3 + I1 + I2;
      for (int it = F.gw; it < NIT; it += F.NGW) {
          int r = it;
          if (r < I0) { p0_transpose_item(A.in[8], 1024, N_IN0, (bf16*)(ws + WS_WIN0), scr, r, F.lane); continue; } r -= I0;
          if (r < I1) { p0_transpose_item(A.in[9], 1024, 1024, (bf16*)(ws + WS_WOUT0), scr, r, F.lane); continue; } r -= I1;
          if (r < I2) { p0_transpose_item(A.in[19], 1024, N_WQ, (bf16*)(ws + WS_WQ0), scr, r, F.lane); continue; } r -= I2;
          if (r < I3) { p0_transpose_item(A.in[27], 1024, N_IN1, (bf16*)(ws + WS_WIN1), scr, r, F.lane); continue; } r -= I3;
          if (r < I1) { p0_transpose_item(A.in[28], 1024, 1024, (bf16*)(ws + WS_WOUT1), scr, r, F.lane); continue; } r -= I1;
          p0_transpose_item(A.in[34], 1024, N_WQ, (bf16*)(ws + WS_WQ1), scr, r, F.lane);
      } }
    { const int gt = F.vcu * (NWAVES * 64) + F.tid, nt = F.G * NWAVES * 64;
      cvt_bf16_stream(A.in[20], (bf16*)(ws + WS_KEYS0), (size_t)8 * 2 * 128 * 128, gt, nt);
      cvt_bf16_stream(A.in[35], (bf16*)(ws + WS_KEYS1), (size_t)8 * 2 * 128 * 128, gt, nt);
      cvt_fp4_uv(A.in[21], A.in[22], ws + WS_U0, gt, nt);
      cvt_fp4_uv(A.in[36], A.in[37], ws + WS_U1, gt, nt); }
}

template <bool FROM_INPUT> __device__ __forceinline__ void norm_mod_phase(const Frame& F, const float* x, const float* ctx, const bf16* XS, const float* gain, const float* sh, const float* sc, bf16* dst, bool lat_only) {
    for (int row = F.gw; row < MT; row += F.NGW) {
        const int b = row / RPB, r = row - b * RPB; const bool cr = r < CL; if (lat_only && cr) continue;
        const int mr = cr ? 8 : b;
        const float* xr = cr ? ctx + ((size_t)b * CL + r) * DM : x + ((size_t)b * TL + (r - CL)) * DM;
        f32x4 v[4]; float s = 0.f;
#pragma unroll
        for (int j = 0; j < 4; ++j) {
            if (FROM_INPUT) v[j] = *(const f32x4*)(xr + 4 * F.lane + 256 * j);
            else { const v2u w = *(const v2u*)(XS + (size_t)row * DM + 4 * F.lane + 256 * j); v[j] = (f32x4){bflo(w.x), bfhi(w.x), bflo(w.y), bfhi(w.y)}; }
            s += (v[j].x * v[j].x + v[j].y * v[j].y) + (v[j].z * v[j].z + v[j].w * v[j].w); }
        const float rs = __builtin_amdgcn_rsqf(wave_sum(s) * (1.f / DM) + EPS);
#pragma unroll
        for (int j = 0; j < 4; ++j) { const int col = 4 * F.lane + 256 * j;
            const f32x4 g = *(const f32x4*)(gain + col), a = *(const f32x4*)(sc + (size_t)mr * 6144 + col), h = *(const f32x4*)(sh + (size_t)mr * 6144 + col);
            const f32x4 y = v[j] * rs * g * (a + 1.0f) + h;
            v2u o; o.x = pk2(y.x, y.y); o.y = pk2(y.z, y.w);
            *(v2u*)(dst + (size_t)row * DM + col) = o; }
    }
}

__device__ __forceinline__ void l0_headnorm_pool_phase(const Frame& F, const Args& A, bf16* PB, bf16* Y, const float* RT) {
    LAS float* wl = (LAS float*)F.lds;
    for (int i = F.tid; i < 4 * 64 * 64; i += NWAVES * 64) wl[i] = A.in[10][i];
    __syncthreads();
    const float* pscale = A.in[11];
    {
        const int l = F.lane, g = l >> 4, hw = 1 << g, d0 = 4 * (l & 15);
        LAS float* ps = (LAS float*)(F.lds + 65536) + F.wave * 256;
        const f32x4 sc4 = *(const f32x4*)(pscale + 4 * l);
        for (int row = F.gw; row < MT; row += F.NGW) {
            const int b = row / RPB, r = row - b * RPB; const bool lat = r >= CL;
            const int pos = lat ? r - CL : r, L = lat ? TL : CL; const size_t segbase = (size_t)b * RPB + (lat ? CL : 0);
            v2u raw[16];
#pragma unroll
            for (int k = 0; k < 16; ++k) { const int p = pos + k - 8; const int pc = min(max(p, 0), L - 1); raw[k] = *(const v2u*)(PB + (segbase + pc) * N_IN0 + 4 * l); }
            f32x4 sum = {0.f, 0.f, 0.f, 0.f};
#pragma unroll
            for (int k = 0; k < 16; ++k) { const int dp = k - 8, p = pos + dp; const bool use = dp >= -hw && dp < hw && p >= 0 && p < L;
                const f32x4 v = {bflo(raw[k].x), bfhi(raw[k].x), bflo(raw[k].y), bfhi(raw[k].y)}; sum = use ? sum + v : sum; }
            const f32x4 self = {bflo(raw[8].x), bfhi(raw[8].x), bflo(raw[8].y), bfhi(raw[8].y)};
            const float rc = 1.0f / (float)(min(pos + hw, L) - max(pos - hw, 0));
            const f32x4 pv = sum * rc - self;
            *(LAS f32x4*)(ps + 4 * l) = pv;
            f32x4 y = {0.f, 0.f, 0.f, 0.f};
#pragma unroll 4
            for (int c = 0; c < 64; c += 4) { const f32x4 p4 = *(const LAS f32x4*)(ps + g * 64 + c);
                const LAS float* wp = wl + (g * 64 + c) * 64 + d0;
                y += p4.x * *(const LAS f32x4*)(wp) + p4.y * *(const LAS f32x4*)(wp + 64) + p4.z * *(const LAS f32x4*)(wp + 128) + p4.w * *(const LAS f32x4*)(wp + 192); }
            y = y * sc4;
            v2u o; o.x = pk2(y.x, y.y); o.y = pk2(y.z, y.w);
            if (DBGZ & 1) { o.x = 0u; o.y = 0u; }
            *(v2u*)(Y + (size_t)row * DM + 4 * l) = o;
        }
    }
    __syncthreads();
}

__device__ __forceinline__ void l0_diff_combine_phase(const Frame& F, const Args& A, const bf16* OD, bf16* Y) {
    const float s1 = wave_sum(A.in[14][F.lane] * A.in[15][F.lane]), s2 = wave_sum(A.in[16][F.lane] * A.in[17][F.lane]);
    const float lam = fast_exp2(s1 * LOG2E) - fast_exp2(s2 * LOG2E) + 0.2f;
    const int l32 = F.lane & 31;
    const f32x4 sub = *(const f32x4*)(A.in[18] + 4 * l32);
    for (int row = F.gw; row < MT; row += F.NGW) {
#pragma unroll
        for (int pass = 0; pass < 3; ++pass) { const int h = pass * 2 + (F.lane >> 5);
            const v2u a = *(const v2u*)(OD + (size_t)row * OD_P + (2 * h) * 128 + 4 * l32), c = *(const v2u*)(OD + (size_t)row * OD_P + (2 * h + 1) * 128 + 4 * l32);
            f32x4 o; o.x = bflo(a.x) - lam * bflo(c.x); o.y = bfhi(a.x) - lam * bfhi(c.x); o.z = bflo(a.y) - lam * bflo(c.y); o.w = bfhi(a.y) - lam * bfhi(c.y);
            float ss = (o.x * o.x + o.y * o.y) + (o.z * o.z + o.w * o.w);
            ss += __shfl_xor(ss, 1); ss += __shfl_xor(ss, 2); ss += __shfl_xor(ss, 4); ss += __shfl_xor(ss, 8); ss += __shfl_xor(ss, 16);
            const float rs = __builtin_amdgcn_rsqf(ss * (1.f / 128) + EPS) * 0.8f;
            v2u w; w.x = pk2(o.x * rs * sub.x, o.y * rs * sub.y); w.y = pk2(o.z * rs * sub.z, o.w * rs * sub.w);
            if (DBGZ & 2) { w.x = 0u; w.y = 0u; }
            *(v2u*)(Y + (size_t)row * DM + 256 + h * 128 + 4 * l32) = w; }
    }
}

constexpr int NCAND = 50;
__device__ __forceinline__ void ce_desc(float& a, float& b) {
    float hi_, lo_; asm("v_max_f32 %0, %2, %3\n\tv_min_f32 %1, %2, %3" : "=&v"(hi_), "=&v"(lo_) : "v"(a), "v"(b)); a = hi_; b = lo_; }
__device__ __forceinline__ float fmax_raw(float a, float b) { float r; asm("v_max_f32 %0, %1, %2" : "=v"(r) : "v"(a), "v"(b)); return r; }
template <int N, int OFF, int NTOT> __device__ __forceinline__ void bitonic_sort_desc(float (&v)[NTOT]) {
#pragma unroll
    for (int k = 2; k <= N; k <<= 1)
#pragma unroll
        for (int j = k >> 1; j > 0; j >>= 1)
#pragma unroll
            for (int i = 0; i < N; ++i) { const int l = i ^ j; if (l > i) { if ((i & k) == 0) ce_desc(v[OFF + i], v[OFF + l]); else ce_desc(v[OFF + l], v[OFF + i]); } }
}
template <int OFF, int NTOT> __device__ __forceinline__ void bitonic_merge16_desc(float (&v)[NTOT]) {
#pragma unroll
    for (int j = 8; j > 0; j >>= 1)
#pragma unroll
        for (int i = 0; i < 16; ++i) { const int l = i ^ j; if (l > i) ce_desc(v[OFF + i], v[OFF + l]); }
}
template <int A, int B, int NTOT> __device__ __forceinline__ void top16_merge(float (&v)[NTOT]) {
#pragma unroll
    for (int i = 0; i < 16; ++i) v[A + i] = fmax_raw(v[A + i], v[B + 15 - i]);
    bitonic_merge16_desc<A, NTOT>(v);
}
__device__ __forceinline__ void partner_top16(float (&t)[16], bool hi) {
    float a[16];
#pragma unroll
    for (int i = 0; i < 16; ++i) a[i] = hi ? t[15 - i] : t[i];
#pragma unroll
    for (int i = 0; i < 16; ++i) { const auto rr = __builtin_amdgcn_permlane32_swap(__builtin_bit_cast(unsigned, a[i]), __builtin_bit_cast(unsigned, a[i]), false, false);
        const unsigned r0_ = rr[0], r1_ = rr[1];
        t[i] = fmax_raw(__builtin_bit_cast(float, r0_), __builtin_bit_cast(float, r1_)); }
    bitonic_merge16_desc<0, 16>(t);
}
template <bool KL> __device__ __forceinline__ void topk_task(const Frame& F, const bf16* QP, const bf16* KEYS, const LAS unsigned char* klds, LAS unsigned short* kt, int* EI, float* EG, const int R0, const int h) {
    const int tk = F.lane & 31, hi = F.lane >> 5;
    const float neg_inf = -INFINITY;
    {
        float sv[2][16];
        unsigned koff = (unsigned)(tk * 128 + hi * 8), qoff = (unsigned)(tk * N_WQ + hi * 8);
        asm volatile("" : "+v"(koff), "+v"(qoff));
        const bf16* qp0 = QP + (size_t)R0 * N_WQ + (2 * h) * 128 + qoff;
        const bf16* kp0 = KEYS + ((size_t)(h * 2) * 128) * 128 + koff;
        const LAS unsigned char* kl0 = klds + tk * 272 + hi * 16;
        bf16x8 qf[8], kf[2][8];
#pragma unroll
        for (int ks = 0; ks < 8; ++ks) qf[ks] = *(const bf16x8*)(qp0 + ks * 16);
#pragma unroll
        for (int ks = 0; ks < 8; ++ks) kf[0][ks] = KL ? *(const LAS bf16x8*)(kl0 + ks * 32) : *(const bf16x8*)(kp0 + ks * 16);
        float v[64];
#pragma unroll
        for (int st = 0; st < 8; ++st) { const int p = st >> 2, kb = st & 3;
            if (st < 7) {
#pragma unroll
                for (int ks = 0; ks < 8; ++ks) kf[(st + 1) & 1][ks] = KL ? *(const LAS bf16x8*)(kl0 + (st + 1) * 32 * 272 + ks * 32) : *(const bf16x8*)(kp0 + (size_t)(st + 1) * 32 * 128 + ks * 16); }
            if (!KL) asm volatile("" ::: "memory");
            f32x16 acc = {};
#pragma unroll
            for (int ks = 0; ks < 8; ++ks) acc = __builtin_amdgcn_mfma_f32_32x32x16_bf16(kf[st & 1][ks], qf[ks], acc, 0, 0, 0);
#pragma unroll
            for (int rg = 0; rg < 16; ++rg) { const unsigned key = (unsigned)(kb * 32 + (rg & 3) + 8 * (rg >> 2)) + 4u * (unsigned)hi;
                const float av = acc[rg];
                v[kb * 16 + rg] = __builtin_bit_cast(float, (__builtin_bit_cast(unsigned, av) & ~127u) | key); }
            if (st == 3) {
#pragma unroll
                for (int ks = 0; ks < 8; ++ks) qf[ks] = *(const bf16x8*)(qp0 + 128 + ks * 16); }
            __builtin_amdgcn_sched_barrier(0);
            if (kb == 0) bitonic_sort_desc<16, 0, 64>(v); else if (kb == 1) bitonic_sort_desc<16, 16, 64>(v); else if (kb == 2) bitonic_sort_desc<16, 32, 64>(v); else bitonic_sort_desc<16, 48, 64>(v);
            if (kb == 3) {
                top16_merge<0, 16, 64>(v); top16_merge<32, 48, 64>(v); top16_merge<0, 32, 64>(v);
                float t[16];
#pragma unroll
                for (int i = 0; i < 16; ++i) t[i] = v[i];
                partner_top16(t, hi != 0);
#pragma unroll
                for (int i = 0; i < 16; ++i) sv[p][i] = t[i];
                __builtin_amdgcn_sched_barrier(0);
            }
        }
        float cv[32];
        {
            int n = 0;
#pragma unroll
            for (int i = 0; i < 16; ++i)
#pragma unroll
                for (int j = 0; j < 16; ++j) if ((i + 1) * (j + 1) <= 16) {
                    const float sum = sv[0][i] + sv[1][j];
                    const float c = __builtin_bit_cast(float, (__builtin_bit_cast(unsigned, sum) & ~255u) | (unsigned)(i * 16 + j));
                    if (n < 25) cv[n] = c; else cv[n - 25] = hi ? c : cv[n - 25];
                    ++n; }
#pragma unroll
            for (int k = 25; k < 32; ++k) cv[k] = neg_inf;
        }
#pragma unroll
        for (int p = 0; p < 2; ++p)
#pragma unroll
            for (int i = 0; i < 16; ++i) kt[(p * 16 + i) * 64 + F.lane] = (unsigned short)(__builtin_bit_cast(unsigned, sv[p][i]) & 127u);
        bitonic_sort_desc<16, 0, 32>(cv); bitonic_sort_desc<16, 16, 32>(cv); top16_merge<0, 16, 32>(cv);
        float tv[16]; int te[16];
#pragma unroll
        for (int i = 0; i < 16; ++i) tv[i] = cv[i];
        partner_top16(tv, hi != 0);
#pragma unroll
        for (int rd = 0; rd < 16; ++rd) { const unsigned id = __builtin_bit_cast(unsigned, tv[rd]) & 255u;
            te[rd] = (int)kt[(id >> 4) * 64 + F.lane] * 128 + (int)kt[(16 + (id & 15u)) * 64 + F.lane]; }
        float den = 0.f; const float tmax = tv[0];
#pragma unroll
        for (int rd = 0; rd < 16; ++rd) { tv[rd] = fast_exp2((tv[rd] - tmax) * LOG2E); den += tv[rd]; }
        const float rden = 1.0f / den;
        const size_t off = (size_t)(R0 + tk) * 128 + h * 16;
        if (hi == 0) {
#pragma unroll
            for (int q = 0; q < 4; ++q) { v4u o; o.x = (unsigned)te[4 * q]; o.y = (unsigned)te[4 * q + 1]; o.z = (unsigned)te[4 * q + 2]; o.w = (unsigned)te[4 * q + 3]; *(v4u*)(EI + off + 4 * q) = o; }
        } else {
#pragma unroll
            for (int q = 0; q < 4; ++q) { f32x4 o; o.x = tv[4 * q] * rden; o.y = tv[4 * q + 1] * rden; o.z = tv[4 * q + 2] * rden; o.w = tv[4 * q + 3] * rden; *(f32x4*)(EG + off + 4 * q) = o; }
        }
    }
}
__device__ __forceinline__ void peer_topk_phase(const Frame& F, const bf16* QP, const bf16* KEYS, int* EI, float* EG, bool lat_only) {
    LAS unsigned char* klds = F.lds;
    LAS unsigned short* kt = (LAS unsigned short*)(F.lds + 69632) + F.wave * 2048;
    for (int h = 0; h < 8; ++h) {
        __syncthreads();
#pragma unroll
        for (int i = 0; i < 8; ++i) { const int ch = F.tid + i * 512, row = ch >> 4, c16 = ch & 15;
            *(LAS v4u*)(klds + row * 272 + c16 * 16) = *(const v4u*)(KEYS + ((size_t)(h * 2) * 128 + row) * 128 + c16 * 8); }
        __syncthreads();
        for (int tgl = F.gw; tgl < NB * (TL / 32); tgl += F.NGW) { const int b = tgl >> 8, j = tgl & 255;
            topk_task<true>(F, QP, KEYS, klds, kt, EI, EG, b * RPB + CL + j * 32, h); }
    }
    __syncthreads();
    if (!lat_only) {
        for (int task = F.gw; task < NB * (CL / 32) * 8; task += F.NGW) { const int tgc = task >> 3, h = task & 7, b = tgc >> 3, j = tgc & 7;
            topk_task<false>(F, QP, KEYS, klds, kt, EI, EG, b * RPB + j * 32, h); }
    }
}

typedef float f32x2v __attribute__((ext_vector_type(2)));
typedef int v8i __attribute__((ext_vector_type(8)));
typedef int v2i_t __attribute__((ext_vector_type(2)));
template <int IMM> __device__ __forceinline__ void glds16_s(const unsigned char* sbase, unsigned voff, unsigned lds_dst) { unsigned keep;
    asm volatile("s_mov_b32 %0, m0\n\ts_mov_b32 m0, %3\n\ts_nop 0\n\tglobal_load_lds_dwordx4 %1, %2 offset:%4\n\ts_mov_b32 m0, %0" : "=&s"(keep) : "v"(voff), "s"(sbase), "s"(lds_dst), "n"(IMM) : "memory"); }
__device__ __forceinline__ v2i_t tr4(const LAS unsigned char* p) { return __builtin_amdgcn_ds_read_tr4_b64_v2i32((LAS v2i_t*)p); }
constexpr int G6_WF = 133120, G6_CF = 137216, G6_HB = 139264;
#define PG6_WAITV(n) do { if (GP == 6) asm volatile("s_waitcnt vmcnt(40)" ::: "memory"); else asm volatile("s_waitcnt vmcnt(" #n ")" ::: "memory"); } while (0)
#define PG6_WAITL() asm volatile("s_waitcnt lgkmcnt(0)" ::: "memory")
#define PG7_DMAU(VO, bt, slot) do { if (GP == 2 || GP == 3) break; _Pragma("unroll") for (int k_ = 0; k_ < 8; ++k_) glds16_s<0>(T + 64 * k_, VO[bt], (unsigned)__builtin_amdgcn_readfirstlane(vsm0 + (slot) * 8192 + k_ * 1024)); } while (0)
#define PG7_UREAD(slot) do { if (GP == 5 || GP == 6 || GP == 7 || GP == 8) break; _Pragma("unroll") for (int s_ = 0; s_ < 8; ++s_) ur[s_] = *(const LAS v4u*)(vsl + ua + ((slot) * 8192 + 1024 * s_)); } while (0)
#define PG7_UMFMA(bt) do { if (GP == 5 || GP == 6 || GP == 7 || GP == 8) break; f32x4 d_ = {0.f, 0.f, 0.f, 0.f}; \
    _Pragma("unroll") for (int s_ = 0; s_ < 8; ++s_) { v8i a_; a_[0] = (int)ur[s_].x; a_[1] = (int)ur[s_].y; a_[2] = (int)ur[s_].z; a_[3] = (int)ur[s_].w; a_[4] = 0; a_[5] = 0; a_[6] = 0; a_[7] = 0; \
        d_ = __builtin_amdgcn_mfma_scale_f32_16x16x128_f8f6f4(a_, bh[s_], d_, 4, 0, 0, 0, 0, 0); } \
    if (l15 == 0) *(LAS f32x4*)(wf + 4 * (16 * (bt) + 4 * q4)) = d_; } while (0)
#define PG7_DMAV2(c, h) do { if (GP == 1 || GP == 3 || GP == 8) break; _Pragma("unroll") for (int k_ = 0; k_ < 8; ++k_) \
    glds16_s<0>(T + 512 + 128 * (c) + 64 * (k_ & 1), voff[(k_ >> 1) + 4 * (h)], (unsigned)__builtin_amdgcn_readfirstlane(vsm0 + (h) * 8192 + k_ * 1024)); } while (0)
#define PG7_VREAD2() do { if (GP >= 5) break; _Pragma("unroll") for (int cg_ = 0; cg_ < 16; ++cg_) { const LAS unsigned char* ap_ = vsl + trp2[(cg_ >> 1) & 3] + (1024 * (cg_ >> 3) + 8 * (cg_ & 1)); vb0[cg_] = tr4(ap_); vb1[cg_] = tr4(ap_ + 2048); } } while (0)
#define PG7_SEL2(D, c, cg) do { const bool m_ = l15 == (cg); _Pragma("unroll") for (int i_ = 0; i_ < 4; ++i_) R[c][i_] = m_ ? D[i_] : R[c][i_]; \
    asm volatile("" : "+v"(R[c][0]), "+v"(R[c][1]), "+v"(R[c][2]), "+v"(R[c][3])); } while (0)
#define PG7_VMFMA2(c) do { if (GP >= 5) break; _Pragma("unroll") for (int cg_ = 0; cg_ < 16; ++cg_) { v8i a_; a_[0] = vb0[cg_].x; a_[1] = vb0[cg_].y; a_[2] = vb1[cg_].x; a_[3] = vb1[cg_].y; a_[4] = 0; a_[5] = 0; a_[6] = 0; a_[7] = 0; \
        f32x4 d_ = {0.f, 0.f, 0.f, 0.f}; \
        d_ = __builtin_amdgcn_mfma_scale_f32_16x16x128_f8f6f4(a_, bhi, d_, 4, 0, 0, 0, 0, 0); \
        PG7_SEL2(d_, c, cg_); } } while (0)
#define PG7_VCHUNK(c, ISSUE) do { PG7_VREAD2(); PG6_WAITL(); ISSUE; __builtin_amdgcn_sched_barrier(0); PG7_VMFMA2(c); } while (0)
#define PG7_USTEP(bt, slot, ISSUE) do { PG7_UREAD(slot); PG6_WAITL(); ISSUE; __builtin_amdgcn_sched_barrier(0); PG7_UMFMA(bt); } while (0)
#define PG7_VOFF(VO, EL, EH) do { _Pragma("unroll") for (int k_ = 0; k_ < 8; ++k_) VO[k_] = (unsigned)__shfl(k_ < 4 ? EL : EH, ((16 * k_) & 63) + (lane >> 2)) * 1024u + vlane; } while (0)
#define PG7_H8(HA, HC, O) do { int p_; \
    p_ = __builtin_amdgcn_cvt_pk_fp8_f32(bflo(HA.x), bfhi(HA.x), 0, false); p_ = __builtin_amdgcn_cvt_pk_fp8_f32(bflo(HA.y), bfhi(HA.y), p_, true); O.x = (unsigned)p_; \
    p_ = __builtin_amdgcn_cvt_pk_fp8_f32(bflo(HA.z), bfhi(HA.z), 0, false); p_ = __builtin_amdgcn_cvt_pk_fp8_f32(bflo(HA.w), bfhi(HA.w), p_, true); O.y = (unsigned)p_; \
    p_ = __builtin_amdgcn_cvt_pk_fp8_f32(bflo(HC.x), bfhi(HC.x), 0, false); p_ = __builtin_amdgcn_cvt_pk_fp8_f32(bflo(HC.y), bfhi(HC.y), p_, true); O.z = (unsigned)p_; \
    p_ = __builtin_amdgcn_cvt_pk_fp8_f32(bflo(HC.z), bfhi(HC.z), 0, false); p_ = __builtin_amdgcn_cvt_pk_fp8_f32(bflo(HC.w), bfhi(HC.w), p_, true); O.w = (unsigned)p_; } while (0)
template <bool FINAL, int GP = 0> __device__ __forceinline__ void peer_gather7_phase(const Frame& F, const bf16* HN, const unsigned char* T, const int* EI, const float* EG, const float* g2, bf16* XS, float* out, bool lat_only, const float* gain_n, const float* mod_n, bf16* XNn) {
    const int lane = F.lane, l15 = lane & 15, q4 = lane >> 4, half = lane >> 5, c32 = lane & 31;
    LAS unsigned char* hb = F.lds + G6_HB + F.wave * 1024;
    LAS unsigned char* wf = F.lds + G6_WF + F.wave * 512;
    LAS unsigned char* cf = F.lds + G6_CF + F.wave * 256;
    const LAS unsigned char* vsl = F.lds + F.wave * 16384;
    const unsigned vsm0 = (unsigned)(uintptr_t)F.lds + (unsigned)F.wave * 16384u;
    unsigned trp[4];
#pragma unroll
    for (int p = 0; p < 4; ++p) trp[p] = 2048u * q4 + 64u * l15 + 16u * ((p + (l15 >> 2)) & 3);
    unsigned trp2[4];
#pragma unroll
    for (int p = 0; p < 4; ++p) trp2[p] = 4096u * q4 + 64u * l15 + 16u * ((p + (l15 >> 2)) & 3);
    const unsigned ua = 64u * l15 + 16u * ((q4 + (l15 >> 2)) & 3);
    const unsigned hoff = (unsigned)(32 * c32 + 16 * half);
    const unsigned coff = (unsigned)(16 * l15 + 4 * q4);
    const unsigned vlane = 16u * (unsigned)(((lane & 3) - (lane >> 4)) & 3);
    const int NV = lat_only ? NB * TL : MT;
    int it = F.gw; if (it >= NV) return;
    int row = lat_only ? (it >> 13) * RPB + CL + (it & 8191) : it;
    int e_lo = EI[(size_t)row * 128 + lane], e_hi = EI[(size_t)row * 128 + 64 + lane];
    float g_lo = EG[(size_t)row * 128 + lane], g_hi = EG[(size_t)row * 128 + 64 + lane];
    unsigned voff[8];
    PG7_VOFF(voff, e_lo, e_hi);
    { const v4u ha = *(const v4u*)(HN + (size_t)row * DM + hoff), hc = *(const v4u*)(HN + (size_t)row * DM + hoff + 8); v4u o; PG7_H8(ha, hc, o); *(LAS v4u*)(hb + hoff) = o; }
    v2u xa[4]; f32x4 gv[4];
    { const int b0 = row / RPB, r0 = row - b0 * RPB; const int mr0 = r0 < CL ? 8 : b0;
      const float* gp = g2 + (size_t)mr0 * 6144 + coff; const bf16* xr = XS + (size_t)row * DM + coff;
#pragma unroll
      for (int ch = 0; ch < 4; ++ch) { xa[ch] = *(const v2u*)(xr + 256 * ch); gv[ch] = *(const f32x4*)(gp + 256 * ch); } }
    PG7_DMAU(voff, 0, 0); PG7_DMAU(voff, 1, 1);
    bool first = true;
    for (;;) {
        const int itn = it + F.NGW; const bool hn = itn < NV; const int rown = hn ? (lat_only ? (itn >> 13) * RPB + CL + (itn & 8191) : itn) : row;
        const int b = row / RPB, r = row - b * RPB; const bool cr = r < CL;
        const int mr = cr ? 8 : b;
        v8i bh[8];
#pragma unroll
        for (int s_ = 0; s_ < 8; ++s_) { const v4u b0 = *(const LAS v4u*)(hb + 128 * s_ + 16 * q4), b1 = *(const LAS v4u*)(hb + 128 * s_ + 64 + 16 * q4);
            bh[s_][0] = (int)b0.x; bh[s_][1] = (int)b0.y; bh[s_][2] = (int)b0.z; bh[s_][3] = (int)b0.w; bh[s_][4] = (int)b1.x; bh[s_][5] = (int)b1.y; bh[s_][6] = (int)b1.z; bh[s_][7] = (int)b1.w; }
        asm volatile("" : "+v"(bh[0]), "+v"(bh[1]), "+v"(bh[2]), "+v"(bh[3]), "+v"(bh[4]), "+v"(bh[5]), "+v"(bh[6]), "+v"(bh[7]));
        if (first) { PG6_WAITV(8); } else { PG6_WAITV(12); }
        v4u ur[8];
        PG7_USTEP(0, 0, PG7_DMAU(voff, 2, 0)); if (first) { PG6_WAITV(8); } else { PG6_WAITV(12); }
        first = false;
        PG7_USTEP(1, 1, PG7_DMAU(voff, 3, 1)); PG6_WAITV(8);
        PG7_USTEP(2, 0, PG7_DMAU(voff, 4, 0)); PG6_WAITV(8);
        PG7_USTEP(3, 1, PG7_DMAU(voff, 5, 1)); PG6_WAITV(8);
        PG7_USTEP(4, 0, PG7_DMAU(voff, 6, 0)); PG6_WAITV(8);
        PG7_USTEP(5, 1, PG7_DMAU(voff, 7, 1)); PG6_WAITV(8);
        int e_lo_n = __builtin_nontemporal_load(EI + (size_t)rown * 128 + lane), e_hi_n = __builtin_nontemporal_load(EI + (size_t)rown * 128 + 64 + lane);
        float g_lo_n = __builtin_nontemporal_load(EG + (size_t)rown * 128 + lane), g_hi_n = __builtin_nontemporal_load(EG + (size_t)rown * 128 + 64 + lane);
        v4u hna = __builtin_nontemporal_load((const v4u*)(HN + (size_t)rown * DM + hoff)), hnc = __builtin_nontemporal_load((const v4u*)(HN + (size_t)rown * DM + hoff + 8));
        v2u xan[4]; f32x4 gvn[4];
        { const int bn = rown / RPB, rn = rown - bn * RPB; const int mrn = rn < CL ? 8 : bn;
          const float* gp = g2 + (size_t)mrn * 6144 + coff; const bf16* xr = XS + (size_t)rown * DM + coff;
#pragma unroll
          for (int ch = 0; ch < 4; ++ch) { xan[ch] = __builtin_nontemporal_load((const v2u*)(xr + 256 * ch)); gvn[ch] = *(const f32x4*)(gp + 256 * ch); } }
        PG7_USTEP(6, 0, PG7_DMAV2(0, 0)); PG6_WAITV(8);
        PG7_USTEP(7, 1, PG7_DMAV2(0, 1)); PG6_WAITV(0);
        asm volatile("" : "+v"(e_lo_n), "+v"(e_hi_n), "+v"(g_lo_n), "+v"(g_hi_n), "+v"(hna), "+v"(hnc));
        asm volatile("" : "+v"(xan[0]), "+v"(xan[1]), "+v"(xan[2]), "+v"(xan[3]), "+v"(gvn[0]), "+v"(gvn[1]), "+v"(gvn[2]), "+v"(gvn[3]));
        { v4u o; PG7_H8(hna, hnc, o); *(LAS v4u*)(hb + hoff) = o; }
        unsigned voffn[8];
        PG7_VOFF(voffn, e_lo_n, e_hi_n);
        f32x2v w2; w2.x = gelu_erf(*(const LAS float*)(wf + 4 * lane) * (1.0f / U_SCALE)) * g_lo; w2.y = gelu_erf(*(const LAS float*)(wf + 256 + 4 * lane) * (1.0f / U_SCALE)) * g_hi;
        float mx = __builtin_fmaxf(__builtin_fabsf(w2.x), __builtin_fabsf(w2.y));
#pragma unroll
        for (int o = 1; o < 64; o <<= 1) mx = __builtin_fmaxf(mx, __shfl_xor(mx, o));
        const float csc = 384.0f / __builtin_fmaxf(mx, 1e-30f);
        { const int hi8 = __builtin_amdgcn_cvt_pk_fp8_f32(w2.x * csc, w2.y * csc, 0, false);
          cf[lane] = (unsigned char)(hi8 & 0xff); cf[64 + lane] = (unsigned char)((hi8 >> 8) & 0xff); }
        v8i bhi;
        { const v4u h0 = *(const LAS v4u*)(cf + 16 * q4), h1 = *(const LAS v4u*)(cf + 64 + 16 * q4);
          bhi[0] = (int)h0.x; bhi[1] = (int)h0.y; bhi[2] = (int)h0.z; bhi[3] = (int)h0.w; bhi[4] = (int)h1.x; bhi[5] = (int)h1.y; bhi[6] = (int)h1.z; bhi[7] = (int)h1.w; }
        float R[4][4];
#pragma unroll
        for (int i = 0; i < 4; ++i) { R[i][0] = 0.f; R[i][1] = 0.f; R[i][2] = 0.f; R[i][3] = 0.f; }
        v2i_t vb0[16], vb1[16];
        PG7_VCHUNK(0, PG7_DMAV2(1, 0); PG7_DMAV2(1, 1)); PG6_WAITV(0);
        PG7_VCHUNK(1, PG7_DMAV2(2, 0); PG7_DMAV2(2, 1)); PG6_WAITV(0);
        PG7_VCHUNK(2, PG7_DMAV2(3, 0); PG7_DMAV2(3, 1)); PG6_WAITV(0);
        PG7_VCHUNK(3, if (hn) { PG7_DMAU(voffn, 0, 0); PG7_DMAU(voffn, 1, 1); });
        const float osc = 1.0f / (V_SCALE * csc);
        float xn[16];
#pragma unroll
        for (int ch = 0; ch < 4; ++ch) {
            xn[4 * ch] = bflo(xa[ch].x) + gv[ch].x * (R[ch][0] * osc); xn[4 * ch + 1] = bfhi(xa[ch].x) + gv[ch].y * (R[ch][1] * osc); xn[4 * ch + 2] = bflo(xa[ch].y) + gv[ch].z * (R[ch][2] * osc); xn[4 * ch + 3] = bfhi(xa[ch].y) + gv[ch].w * (R[ch][3] * osc); }
        if (FINAL) {
            float* orow = out + ((size_t)b * TL + (r - CL)) * DM + coff;
#pragma unroll
            for (int ch = 0; ch < 4; ++ch) { f32x4 o; o.x = xn[4 * ch]; o.y = xn[4 * ch + 1]; o.z = xn[4 * ch + 2]; o.w = xn[4 * ch + 3]; __builtin_nontemporal_store(o, (f32x4*)(orow + 256 * ch)); }
        } else {
            bf16* orow = XS + (size_t)row * DM + coff;
#pragma unroll
            for (int ch = 0; ch < 4; ++ch) { v2u o; o.x = pk2(xn[4 * ch], xn[4 * ch + 1]); o.y = pk2(xn[4 * ch + 2], xn[4 * ch + 3]); *(v2u*)(orow + 256 * ch) = o; }
            float ss = 0.f;
#pragma unroll
            for (int i = 0; i < 16; ++i) ss += xn[i] * xn[i];
            const float rs = __builtin_amdgcn_rsqf(wave_sum(ss) * (1.f / DM) + EPS);
            const float* gn = gain_n + coff; const float* shp = mod_n + (size_t)mr * 6144 + coff; const float* scp = shp + 1024;
            bf16* nxp = XNn + (size_t)row * DM + coff;
#pragma unroll
            for (int ch = 0; ch < 4; ++ch) { const f32x4 g = *(const f32x4*)(gn + 256 * ch), sh = *(const f32x4*)(shp + 256 * ch), sc = *(const f32x4*)(scp + 256 * ch);
                const float y0 = xn[4 * ch] * rs * g.x * (sc.x + 1.0f) + sh.x, y1 = xn[4 * ch + 1] * rs * g.y * (sc.y + 1.0f) + sh.y, y2 = xn[4 * ch + 2] * rs * g.z * (sc.z + 1.0f) + sh.z, y3 = xn[4 * ch + 3] * rs * g.w * (sc.w + 1.0f) + sh.w;
                v2u o; o.x = pk2(y0, y1); o.y = pk2(y2, y3); *(v2u*)(nxp + 256 * ch) = o; }
        }
        if (!hn) break;
        it = itn; row = rown; e_lo = e_lo_n; e_hi = e_hi_n; g_lo = g_lo_n; g_hi = g_hi_n;
#pragma unroll
        for (int k = 0; k < 8; ++k) voff[k] = voffn[k];
#pragma unroll
        for (int ch = 0; ch < 4; ++ch) { xa[ch] = xan[ch]; gv[ch] = gvn[ch]; }
    }
}

#ifndef MK_MASK
#define MK_MASK 0x7ff
#endif
#define ENAB(r) (((MK_MASK) >> (r)) & 1)
#define IN(k) (lo <= (k) && (k) < hi)
#define SEAM(k) do { if ((k) + 1 < hi) { if (MK_PER_PHASE) { if (F.tid == 0) __hip_atomic_store(F.ctl + CW_TMO, 0xBADBA0u, RLX_AGENT); } else xcd_barrier(bar); } } while (0)

template <int layer> __device__ __forceinline__ void run_layer(const Frame& F, const Args& args, const XcdBarrier& bar, const int lo, const int hi, unsigned char* lds) {
    unsigned char* ws = args.ws;
    float* MOD = (float*)(ws + WS_MOD);
    const float* RT = (const float*)(ws + WS_ROPE);
    bf16* XS = (bf16*)(ws + WS_XS);
    bf16* OD = (bf16*)(ws + WS_XS);
    bf16* XN = (bf16*)(ws + WS_XN);
    bf16* PB = (bf16*)(ws + WS_PB);
    int* EI = (int*)(ws + WS_EI); float* EG = (float*)(ws + WS_EG);
        const int pb = 1 + layer * PH_PER_LAYER;
        const float* mod = MOD + (size_t)layer * 9 * 6144;
        const float* norm1 = args.in[layer ? 25 : 6]; const float* norm2 = args.in[layer ? 26 : 7];
        const bf16* W_in = (const bf16*)(ws + (layer ? WS_WIN1 : WS_WIN0)); const bf16* W_out = (const bf16*)(ws + (layer ? WS_WOUT1 : WS_WOUT0)); const bf16* W_q = (const bf16*)(ws + (layer ? WS_WQ1 : WS_WQ0));
        const bf16* KEYS = (const bf16*)(ws + (layer ? WS_KEYS1 : WS_KEYS0)); const unsigned char* PU = ws + (layer ? WS_U1 : WS_U0); const unsigned char* PV = PU;
        const int n_in = layer ? N_IN1 : N_IN0;
        const bool lat_only = layer == 1;

        if (ENAB(0) && IN(pb + 0)) {
            if (layer == 0) { norm_mod_phase<true>(F, args.in[0], args.in[2], XS, norm1, mod + 0, mod + 1024, XN, false); SEAM(pb + 0); }
        }
        if (ENAB(1) && IN(pb + 1)) {
            pg8::Gemm g{XN, W_in, MT, n_in, DM}; pg8::StaticOrder S; S.init(MT, n_in, F.G, (int)blockIdx.x);
            PG8_LAS float* xch = (PG8_LAS float*)(F.lds + 132096);
            pg8::EpiHeadNorm<layer> E{PB, n_in, RT + 4096 + layer * 256, RT, xch, QSCALE};
            pg8::gemm_phase<pg8::EpiHeadNorm<layer>, pg8::StaticOrder, true, true>(F.lds, g, S, E);
            SEAM(pb + 1);
        }
        if (ENAB(2) && IN(pb + 2)) {
            if (layer == 0) { l0_headnorm_pool_phase(F, args, PB, XN, RT); SEAM(pb + 2); }
        }
        if (ENAB(3) && IN(pb + 3)) {
            using abf = attn_body::bf16;
            if (layer == 0) {
                for (int u = F.vcu, first = 1; u < NB * 12 * 32; u += F.G, first = 0) {
                    const int combo = u >> 5, qb = u & 31, b = combo / 12, s = combo % 12;
                    const size_t kr0 = (size_t)b * RPB, qr0 = kr0 + CL + (size_t)qb * 256;
                    const int un = u + F.G; const bool hn = un < NB * 12 * 32; const int cn = (hn ? un : u) >> 5, bn = cn / 12, sn = cn % 12; const size_t krn = (size_t)bn * RPB;
                    attn_body::attn_unit2<2, N_IN0, OD_P, 0>((const abf*)(PB + qr0 * N_IN0 + 256 + s * 64), (const abf*)(PB + kr0 * N_IN0 + 1024 + s * 64), (const abf*)(PB + kr0 * N_IN0 + 1792 + (s >> 1) * 128),
                                                         (abf*)(OD + qr0 * OD_P + s * 128), (RPB / 64), (char*)lds, nullptr, 0,
                                                         !first, hn, (const abf*)(PB + krn * N_IN0 + 1024 + sn * 64), (const abf*)(PB + krn * N_IN0 + 1792 + (sn >> 1) * 128));
                }
                for (int u = F.vcu; u < NB * 12; u += F.G) {
                    const int b = u / 12, s = u % 12; const size_t kr0 = (size_t)b * RPB;
                    attn_body::attn_unit2<2, N_IN0, OD_P, 0>((const abf*)(PB + kr0 * N_IN0 + 256 + s * 64), (const abf*)(PB + kr0 * N_IN0 + 1024 + s * 64), (const abf*)(PB + kr0 * N_IN0 + 1792 + (s >> 1) * 128),
                                                         (abf*)(OD + kr0 * OD_P + s * 128), (CL / 64), (char*)lds, nullptr, 0, false, false, nullptr, nullptr);
                }
            } else {
                for (int u = F.vcu, first = 1; u < NB * 8 * 32; u += F.G, first = 0) {
                    const int combo = u >> 5, qb = u & 31, b = combo >> 3, h = combo & 7;
                    const size_t kr0 = (size_t)b * RPB, qr0 = kr0 + CL + (size_t)qb * 256;
                    const int un = u + F.G; const bool hn = un < NB * 8 * 32; const int cn = (hn ? un : u) >> 5, bn = cn >> 3, hn_ = cn & 7; const size_t krn = (size_t)bn * RPB;
                    attn_body::attn_unit2<1, N_IN1, DM, 0>((const abf*)(PB + qr0 * N_IN1 + h * 64), (const abf*)(PB + kr0 * N_IN1 + 512 + (h >> 2) * 64), (const abf*)(PB + kr0 * N_IN1 + 640 + (h >> 2) * 64),
                                                       (abf*)(XN + qr0 * DM + h * 64), (RPB / 64), (char*)lds, nullptr, 0,
                                                       !first, hn, (const abf*)(PB + krn * N_IN1 + 512 + (hn_ >> 2) * 64), (const abf*)(PB + krn * N_IN1 + 640 + (hn_ >> 2) * 64));
                }
            }
            if (layer == 0) SEAM(pb + 3);
        }
        if (ENAB(4) && IN(pb + 4)) {
            if (layer == 0) l0_diff_combine_phase(F, args, OD, XN);
            else {
                if (!(DBGZ & 16)) {
                    using abf = attn_body::bf16;
                    for (int u = F.vcu, first = 1; u < NB * 8 * 32; u += F.G, first = 0) {
                        const int combo = u >> 5, qb = u & 31, b = combo >> 3, h = combo & 7;
                        const size_t kr0 = (size_t)b * RPB, qr0 = kr0 + CL + (size_t)qb * 256;
                        const int un = u + F.G; const bool hn = un < NB * 8 * 32; const int cn = (hn ? un : u) >> 5, bn = cn >> 3, hn_ = cn & 7; const size_t krn = (size_t)bn * RPB;
                        attn_body::attn_unit2<1, N_IN1, DM, 1>((const abf*)(PB + qr0 * N_IN1 + 768 + h * 64), (const abf*)(PB + kr0 * N_IN1 + 1280 + h * 64), (const abf*)(PB + kr0 * N_IN1 + 1792 + h * 64),
                                                              (abf*)(XN + qr0 * DM + 512 + h * 64), 16, (char*)lds, args.in[33] + h * 465, qb * 4,
                                                              !first, hn, (const abf*)(PB + krn * N_IN1 + 1280 + hn_ * 64), (const abf*)(PB + krn * N_IN1 + 1792 + hn_ * 64));
                    }
                }
                if (DBGZ & 24) { for (int row = F.gw; row < MT; row += F.NGW) { v4u z = {0u, 0u, 0u, 0u};
                    if (DBGZ & 8) *(v4u*)(XN + (size_t)row * DM + 8 * F.lane) = z;
                    if (DBGZ & 16) *(v4u*)(XN + (size_t)row * DM + 512 + 8 * F.lane) = z; } }
            }
            SEAM(pb + 4);
        }
        if (ENAB(5) && IN(pb + 5)) {
            pg8::Gemm g{XN, W_out, MT, DM, DM};
            pg8::EpiRes E{XS, args.in[0], args.in[2], mod + 2048, layer == 0 ? 1 : 0};
            if (layer == 0) { pg8::StaticOrder S; S.init(MT, DM, F.G, (int)blockIdx.x); pg8::gemm_phase<pg8::EpiRes, pg8::StaticOrder, true, true>(F.lds, g, S, E); }
            else { pg8::LatOrder S; S.init(DM, F.G, (int)blockIdx.x); pg8::gemm_phase<pg8::EpiRes, pg8::LatOrder, true, true>(F.lds, g, S, E); }
            SEAM(pb + 5);
        }
        if (ENAB(6) && IN(pb + 6)) { norm_mod_phase<false>(F, args.in[0], args.in[2], XS, norm2, mod + 3072, mod + 4096, XN, lat_only); SEAM(pb + 6); }
        if (ENAB(7) && IN(pb + 7)) {
            pg8::Gemm g{XN, W_q, MT, N_WQ, DM};
            pg8::EpiBf16<0> E{PB, N_WQ, nullptr, 0, 0, 1.f};
            if (layer == 0) { pg8::StaticOrder S; S.init(MT, N_WQ, F.G, (int)blockIdx.x); pg8::gemm_phase<pg8::EpiBf16<0>, pg8::StaticOrder, true, true>(F.lds, g, S, E); }
            else { pg8::LatOrder S; S.init(N_WQ, F.G, (int)blockIdx.x); pg8::gemm_phase<pg8::EpiBf16<0>, pg8::LatOrder, true, true>(F.lds, g, S, E); }
            SEAM(pb + 7);
        }
        if (ENAB(8) && IN(pb + 8)) { peer_topk_phase(F, PB, KEYS, EI, EG, lat_only); SEAM(pb + 8); }
        if (ENAB(9) && IN(pb + 9)) {
            if (layer == 0) peer_gather7_phase<false>(F, XN, PU, EI, EG, mod + 5120, XS, args.out, false, args.in[25], MOD + (size_t)9 * 6144, XN);
            else {
#if defined(PROBE_G6)
                if (args.pad) peer_gather7_phase<true, PROBE_G6>(F, XN, PU, EI, EG, mod + 5120, XS, (float*)(ws + WS_PB), true, nullptr, nullptr, nullptr); else
#endif
                peer_gather7_phase<true>(F, XN, PU, EI, EG, mod + 5120, XS, args.out, true, nullptr, nullptr, nullptr);
            }
            SEAM(pb + 9);
        }
}
__global__ void __launch_bounds__(NWAVES * 64, 2) mk_fwd(Args args) {
    extern __shared__ __attribute__((aligned(16))) unsigned char lds[];
    Frame F;
    F.lds = (LAS unsigned char*)lds;
    F.tid = threadIdx.x; F.lane = F.tid & 63; F.wave = __builtin_amdgcn_readfirstlane(F.tid >> 6);
    F.G = gridDim.x; { const int bx = blockIdx.x; F.vcu = (F.G % 8 == 0) ? (bx % 8) * (F.G / 8) + bx / 8 : bx; }
    F.gw = F.vcu * NWAVES + F.wave; F.NGW = F.G * NWAVES;
    unsigned char* ws = args.ws;
    F.ctl = (gu32*)(ws + WS_CTL);
    for (int u = F.tid; u < (LDS_BYTES - LDSCTL_OFF) / 4; u += NWAVES * 64) ((LAS unsigned*)(F.lds + LDSCTL_OFF))[u] = 0u;
    __syncthreads();
    XcdBarrier bar; bar.bar = (unsigned*)(F.ctl + CW_BAR) + args.li * XCD_BAR_WORDS; bar.x = 0; bar.st = nullptr;
    if (!MK_PER_PHASE) bar = xcd_barrier_post((unsigned*)(F.ctl + CW_BAR) + args.li * XCD_BAR_WORDS, (volatile LAS unsigned*)(F.lds + MISC_OFF) + 8);
    const int lo = args.ph_lo, hi = args.ph_hi;
    if (ENAB(10) && IN(0)) { p0_prologue(F, args); SEAM(0); }
    run_layer<0>(F, args, bar, lo, hi, lds);
    run_layer<1>(F, args, bar, lo, hi, lds);
#if defined(EXTRA_BARRIERS)
    if (hi == N_PHASES) { for (int i = 0; i < EXTRA_BARRIERS; ++i) xcd_barrier(bar); }
#endif
}


extern "C" void kernel_launch(void* const* d_in, const int* in_sizes, int n_in, void* d_out, int out_size, void* d_ws, size_t ws_size, hipStream_t stream) {
    static int grid = 0;
    if (grid == 0) {
        if (n_in != 38 || in_sizes[0] != NB * TL * DM || out_size != NB * TL * DM || ws_size < WS_END) {
            fprintf(stderr, "kernel_launch: unexpected problem shape (n_in %d, in0 %d, out %d, ws %zu; need ws >= %zu); nothing launched\n", n_in, n_in > 0 ? in_sizes[0] : -1, out_size, ws_size, (size_t)WS_END); grid = -1; return; }
        int dev = 0, cus = 0, per_cu = 0;
        if (hipGetDevice(&dev) != hipSuccess || hipDeviceGetAttribute(&cus, hipDeviceAttributeMultiprocessorCount, dev) != hipSuccess) { grid = -1; return; }
        if (hipFuncSetAttribute((const void*)mk_fwd, hipFuncAttributeMaxDynamicSharedMemorySize, LDS_BYTES) != hipSuccess) { fprintf(stderr, "kernel_launch: hipFuncSetAttribute failed\n"); grid = -1; return; }
        if (hipOccupancyMaxActiveBlocksPerMultiprocessor(&per_cu, (const void*)mk_fwd, NWAVES * 64, LDS_BYTES) != hipSuccess || per_cu < 1) { fprintf(stderr, "kernel_launch: occupancy query says %d blocks per CU\n", per_cu); }
        (void)hipGetLastError();
        grid = cus;
    }
    if (grid < 0) return;
    if (hipMemsetAsync((char*)d_ws + WS_CTL, 0, CTL_ZERO_BYTES, stream) != hipSuccess) return;
    Args a{};
    for (int i = 0; i < 38; ++i) a.in[i] = (const float*)d_in[i];
    a.out = (float*)d_out; a.ws = (unsigned char*)d_ws;
#if MK_PER_PHASE
    for (int p = 0; p < N_PHASES; ++p) { a.ph_lo = p; a.ph_hi = p + 1; hipLaunchKernelGGL(mk_fwd, dim3(grid), dim3(NWAVES * 64), LDS_BYTES, stream, a); }
#else
    a.ph_lo = 0; a.ph_hi = N_PHASES;
    hipLaunchKernelGGL(mk_fwd, dim3(grid), dim3(NWAVES * 64), LDS_BYTES, stream, a);
#if defined(EXTRA_PHASE)
#ifndef EXTRA_HI
#define EXTRA_HI (EXTRA_PHASE + 1)
#endif
    a.ph_lo = EXTRA_PHASE; a.ph_hi = EXTRA_HI; a.li = 1;
#if defined(PROBE_G6)
    a.pad = 1;
#endif
    hipLaunchKernelGGL(mk_fwd, dim3(grid), dim3(NWAVES * 64), LDS_BYTES, stream, a);
#endif
#endif
    const hipError_t le = hipPeekAtLastError();
    if (le != hipSuccess) fprintf(stderr, "kernel_launch: launch failed: %s\n", hipGetErrorName(le));
}
```

```cpp
#include <hip/hip_runtime.h>
#include <hip/hip_bf16.h>
#include <cstdio>
#include <cstdint>
#include <cmath>
namespace pg8 {
#define PG8_LAS __attribute__((address_space(3)))
typedef unsigned short bf16_t;
typedef short bf16x8 __attribute__((ext_vector_type(8)));
typedef float f32x4 __attribute__((ext_vector_type(4)));
typedef unsigned u32x4 __attribute__((ext_vector_type(4)));
constexpr int BM = 256, BK = 64, HALF = 128, HTB = HALF * BK * 2  , STAGE_BYTES = 8 * HTB, NXCD = 8, WGM = 8;

__host__ __device__ __forceinline__ int lds_byte(int r, int c) { const int st = (r >> 4) * 2 + (c >> 5), rr = r & 15, cc = c & 31, ob = rr * 64 + cc * 2; return st * 1024 + (ob ^ (((ob >> 9) & 1) << 5)); }
__host__ __device__ __forceinline__ void stage_rc(int b, int& R, int& C) { const int st = b / 1024, sb = b % 1024, swz = sb ^ (((sb >> 9) & 1) << 5); R = (st >> 1) * 16 + swz / 64; C = (st & 1) * 32 + (swz % 64) / 2; }
__host__ __device__ __forceinline__ int perm32(int rho) { const int n = rho >> 4, i = rho & 15; return 8 * (i >> 2) + 4 * n + (i & 3); }

struct Unit { int pm, pn; };
struct Gemm { const bf16_t* A; const bf16_t* Bt; int M, N, K; };

struct StaticOrder {
    int nM, nN, nwg, G, c;
    __host__ __device__ void init(int M, int N, int G_, int c_) { nM = M / BM; nN = N / BM; nwg = nM * nN; G = G_; c = c_; }
    __host__ __device__ bool next(int i, Unit& u) const {
        const long L = (long)i * G + c; if (L >= nwg) return false;
        int wgid = (int)L; { const int q = nwg / NXCD, r = nwg % NXCD, xcd = wgid % NXCD, off = wgid / NXCD; wgid = (xcd < r ? xcd * (q + 1) : r * (q + 1) + (xcd - r) * q) + off; }
        const int nig = WGM * nN, gid = wgid / nig, fm = gid * WGM, gsz = (nM - fm) < WGM ? (nM - fm) : WGM;
        u.pm = fm + ((wgid % nig) % gsz); u.pn = (wgid % nig) / gsz; return true;
    }
    __device__ __forceinline__ void a_ready(const Unit&) const {}
    __device__ __forceinline__ void done(const Unit&) const {}
};

__device__ __forceinline__ unsigned cvt_pk_bf16(float lo, float hi) { unsigned r; asm volatile("v_cvt_pk_bf16_f32 %0, %1, %2" : "=v"(r) : "v"(lo), "v"(hi)); return r; }
typedef float f32x2 __attribute__((ext_vector_type(2)));
__device__ __forceinline__ f32x2 gelu_pk(f32x2 v) {
    const f32x2 av = __builtin_elementwise_abs(v), d = av * 0.2316418882f + 1.0f;
    f32x2 t; t.x = __builtin_amdgcn_rcpf(d.x); t.y = __builtin_amdgcn_rcpf(d.y);
    f32x2 q = t * 0.5307027145f + (-0.7265760135f); q = q * t + 0.7107068705f; q = q * t + (-0.142248368f); q = q * t + 0.127414796f; q = q * t;
    const f32x2 s = (v * v) * (-0.72134752044f);
    f32x2 e; e.x = __builtin_amdgcn_exp2f(s.x); e.y = __builtin_amdgcn_exp2f(s.y);
    const f32x2 m = v * (q * e), r = v - m;
    f32x2 o; o.x = v.x < 0.f ? m.x : r.x; o.y = v.y < 0.f ? m.y : r.y; return o;
}

template <int ACT  > struct EpiBf16 {
    static constexpr bool PERM = true, AFTER_DRAIN = false; static_assert(ACT == 0 || ACT == 1, "EpiBf16: ACT is 0 (none) or 1 (gelu_pk)");
    bf16_t* O; int ldc; const float* bias; int split_cols; size_t split_stride; float scale0;
    __device__ __forceinline__ void operator()(const f32x4 (&acc)[2][2][4][2], const Unit& u, int wr, int wc, int fr, int fq) const {
        const int row0 = u.pm * BM + wr * 64 + fr; int colt = u.pn * BM; bf16_t* base = O;
        float sc = 1.f; if (split_cols) { const int t = colt / split_cols; base += (size_t)t * split_stride; colt -= t * split_cols; if (t == 0) sc = scale0; }
        const int col0 = colt + wc * 32 + 8 * fq, bcol0 = u.pn * BM + wc * 32 + 8 * fq;
        const int srcl = (fr & 3) * 16 + fq * 4 + (fr >> 2);
        bf16_t* rowq = base + (size_t)(u.pm * BM + wr * 64 + fq * 4 + (fr >> 2)) * ldc + colt + wc * 32 + 8 * (fr & 3);
        f32x4 bv[2][2];
#pragma unroll
        for (int bj = 0; bj < 2; ++bj)
#pragma unroll
            for (int n = 0; n < 2; ++n) bv[bj][n] = bias ? *(const f32x4*)(bias + bcol0 + bj * HALF + 4 * n) : (f32x4){0.f, 0.f, 0.f, 0.f};
#pragma unroll
        for (int ai = 0; ai < 2; ++ai)
#pragma unroll
            for (int m = 0; m < 4; ++m) {
#pragma unroll
                for (int bj = 0; bj < 2; ++bj) { f32x4 v0 = acc[ai][bj][m][0] + bv[bj][0], v1 = acc[ai][bj][m][1] + bv[bj][1];
                    if (ACT == 1) { f32x2 a = gelu_pk((f32x2){v0[0], v0[1]}), b = gelu_pk((f32x2){v0[2], v0[3]}), c = gelu_pk((f32x2){v1[0], v1[1]}), d = gelu_pk((f32x2){v1[2], v1[3]});
                        v0 = (f32x4){a.x, a.y, b.x, b.y}; v1 = (f32x4){c.x, c.y, d.x, d.y}; }
                    v0 = v0 * sc; v1 = v1 * sc; u32x4 w; w.x = cvt_pk_bf16(v0[0], v0[1]); w.y = cvt_pk_bf16(v0[2], v0[3]); w.z = cvt_pk_bf16(v1[0], v1[1]); w.w = cvt_pk_bf16(v1[2], v1[3]);
                    u32x4 t; t.x = (unsigned)__shfl((int)w.x, srcl); t.y = (unsigned)__shfl((int)w.y, srcl); t.z = (unsigned)__shfl((int)w.z, srcl); t.w = (unsigned)__shfl((int)w.w, srcl);
                    *(u32x4*)(rowq + (size_t)(ai * HALF + m * 16) * ldc + bj * HALF) = t; } }
    }
};

struct EpiRes {
    static constexpr bool PERM = true, AFTER_DRAIN = false;
    bf16_t* out; const float* xlat; const float* xctx; const float* g1; int from_input;
    __device__ __forceinline__ void operator()(const f32x4 (&acc)[2][2][4][2], const Unit& u, int wr, int wc, int fr, int fq) const {
        const int b = u.pm / 33, seg = u.pm % 33, mr = seg == 0 ? 8 : b;
        const int col0 = u.pn * BM + wc * 32 + 8 * fq;
        const int srcl = (fr & 3) * 16 + fq * 4 + (fr >> 2);
        const int rq0 = wr * 64 + fq * 4 + (fr >> 2), cq0 = u.pn * BM + wc * 32 + 8 * (fr & 3);
        const float* gp = g1 + (size_t)mr * 6144 + col0;
        const float* xbase = seg == 0 ? xctx + (size_t)b * 256 * 1024 : xlat + ((size_t)b * 8192 + (size_t)(seg - 1) * 256) * 1024;
        bf16_t* obase = out + (size_t)u.pm * BM * 1024;
#pragma unroll
        for (int bj = 0; bj < 2; ++bj) { const f32x4 g0 = *(const f32x4*)(gp + bj * HALF), g1v = *(const f32x4*)(gp + bj * HALF + 4);
#pragma unroll
            for (int ai = 0; ai < 2; ++ai)
#pragma unroll
                for (int m = 0; m < 4; ++m) { const unsigned ro = (unsigned)(rq0 * 1024 + cq0) + (unsigned)((ai * HALF + m * 16) * 1024 + bj * HALF);
                    f32x4 x0, x1;
                    if (from_input) { x0 = *(const f32x4*)(xbase + ro); x1 = *(const f32x4*)(xbase + ro + 4); }
                    else { const u32x4 w = *(const u32x4*)(obase + ro);
                        x0 = (f32x4){__builtin_bit_cast(float, w.x << 16), __builtin_bit_cast(float, w.x & 0xffff0000u), __builtin_bit_cast(float, w.y << 16), __builtin_bit_cast(float, w.y & 0xffff0000u)};
                        x1 = (f32x4){__builtin_bit_cast(float, w.z << 16), __builtin_bit_cast(float, w.z & 0xffff0000u), __builtin_bit_cast(float, w.w << 16), __builtin_bit_cast(float, w.w & 0xffff0000u)}; }
                    const f32x4 u0 = g0 * acc[ai][bj][m][0], u1 = g1v * acc[ai][bj][m][1];
                    const unsigned p0 = (unsigned)__shfl((int)cvt_pk_bf16(u0[0], u0[1]), srcl), p1 = (unsigned)__shfl((int)cvt_pk_bf16(u0[2], u0[3]), srcl), p2 = (unsigned)__shfl((int)cvt_pk_bf16(u1[0], u1[1]), srcl), p3 = (unsigned)__shfl((int)cvt_pk_bf16(u1[2], u1[3]), srcl);
                    const f32x4 v0 = x0 + (f32x4){__builtin_bit_cast(float, p0 << 16), __builtin_bit_cast(float, p0 & 0xffff0000u), __builtin_bit_cast(float, p1 << 16), __builtin_bit_cast(float, p1 & 0xffff0000u)};
                    const f32x4 v1 = x1 + (f32x4){__builtin_bit_cast(float, p2 << 16), __builtin_bit_cast(float, p2 & 0xffff0000u), __builtin_bit_cast(float, p3 << 16), __builtin_bit_cast(float, p3 & 0xffff0000u)};
                    u32x4 o; o.x = cvt_pk_bf16(v0[0], v0[1]); o.y = cvt_pk_bf16(v0[2], v0[3]); o.z = cvt_pk_bf16(v1[0], v1[1]); o.w = cvt_pk_bf16(v1[2], v1[3]);
                    *(u32x4*)(obase + ro) = o; }
            asm volatile("" ::: "memory"); }
    }
};

template <int LAYER> struct EpiHeadNorm {
    static constexpr bool PERM = true, AFTER_DRAIN = false;
    bf16_t* O; int ldc; const float* gains; const float* RT; PG8_LAS float* xch; float qscale;
    __device__ __forceinline__ static int kind_of(int pn, int hh) {
        if (LAYER == 0) return (pn >= 1 && pn <= 3) ? 1 : (pn >= 4 && pn <= 6) ? 2 : 0;
        return pn <= 1 ? 1 : pn == 2 ? (hh < 2 ? 2 : 0) : pn <= 4 ? 1 : pn <= 6 ? 2 : 0;
    }
    __device__ __forceinline__ void operator()(const f32x4 (&acc)[2][2][4][2], const Unit& u, int wr, int wc, int fr, int fq) const {
        asm volatile("" : "+v"(fr), "+v"(fq));
        const int pn = u.pn, wid = wr * 4 + wc;
        const int row0 = u.pm * BM + wr * 64 + fr, col0 = pn * BM + wc * 32 + 8 * fq;
        const bool any = LAYER == 0 ? (pn >= 1 && pn <= 6) : (pn <= 6);
        if (any) {
#pragma unroll
            for (int ai = 0; ai < 2; ++ai)
#pragma unroll
                for (int m = 0; m < 4; ++m)
#pragma unroll
                    for (int bj = 0; bj < 2; ++bj) { const f32x4 a = acc[ai][bj][m][0], b = acc[ai][bj][m][1];
                        float s = (a[0] * a[0] + a[1] * a[1]) + (a[2] * a[2] + a[3] * a[3]) + (b[0] * b[0] + b[1] * b[1]) + (b[2] * b[2] + b[3] * b[3]);
                        s += __shfl_xor(s, 16); s += __shfl_xor(s, 32);
                        if (fq == 0) xch[wid * 256 + ((ai * 4 + m) * 2 + bj) * 16 + fr] = s; }
            asm volatile("s_waitcnt lgkmcnt(0)" ::: "memory");
            __builtin_amdgcn_s_barrier();
        }
        const int seg = u.pm % 33; const bool lat = seg != 0;
        const int srcl = (fr & 3) * 16 + fq * 4 + (fr >> 2);
        bf16_t* rowq = O + (size_t)(u.pm * BM + wr * 64 + fq * 4 + (fr >> 2)) * ldc + pn * BM + wc * 32 + 8 * (fr & 3);
#pragma unroll
        for (int ai = 0; ai < 2; ++ai)
#pragma unroll
            for (int m = 0; m < 4; ++m) { const int rt = wr * 64 + fr + ai * HALF + m * 16;
                const int t = (seg - 1) * 256 + rt;
#pragma unroll
                for (int bj = 0; bj < 2; ++bj) {
                    const int hh = 2 * bj + (wc >> 1); const int kind = kind_of(pn, hh);
                    float rs = 1.f; const bool rope = kind != 0 && lat && (LAYER == 0 || pn <= 2);
                    if (kind != 0) {
                        const float tot = xch[wid * 256 + ((ai * 4 + m) * 2 + bj) * 16 + fr] + xch[(wid ^ 1) * 256 + ((ai * 4 + m) * 2 + bj) * 16 + fr];
                        rs = __builtin_amdgcn_rsqf(tot * (1.f / 64) + 1e-6f) * (kind == 1 ? qscale : 1.f); }
                    const bool fam2 = LAYER == 1 && pn >= 3;
                    const float* gp = gains + ((kind == 1 ? 0 : 1) + (fam2 ? 2 : 0)) * 64 + 32 * (wc & 1) + 8 * fq;
                    const int pos = (wc & 1) == 0 ? (t >> 6) : (t & 63);
                    const float* cp = RT + pos * 16 + 8 * (fq & 1);
                    unsigned wv[4];
#pragma unroll
                    for (int n = 0; n < 2; ++n) { f32x4 v = acc[ai][bj][m][n];
                        if (kind != 0) { v = v * rs * *(const f32x4*)(gp + 4 * n);
                            if (rope) { const f32x4 c = *(const f32x4*)(cp + 4 * n), sn = *(const f32x4*)(cp + 2048 + 4 * n); f32x4 p;
#pragma unroll
                                for (int e = 0; e < 4; ++e) p[e] = __shfl_xor(v[e], 32);
                                v = ((fq >> 1) == 0) ? v * c - p * sn : v * c + p * sn; } }
                        wv[2 * n] = cvt_pk_bf16(v[0], v[1]); wv[2 * n + 1] = cvt_pk_bf16(v[2], v[3]); }
                    u32x4 w; w.x = (unsigned)__shfl((int)wv[0], srcl); w.y = (unsigned)__shfl((int)wv[1], srcl); w.z = (unsigned)__shfl((int)wv[2], srcl); w.w = (unsigned)__shfl((int)wv[3], srcl);
                    *(u32x4*)(rowq + (size_t)(ai * HALF + m * 16) * ldc + bj * HALF) = w; }
                asm volatile("" ::: "memory"); }
    }
};
struct LatOrder {
    StaticOrder S;
    __host__ __device__ void init(int N, int G_, int c_) { S.init(65536, N, G_, c_); }
    __host__ __device__ bool next(int i, Unit& u) const { if (!S.next(i, u)) return false; u.pm = u.pm + u.pm / 32 + 1; return true; }
    __device__ __forceinline__ void a_ready(const Unit&) const {}
    __device__ __forceinline__ void done(const Unit&) const {}
};
template <class Epi, class Sched, bool ALIGN_EPI = false, bool SP2 = false>
__device__ __forceinline__ void gemm_phase(PG8_LAS unsigned char* lds, const Gemm g, const Sched& S, const Epi& E) {
    const int tid = threadIdx.x, wid = __builtin_amdgcn_readfirstlane(tid >> 6), lane = tid & 63, wr = wid >> 2, wc = wid & 3, fr = lane & 15, fq = lane >> 4;
    const int K = g.K, nt = K / BK;
    unsigned voffA[2], voffB[2];
#pragma unroll
    for (int i = 0; i < 2; ++i) { int R, C; stage_rc(tid * 16 + i * 8192, R, C); const int Rb = Epi::PERM ? ((R & ~31) + perm32(R & 31)) : R;
        voffA[i] = (unsigned)(R * K + C) * 2u; voffB[i] = (unsigned)(Rb * K + C) * 2u; }
    const size_t kstep = (size_t)(BK * 2);
    const size_t hstep = (size_t)HALF * K * 2;
    const size_t tstep = 2 * hstep;
    const unsigned ldsw = (unsigned)wid * 1024u;
    const int aoff = lds_byte(wr * 64 + fr, fq * 8), boff = lds_byte(wc * 32 + fr, fq * 8);
#define PG8_SA(b, h) (((b) * 2 + (h)) * HTB)
#define PG8_SB(b, h) ((4 + (b) * 2 + (h)) * HTB)
#define PG8_STAGE(bufoff, gbase, voff) do { _Pragma("unroll") for (int _i = 0; _i < 2; ++_i) \
        __builtin_amdgcn_global_load_lds((const unsigned*)((const char*)(gbase) + (voff)[_i]), (PG8_LAS unsigned*)(lds + (bufoff) + ldsw + _i * 8192), 16, 0, 0); } while (0)
#define PG8_LDA(dst, b, h) do { _Pragma("unroll") for (int m = 0; m < 4; ++m) _Pragma("unroll") for (int k = 0; k < 2; ++k) dst[m][k] = *(const PG8_LAS bf16x8*)(lds + PG8_SA(b, h) + aoff + m * 2048 + k * 1024); } while (0)
#define PG8_LDB(dst, b, h) do { _Pragma("unroll") for (int n = 0; n < 2; ++n) _Pragma("unroll") for (int k = 0; k < 2; ++k) dst[n][k] = *(const PG8_LAS bf16x8*)(lds + PG8_SB(b, h) + boff + n * 2048 + k * 1024); } while (0)
#define PG8_MMA(ai, bj, At, Bt) do { __builtin_amdgcn_s_setprio(1); _Pragma("unroll") for (int m = 0; m < 4; ++m) _Pragma("unroll") for (int n = 0; n < 2; ++n) _Pragma("unroll") for (int k = 0; k < 2; ++k) \
        acc[ai][bj][m][n] = __builtin_amdgcn_mfma_f32_16x16x32_bf16(Bt[n][k], At[m][k], acc[ai][bj][m][n], 0, 0, 0); __builtin_amdgcn_s_setprio(0); } while (0)
#define PG8_WAIT_V(n) asm volatile("s_waitcnt vmcnt(" #n ")" ::: "memory")
#define PG8_WAIT_L(n) asm volatile("s_waitcnt lgkmcnt(" #n ")" ::: "memory")
#define PG8_BAR __builtin_amdgcn_s_barrier()
#define PG8_SCHED __builtin_amdgcn_sched_barrier(0)
    Unit cur, nxt; int ui = 0;
    if (!S.next(0, cur)) return;
    f32x4 acc[2][2][4][2];
#pragma unroll
    for (int a = 0; a < 2; ++a)
#pragma unroll
        for (int b = 0; b < 2; ++b)
#pragma unroll
            for (int m = 0; m < 4; ++m)
#pragma unroll
                for (int n = 0; n < 2; ++n) acc[a][b][m][n] = (f32x4){0.f, 0.f, 0.f, 0.f};
    bf16x8 At[4][2], B0[2][2], B1[2][2];
    const char* cA = (const char*)g.A + (size_t)cur.pm * tstep; const char* cB = (const char*)g.Bt + (size_t)cur.pn * tstep;
    S.a_ready(cur);
    if constexpr (SP2) {
        PG8_STAGE(PG8_SB(0, 0), cB, voffB); PG8_STAGE(PG8_SB(0, 1), cB + hstep, voffB); PG8_STAGE(PG8_SA(0, 0), cA, voffA); PG8_STAGE(PG8_SA(0, 1), cA + hstep, voffA);
        if (wr == 1) PG8_BAR;
        PG8_WAIT_V(2); PG8_BAR;
        PG8_STAGE(PG8_SB(1, 0), cB + kstep, voffB); PG8_STAGE(PG8_SA(1, 0), cA + kstep, voffA); PG8_STAGE(PG8_SB(1, 1), cB + hstep + kstep, voffB);
        PG8_WAIT_V(6); PG8_BAR;
    } else {
        PG8_STAGE(PG8_SB(0, 0), cB, voffB); PG8_STAGE(PG8_SA(0, 0), cA, voffA); PG8_STAGE(PG8_SB(0, 1), cB + hstep, voffB); PG8_STAGE(PG8_SA(0, 1), cA + hstep, voffA);
        if (wr == 1) PG8_BAR;
        PG8_WAIT_V(4); PG8_BAR;
        PG8_STAGE(PG8_SB(1, 0), cB + kstep, voffB); PG8_STAGE(PG8_SA(1, 0), cA + kstep, voffA); PG8_STAGE(PG8_SB(1, 1), cB + hstep + kstep, voffB);
        PG8_WAIT_V(6); PG8_BAR;
    }
    for (;;) {
        const bool has_next = S.next(ui + 1, nxt);
        const char* nA = has_next ? (const char*)g.A + (size_t)nxt.pm * tstep : cA; const char* nB = has_next ? (const char*)g.Bt + (size_t)nxt.pn * tstep : cB;
        for (int t = 0; t < nt; t += 2) {
            const bool last = (t == nt - 2);
            const char* a1 = cA + (size_t)(t + 1) * kstep;
            const char* a2 = last ? nA : cA + (size_t)(t + 2) * kstep; const char* b2 = last ? nB : cB + (size_t)(t + 2) * kstep;
            const char* a3 = a2 + kstep; const char* b3 = b2 + kstep;
            if (last && has_next) S.a_ready(nxt);
            if constexpr (SP2) {
            PG8_LDB(B0, 0, 0); PG8_LDB(B1, 0, 1); PG8_SCHED; PG8_LDA(At, 0, 0); PG8_STAGE(PG8_SA(1, 1), a1 + hstep, voffA);
            PG8_WAIT_V(8); PG8_WAIT_L(0); PG8_BAR; PG8_MMA(0, 0, At, B0); PG8_MMA(0, 1, At, B1); PG8_BAR; PG8_SCHED;
            PG8_LDA(At, 0, 1); PG8_STAGE(PG8_SB(0, 0), b2, voffB); PG8_STAGE(PG8_SB(0, 1), b2 + hstep, voffB); PG8_STAGE(PG8_SA(0, 0), a2, voffA);
            PG8_WAIT_V(8); PG8_WAIT_L(0); PG8_BAR; PG8_MMA(1, 0, At, B0); PG8_MMA(1, 1, At, B1); PG8_BAR; PG8_SCHED;
            PG8_LDB(B0, 1, 0); PG8_LDB(B1, 1, 1); PG8_SCHED; PG8_LDA(At, 1, 0); PG8_STAGE(PG8_SA(0, 1), a2 + hstep, voffA);
            PG8_WAIT_V(8); PG8_WAIT_L(0); PG8_BAR; PG8_MMA(0, 0, At, B0); PG8_MMA(0, 1, At, B1); PG8_BAR; PG8_SCHED;
            PG8_LDA(At, 1, 1); PG8_STAGE(PG8_SB(1, 0), b3, voffB); PG8_STAGE(PG8_SB(1, 1), b3 + hstep, voffB); PG8_STAGE(PG8_SA(1, 0), a3, voffA);
            PG8_WAIT_V(8); PG8_WAIT_L(0); PG8_BAR; PG8_MMA(1, 0, At, B0); PG8_MMA(1, 1, At, B1); PG8_BAR; PG8_SCHED;
            } else {
            PG8_LDB(B0, 0, 0); PG8_SCHED; PG8_LDA(At, 0, 0); PG8_STAGE(PG8_SA(1, 1), a1 + hstep, voffA);
            PG8_WAIT_L(8); PG8_BAR; PG8_WAIT_L(0); PG8_MMA(0, 0, At, B0); PG8_BAR; PG8_SCHED;
            PG8_LDB(B1, 0, 1); PG8_STAGE(PG8_SB(0, 0), b2, voffB);
            PG8_BAR; PG8_WAIT_L(0); PG8_MMA(0, 1, At, B1); PG8_BAR;
            PG8_LDA(At, 0, 1); PG8_STAGE(PG8_SA(0, 0), a2, voffA);
            PG8_BAR; PG8_WAIT_L(0); PG8_MMA(1, 0, At, B0); PG8_BAR; PG8_SCHED;
            PG8_STAGE(PG8_SB(0, 1), b2 + hstep, voffB);
            PG8_WAIT_V(6); PG8_BAR; PG8_MMA(1, 1, At, B1); PG8_BAR;
            PG8_LDB(B0, 1, 0); PG8_SCHED; PG8_LDA(At, 1, 0); PG8_STAGE(PG8_SA(0, 1), a2 + hstep, voffA);
            PG8_WAIT_L(8); PG8_BAR; PG8_WAIT_L(0); PG8_MMA(0, 0, At, B0); PG8_BAR; PG8_SCHED;
            PG8_LDB(B1, 1, 1); PG8_STAGE(PG8_SB(1, 0), b3, voffB);
            PG8_BAR; PG8_WAIT_L(0); PG8_MMA(0, 1, At, B1); PG8_BAR;
            PG8_LDA(At, 1, 1); PG8_STAGE(PG8_SA(1, 0), a3, voffA);
            PG8_BAR; PG8_WAIT_L(0); PG8_MMA(1, 0, At, B0); PG8_BAR; PG8_SCHED;
            PG8_STAGE(PG8_SB(1, 1), b3 + hstep, voffB);
            PG8_WAIT_V(6); PG8_BAR; PG8_MMA(1, 1, At, B1); PG8_BAR;
            }
        }
        if constexpr (ALIGN_EPI) { if (wr == 0) PG8_BAR; }
        if constexpr (!Epi::AFTER_DRAIN) { E(acc, cur, wr, wc, fr, fq); S.done(cur); }
        if (!has_next) break;
#pragma unroll
        for (int a = 0; a < 2; ++a)
#pragma unroll
            for (int b = 0; b < 2; ++b)
#pragma unroll
                for (int m = 0; m < 4; ++m)
#pragma unroll
                    for (int n = 0; n < 2; ++n) acc[a][b][m][n] = (f32x4){0.f, 0.f, 0.f, 0.f};
        cur = nxt; cA = nA; cB = nB; ++ui;
        if constexpr (ALIGN_EPI) { if (wr == 1) PG8_BAR; }
    }
    PG8_WAIT_V(0);
    if constexpr (!ALIGN_EPI) { if (wr == 0) PG8_BAR; }
    PG8_BAR;
    if constexpr (Epi::AFTER_DRAIN) { E.fused(acc, cur, wr, wc, fr, fq, lds, wid, lane); S.done(cur); }
#undef PG8_SA
#undef PG8_SB
#undef PG8_STAGE
#undef PG8_LDA
#undef PG8_LDB
#undef PG8_MMA
#undef PG8_WAIT_V
#undef PG8_WAIT_L
#undef PG8_BAR
#undef PG8_SCHED
}
}

namespace attn_body {
using bf16=__hip_bfloat16;
using bf16x8=__attribute__((ext_vector_type(8)))short;
using s16x4=__attribute__((ext_vector_type(4)))short;
using f32x16=__attribute__((ext_vector_type(16)))float;
using u32x4=__attribute__((ext_vector_type(4)))unsigned;
constexpr int D=64;
constexpr int NW=8,QBLK=32,QB=QBLK*NW,KVBLK=64;
__device__ __forceinline__ int crow(int r,int hi){return (r&3)+8*(r>>2)+4*hi;}
#define SBAR() __builtin_amdgcn_sched_barrier(0)
__device__ __forceinline__ void cmask(f32x16&p0,f32x16&p1,int jb,int qrel,int hi){
  const float NEG=-INFINITY; int kb=64*jb+4*hi;
  #pragma unroll
  for(int r=0;r<16;++r){int kv=kb+(r&3)+8*(r>>2); if(kv>qrel)p0[r]=NEG; if(kv+32>qrel)p1[r]=NEG;}
}

constexpr int NSLOT=3, SLOTB=8192;
constexpr int LDS_K=0, LDS_V=NSLOT*SLOTB, LDS_WS=2*NSLOT*SLOTB, LDS_OST=LDS_WS+NW*64*4, LDS_BYTES=LDS_OST+NW*4096;
constexpr float C2=0.125f*1.4426950408889634f;
__device__ __forceinline__ void glds16(const void*gsrc,unsigned lds_dst){unsigned keep;
  asm volatile("s_mov_b32 %0, m0\n\ts_mov_b32 m0, %2\n\ts_nop 0\n\tglobal_load_lds_dwordx4 %1, off\n\ts_mov_b32 m0, %0":"=&s"(keep):"v"(gsrc),"s"(lds_dst):"memory");}
__device__ __forceinline__ float max3f(float a,float b,float c){float r;asm("v_max3_f32 %0, %1, %2, %3":"=v"(r):"v"(a),"v"(b),"v"(c));return r;}
__device__ __forceinline__ float max2f(float a,float b){float r;asm("v_max_f32_e32 %0, %1, %2":"=v"(r):"v"(a),"v"(b));return r;}
__device__ __forceinline__ float fadd_s(float a,float b){float r;asm("v_add_f32_e32 %0, %1, %2":"=v"(r):"v"(a),"v"(b));return r;}
__device__ __forceinline__ float fsub_s(float a,float b){float r;asm("v_sub_f32_e32 %0, %1, %2":"=v"(r):"v"(a),"v"(b));return r;}
typedef float f32x2_t __attribute__((ext_vector_type(2))); typedef __bf16 bf16x2_t __attribute__((ext_vector_type(2)));
__device__ __forceinline__ unsigned cvtpk_s(float lo,float hi){f32x2_t v={lo,hi};bf16x2_t b=__builtin_convertvector(v,bf16x2_t);return __builtin_bit_cast(unsigned,b);}
#define WAIT_BAR(N) asm volatile("s_waitcnt vmcnt(" #N ") lgkmcnt(0)\n\ts_barrier":::"memory")

__device__ __forceinline__ void qkt(f32x16&p0,f32x16&p1,const char*Kslot,const bf16x8*qr,const f32x16&negm,int r32,int hi){
  const char*kb=Kslot+hi*1024+r32*16;
  #pragma unroll
  for(int d0=0;d0<4;++d0){
    const bf16x8 b0=*reinterpret_cast<const bf16x8*>(kb+d0*2048);
    const bf16x8 b1=*reinterpret_cast<const bf16x8*>(kb+d0*2048+512);
    if(d0==0){p0=__builtin_amdgcn_mfma_f32_32x32x16_bf16(b0,qr[0],negm,0,0,0);p1=__builtin_amdgcn_mfma_f32_32x32x16_bf16(b1,qr[0],negm,0,0,0);}
    else{p0=__builtin_amdgcn_mfma_f32_32x32x16_bf16(b0,qr[d0],p0,0,0,0);p1=__builtin_amdgcn_mfma_f32_32x32x16_bf16(b1,qr[d0],p1,0,0,0);}}
}
typedef __attribute__((address_space(3))) const char* lds_cptr;
typedef short v4i16_t __attribute__((ext_vector_type(4)));
__device__ __forceinline__ void kload8(bf16x8*kf,lds_cptr kp){
  kf[0]=*(const __attribute__((address_space(3))) bf16x8*)(kp);      kf[1]=*(const __attribute__((address_space(3))) bf16x8*)(kp+512);
  kf[2]=*(const __attribute__((address_space(3))) bf16x8*)(kp+2048); kf[3]=*(const __attribute__((address_space(3))) bf16x8*)(kp+2560);
  kf[4]=*(const __attribute__((address_space(3))) bf16x8*)(kp+4096); kf[5]=*(const __attribute__((address_space(3))) bf16x8*)(kp+4608);
  kf[6]=*(const __attribute__((address_space(3))) bf16x8*)(kp+6144); kf[7]=*(const __attribute__((address_space(3))) bf16x8*)(kp+6656);
}
__device__ __forceinline__ void kload2(bf16x8*kf,lds_cptr kp,int j){ kf[2*j]=*(const __attribute__((address_space(3))) bf16x8*)(kp+j*2048); kf[2*j+1]=*(const __attribute__((address_space(3))) bf16x8*)(kp+j*2048+512); }
__device__ __forceinline__ s16x4 vtr(lds_cptr p){ return __builtin_bit_cast(s16x4,__builtin_amdgcn_ds_read_tr16_b64_v4i16((__attribute__((address_space(3))) v4i16_t*)p)); }
__device__ __forceinline__ float rowmax(const f32x16&p0,const f32x16&p1){
  float a=max3f(p0[0],p0[1],p1[0]),b=max3f(p0[2],p0[3],p1[1]);a=max3f(a,p1[2],p1[3]);
  #pragma unroll
  for(int r=4;r<16;r+=4){a=max3f(a,p0[r],p0[r+1]);b=max3f(b,p0[r+2],p0[r+3]);a=max3f(a,p1[r],p1[r+1]);b=max3f(b,p1[r+2],p1[r+3]);}
  const float m=max2f(a,b);
  auto rr=__builtin_amdgcn_permlane32_swap(__float_as_uint(m),__float_as_uint(m),false,false);
  return max2f(__uint_as_float(rr[0]),__uint_as_float(rr[1]));
}
__device__ __forceinline__ void pv(f32x16*o,int vb,bf16x8 pa0,bf16x8 pa1,bf16x8 pa2,bf16x8 pa3){
  #pragma unroll
  for(int d0=0;d0<2;++d0){s16x4 lo[4],hi[4];
    #pragma unroll
    for(int ks=0;ks<4;++ks){
      asm volatile("ds_read_b64_tr_b16 %0,%1 offset:%c2":"=&v"(lo[ks]):"v"(vb),"i"(d0*4096+ks*1024):"memory");
      asm volatile("ds_read_b64_tr_b16 %0,%1 offset:%c2":"=&v"(hi[ks]):"v"(vb),"i"(d0*4096+ks*1024+512):"memory");}
    asm volatile("s_waitcnt lgkmcnt(0)":::"memory");SBAR();
    #define PK(k) (bf16x8){lo[k][0],lo[k][1],lo[k][2],lo[k][3],hi[k][0],hi[k][1],hi[k][2],hi[k][3]}
    o[d0]=__builtin_amdgcn_mfma_f32_32x32x16_bf16(pa0,PK(0),o[d0],0,0,0);
    o[d0]=__builtin_amdgcn_mfma_f32_32x32x16_bf16(pa1,PK(1),o[d0],0,0,0);
    o[d0]=__builtin_amdgcn_mfma_f32_32x32x16_bf16(pa2,PK(2),o[d0],0,0,0);
    o[d0]=__builtin_amdgcn_mfma_f32_32x32x16_bf16(pa3,PK(3),o[d0],0,0,0);
    #undef PK
  }
}

#ifndef ATTN_STORE16
#define ATTN_STORE16(p,v) (*(u32x4*)(p)=(v))
#endif
template<int DV2,int P,int OP,int MODE> __device__ __forceinline__ void attn_unit2(const bf16*Q0,const bf16*__restrict__ Kh,const bf16*__restrict__ Vh,bf16*O0,const int NT,char*shm,const float*rpbh,const int gr0,
    const bool pre,const bool has_next,const bf16*__restrict__ Khn,const bf16*__restrict__ Vhn){
  const int tid=threadIdx.x,lane=tid&63,r32=lane&31,hi=lane>>5; const int wid=__builtin_amdgcn_readfirstlane(tid>>6);
  const bf16*Qw=Q0+(long)(wid*QBLK)*P;
  constexpr int VSL=DV2, LWS_=LDS_V+NSLOT*SLOTB*DV2, LOST_=LWS_+NW*64*4;
  const unsigned lds0=(unsigned)(uintptr_t)shm;
  float*wsf=(float*)(shm+LWS_)+wid*64;
  const bf16*ksrc=Kh+(long)lane*P+wid*8;
  const bf16*vsrc=Vh+(long)(16*(wid&3)+(lane>>2))*P+(wid>>2)*32+(lane&3)*8;
  const unsigned kdst=lds0+LDS_K+wid*1024, vdst=lds0+LDS_V+wid*1024;
  #define TROW(t) (MODE==1?((t)<4?(t)*64:nb0+(t)*64):(t)*64)
  #define DMA_K(t,slot) glds16(ksrc+(long)TROW(t)*P,(unsigned)__builtin_amdgcn_readfirstlane(kdst+(slot)))
  #define DMA_V(t,slot) do{ glds16(vsrc+(long)TROW(t)*P,(unsigned)__builtin_amdgcn_readfirstlane(vdst+(slot)*VSL)); \
    if constexpr(DV2==2) glds16(vsrc+64+(long)TROW(t)*P,(unsigned)__builtin_amdgcn_readfirstlane(vdst+(slot)*VSL+8192)); }while(0)
  const int vb0=(int)(lds0+LDS_V)+((lane>>4)&1)*32+(lane&3)*8+(4*hi+((lane&15)>>2))*64;
  const char*Kbase=shm+LDS_K; bf16x8 kf[8];
  const lds_cptr shm3=(lds_cptr)shm; const lds_cptr kp0=shm3+LDS_K+hi*1024+r32*16; const lds_cptr vp0=shm3+LDS_V+((lane>>4)&1)*32+(lane&3)*8+(4*hi+((lane&15)>>2))*64;
  const int rbase=min(max(gr0-4,0),116), nb0=256+rbase*64-256;
  const int qrow=gr0+(wid>>1), r0q=min(max(qrow-4,0),120), qc=32*(wid&1)+r32, c0q=min(max(qc-8,0),48);
  const int cb=15-qc+4*hi, kvb=4*hi-c0q;
  typedef __attribute__((address_space(3))) float* lds_fptr;
  const lds_fptr btab=(lds_fptr)(shm3+LOST_+NW*4096);
  if constexpr(MODE==1){ if(tid<465) btab[tid]=rpbh[tid]*1.4426950408889634f; }
  if(!pre){DMA_K(0,0);DMA_V(0,0);DMA_K(1,SLOTB);}
  bf16x8 qr[4];
  #pragma unroll
  for(int d0=0;d0<4;++d0)qr[d0]=*reinterpret_cast<const bf16x8*>(&Qw[(long)r32*P+d0*16+hi*8]);
  float l_reg=0.f;f32x16 o[2*DV2];
  #pragma unroll
  for(int i=0;i<2*DV2;++i)o[i]=f32x16{};
  const f32x16 zero16=f32x16{};
  #define CMASK(P0,P1,t) do{ if constexpr(MODE==1){ if((t)>=4){ const int kr_=rbase+(t)-4; const bool rv_=(unsigned)(kr_-r0q)<8u; const lds_fptr bt_=btab+(rv_?(kr_-qrow+7):0)*31+cb; \
      _Pragma("unroll") for(int r=0;r<16;++r){ const int kv_=(r&3)+8*(r>>2); const bool v0_=rv_&&((unsigned)(kv_+kvb)<16u), v1_=rv_&&((unsigned)(kv_+32+kvb)<16u); \
        const float b0_=bt_[kv_], b1_=bt_[kv_+32]; P0[r]=v0_?P0[r]+b0_:-INFINITY; P1[r]=v1_?P1[r]+b1_:-INFINITY; } } } }while(0)
  #define START(P0,P1) do{ _Pragma("unroll") for(int r=0;r<16;++r)P0[r]=__builtin_amdgcn_exp2f(P0[r]); }while(0)
  #define RESC() do{}while(0)
  f32x16 pA0,pA1,pB0,pB1;
  #define WAIT_K1V() do{ if constexpr(DV2==2){WAIT_BAR(3);} else {WAIT_BAR(2);} }while(0)
  #define WAIT_V1() do{ if constexpr(DV2==2){WAIT_BAR(2);} else {WAIT_BAR(1);} }while(0)
  int sl_prev=0,sl_cur=0,sl_next=SLOTB;
  #define ROT() do{sl_prev=sl_cur;sl_cur=sl_next;sl_next=(sl_next==(NSLOT-1)*SLOTB)?0:sl_next+SLOTB;}while(0)
  if(!pre)DMA_K(2,2*SLOTB);
  WAIT_BAR(3);
  qkt(pA0,pA1,Kbase,qr,zero16,r32,hi);asm volatile("s_nop 15\n\ts_nop 7":"+v"(pA0),"+v"(pA1));CMASK(pA0,pA1,0);
  START(pA0,pA1);
  _Pragma("unroll") for(int r=0;r<16;++r)pA1[r]=__builtin_amdgcn_exp2f(pA1[r]);
  WAIT_BAR(0);
  DMA_K(3,0);DMA_V(1,SLOTB);
  ROT();
  kload8(kf,kp0+sl_cur);
  WAIT_K1V();
  s16x4 vlo[8],vhi[8]; u32x4 pw0,pw1,pw2,pw3;
  #define PKW(P,B) cvtpk_s(P[B],P[B+1])
  #define PAF(k) __builtin_bit_cast(bf16x8,pw##k)
  #define VFR(i) (bf16x8){vlo[i][0],vlo[i][1],vlo[i][2],vlo[i][3],vhi[i][0],vhi[i][1],vhi[i][2],vhi[i][3]}
  #define PIN(x) asm volatile("":"+v"(x))
  #define MX3(a,b,c) __builtin_fmaxf(__builtin_fmaxf((a),(b)),(c))
  #define GAPA(MF,A0,A1,A2,A3,W0,W1,PW) do{ MF; sacc+=A0; sacc+=A1; sacc+=A2; sacc+=A3; PIN(sacc); W0; W1; PIN(PW); SBAR(); }while(0)
  #define EX(v) __builtin_amdgcn_exp2f(v)
  #define GAPB(MF,X,B) do{ MF; X[B]=EX(X[B]); X[B+1]=EX(X[B+1]); X[B+2]=EX(X[B+2]); X[B+3]=EX(X[B+3]); PIN(X); SBAR(); }while(0)
  #define VRD(i) do{ vlo[i]=vtr(vp_+(((i)>>2)*4096+((i)&3)*1024)); vhi[i]=vtr(vp_+(((i)>>2)*4096+((i)&3)*1024+512)); }while(0)
  #define KRD(G,j) do{ if(G){ kload2(kf,kp0+sl_next,j); SBAR(); } }while(0)
  #define H1MF(oi,k,i) do{ if constexpr(DV2==2){ o[oi]=__builtin_amdgcn_mfma_f32_32x32x16_bf16(PAF(k),VFR(i),o[oi],0,0,0); } }while(0)
  #define VRDH(i) do{ if constexpr(DV2==2){ vlo[i]=vtr(vp_+(8192+((i)>>2)*4096+((i)&3)*1024)); vhi[i]=vtr(vp_+(8192+((i)>>2)*4096+((i)&3)*1024+512)); } }while(0)
  #define STEP(C0,C1,P0,P1,t,GK,GV,GL) do{ SBAR(); \
    const lds_cptr vp_=vp0+sl_prev*VSL; \
    VRD(0); SBAR(); float sacc=(P0[0]+P0[1]); \
    GAPA(C0=__builtin_amdgcn_mfma_f32_32x32x16_bf16(kf[0],qr[0],zero16,0,0,0), P0[2],P0[3],P0[4],P0[5],     pw0[0]=PKW(P0,0), pw0[1]=PKW(P0,2), pw0); \
    VRD(4); SBAR(); GAPA(C1=__builtin_amdgcn_mfma_f32_32x32x16_bf16(kf[1],qr[0],zero16,0,0,0), P0[6],P0[7],P0[8],P0[9],     pw0[2]=PKW(P0,4), pw0[3]=PKW(P0,6), pw0); \
    VRD(1); SBAR(); GAPA(C0=__builtin_amdgcn_mfma_f32_32x32x16_bf16(kf[2],qr[1],C0,0,0,0),   P0[10],P0[11],P0[12],P0[13], pw1[0]=PKW(P0,8), pw1[1]=PKW(P0,10), pw1); \
    VRD(5); SBAR(); GAPA(C1=__builtin_amdgcn_mfma_f32_32x32x16_bf16(kf[3],qr[1],C1,0,0,0),   P0[14],P0[15],P1[0],P1[1],   pw1[2]=PKW(P0,12),pw1[3]=PKW(P0,14), pw1); \
    VRD(2); SBAR(); GAPA(C0=__builtin_amdgcn_mfma_f32_32x32x16_bf16(kf[4],qr[2],C0,0,0,0),   P1[2],P1[3],P1[4],P1[5],     pw2[0]=PKW(P1,0), pw2[1]=PKW(P1,2), pw2); \
    VRD(6); SBAR(); GAPA(C1=__builtin_amdgcn_mfma_f32_32x32x16_bf16(kf[5],qr[2],C1,0,0,0),   P1[6],P1[7],P1[8],P1[9],     pw2[2]=PKW(P1,4), pw2[3]=PKW(P1,6), pw2); \
    VRD(3); SBAR(); GAPA(C0=__builtin_amdgcn_mfma_f32_32x32x16_bf16(kf[6],qr[3],C0,0,0,0),   P1[10],P1[11],P1[12],P1[13], pw3[0]=PKW(P1,8), pw3[1]=PKW(P1,10), pw3); \
    VRD(7); SBAR(); GAPA(C1=__builtin_amdgcn_mfma_f32_32x32x16_bf16(kf[7],qr[3],C1,0,0,0),   P1[14],P1[15],0.f,0.f,       pw3[2]=PKW(P1,12),pw3[3]=PKW(P1,14), pw3); \
    l_reg+=sacc; \
    if(GK){DMA_K((t)+3,sl_cur);} if(GV){DMA_V((t)+1,sl_next);} \
    CMASK(C0,C1,t); \
    SBAR(); \
    GAPB(o[0]=__builtin_amdgcn_mfma_f32_32x32x16_bf16(PAF(0),VFR(0),o[0],0,0,0); VRDH(0), C0,0); \
    GAPB(o[1]=__builtin_amdgcn_mfma_f32_32x32x16_bf16(PAF(0),VFR(4),o[1],0,0,0); VRDH(4), C0,4); \
    KRD(GL,0); GAPB(o[0]=__builtin_amdgcn_mfma_f32_32x32x16_bf16(PAF(1),VFR(1),o[0],0,0,0); H1MF(2,0,0); VRDH(1), C0,8); \
    KRD(GL,1); GAPB(o[1]=__builtin_amdgcn_mfma_f32_32x32x16_bf16(PAF(1),VFR(5),o[1],0,0,0); H1MF(3,0,4); VRDH(5), C0,12); \
    KRD(GL,2); GAPB(o[0]=__builtin_amdgcn_mfma_f32_32x32x16_bf16(PAF(2),VFR(2),o[0],0,0,0); H1MF(2,1,1); VRDH(2), C1,0); \
    KRD(GL,3); GAPB(o[1]=__builtin_amdgcn_mfma_f32_32x32x16_bf16(PAF(2),VFR(6),o[1],0,0,0); H1MF(3,1,5); VRDH(6), C1,4); \
    GAPB(o[0]=__builtin_amdgcn_mfma_f32_32x32x16_bf16(PAF(3),VFR(3),o[0],0,0,0); H1MF(2,2,2); VRDH(3), C1,8); \
    GAPB(o[1]=__builtin_amdgcn_mfma_f32_32x32x16_bf16(PAF(3),VFR(7),o[1],0,0,0); H1MF(3,2,6); VRDH(7), C1,12); \
    if constexpr(DV2==2){ H1MF(2,3,3); H1MF(3,3,7); SBAR(); } \
    }while(0)
  int t=1;
  for(;t+5<NT;t+=2){
    STEP(pB0,pB1,pA0,pA1,t,true,true,true);     WAIT_K1V(); RESC(); ROT();
    STEP(pA0,pA1,pB0,pB1,t+1,true,true,true);   WAIT_K1V(); RESC(); ROT();
  }
  #define ENDW(tt) do{ if((tt)+3<NT){WAIT_K1V();} else if((tt)+2<NT){WAIT_V1();} else {WAIT_BAR(0);} }while(0)
  for(;t+1<NT;t+=2){
    STEP(pB0,pB1,pA0,pA1,t,(t+3<NT),(t+1<NT),(t+1<NT));       ENDW(t);   RESC(); ROT();
    STEP(pA0,pA1,pB0,pB1,t+1,(t+4<NT),(t+2<NT),(t+2<NT));     ENDW(t+1); RESC(); ROT();
  }
  STEP(pB0,pB1,pA0,pA1,NT-1,false,false,false); RESC();
  { float sacc=pB0[0]+pB0[1]; _Pragma("unroll") for(int r=2;r<16;++r)sacc+=pB0[r]; _Pragma("unroll") for(int r=0;r<16;++r)sacc+=pB1[r]; l_reg+=sacc;
    pw0=(u32x4){PKW(pB0,0),PKW(pB0,2),PKW(pB0,4),PKW(pB0,6)};pw1=(u32x4){PKW(pB0,8),PKW(pB0,10),PKW(pB0,12),PKW(pB0,14)};pw2=(u32x4){PKW(pB1,0),PKW(pB1,2),PKW(pB1,4),PKW(pB1,6)};pw3=(u32x4){PKW(pB1,8),PKW(pB1,10),PKW(pB1,12),PKW(pB1,14)};
    SBAR(); pv(o,vb0+sl_cur*VSL,PAF(0),PAF(1),PAF(2),PAF(3)); if constexpr(DV2==2) pv(o+2,vb0+sl_cur*VSL+8192,PAF(0),PAF(1),PAF(2),PAF(3)); }
  #undef PKW
  #undef PAF
  #undef VFR
  #undef PIN
  #undef MX3
  #undef GAPA
  #undef GAPB
  #undef EX
  #undef VRD
  #undef KRD
  #undef STEP
  #undef ENDW
  asm volatile("s_waitcnt lgkmcnt(0)\n\ts_barrier":::"memory");
  if(has_next){ const bf16*ksn=Khn+(long)lane*P+wid*8; const bf16*vsn=Vhn+(long)(16*(wid&3)+(lane>>2))*P+(wid>>2)*32+(lane&3)*8;
    glds16(ksn,(unsigned)__builtin_amdgcn_readfirstlane(kdst)); glds16(vsn,(unsigned)__builtin_amdgcn_readfirstlane(vdst));
    if constexpr(DV2==2) glds16(vsn+64,(unsigned)__builtin_amdgcn_readfirstlane(vdst+8192));
    glds16(ksn+(long)64*P,(unsigned)__builtin_amdgcn_readfirstlane(kdst+SLOTB)); glds16(ksn+(long)128*P,(unsigned)__builtin_amdgcn_readfirstlane(kdst+2*SLOTB)); }
  {auto rr=__builtin_amdgcn_permlane32_swap(__float_as_uint(l_reg),__float_as_uint(l_reg),false,false);l_reg=__uint_as_float(rr[0])+__uint_as_float(rr[1]);}
  if(hi==0)wsf[32+r32]=l_reg;asm volatile("s_waitcnt lgkmcnt(0)":::"memory");
  float rli[16];
  #pragma unroll
  for(int r=0;r<16;++r)rli[r]=__builtin_amdgcn_rcpf(wsf[32+crow(r,hi)]);
  bf16*Ow=O0+(long)(wid*QBLK)*OP;
  { bf16*stg=(bf16*)(shm+LOST_)+wid*2048;
    #pragma unroll
    for(int hh=0;hh<DV2;++hh){
      #pragma unroll
      for(int r=0;r<16;++r){const int orow=crow(r,hi);
        #pragma unroll
        for(int d0=0;d0<2;++d0)stg[orow*64+d0*32+r32]=__float2bfloat16(o[2*hh+d0][r]*rli[r]);}
      asm volatile("s_waitcnt lgkmcnt(0)":::"memory");
      #pragma unroll
      for(int i=0;i<4;++i){const int row=i*8+(lane>>3),ch=lane&7; const u32x4 v=*(const u32x4*)(stg+row*64+ch*8); ATTN_STORE16(Ow+(long)row*OP+hh*64+ch*8,v);}
      asm volatile("s_waitcnt lgkmcnt(0)":::"memory"); } }
  asm volatile("s_waitcnt lgkmcnt(0)\n\ts_barrier":::"memory");
  #undef DMA_K
  #undef DMA_V
  #undef CMASK
  #undef START
  #undef RESC
  #undef ROT
  #undef TROW
  #undef WAIT_K1V
  #undef WAIT_V1
  #undef VRDH
  #undef H1MF
}

#undef SBAR
#undef WAIT_BAR
}

constexpr int NWAVES = 8;
#ifndef DBGZ
#define DBGZ 0
#endif
#ifndef MK_PER_PHASE
#define MK_PER_PHASE 0
#endif

constexpr int NB = 8, TL = 8192, CL = 256, RPB = TL + CL  , MT = NB * RPB  , DM = 1024;
constexpr int N_IN0 = 2560, N_IN1 = 2304, N_WQ = 2048, OD_P = 1536;
constexpr float EPS = 1e-6f, LOG2E = 1.4426950408889634f, QSCALE = 0.125f * 1.4426950408889634f;
constexpr int PH_PER_LAYER = 10, N_PHASES = 1 + 2 * PH_PER_LAYER;

constexpr size_t MiB = 1u << 20;
constexpr size_t WS_CTL = 0, CTL_ZERO_BYTES = 1 * MiB;
constexpr size_t WS_MOD = 1 * MiB;
constexpr size_t WS_ROPE = 2 * MiB;
constexpr size_t WS_WIN0 = 3 * MiB, WS_WOUT0 = 8 * MiB, WS_WQ0 = 10 * MiB, WS_WIN1 = 14 * MiB, WS_WOUT1 = 19 * MiB, WS_WQ1 = 21 * MiB;
constexpr size_t WS_KEYS0 = 25 * MiB, WS_KEYS1 = 25 * MiB + 512 * 1024;
constexpr size_t WS_U0 = 32 * MiB, WS_U1 = 64 * MiB;
constexpr float U_SCALE = 64.f, V_SCALE = 4.f;
constexpr size_t WS_XS = 160 * MiB;
constexpr size_t WS_XN = 424 * MiB;
constexpr size_t WS_PB = 556 * MiB;
constexpr size_t WS_EI = WS_PB + 264 * MiB, WS_EG = WS_EI + 33 * MiB;
constexpr size_t WS_END = 886 * MiB;
static_assert((size_t)MT * 1024 * 4 == 264 * MiB && (size_t)MT * 2560 * 2 == 330 * MiB && (size_t)MT * 128 * 4 == 33 * MiB, "ws map");
constexpr int CW_TMO = 0, CW_BAR = 4096;

constexpr int RING_BYTES = 131072, LDSCTL_OFF = RING_BYTES, MISC_OFF = LDSCTL_OFF + 320, LDS_BYTES = 147456;

#define GAS __attribute__((address_space(1)))
#define LAS __attribute__((address_space(3)))
typedef unsigned short bf16;
typedef unsigned v4u __attribute__((ext_vector_type(4)));
typedef unsigned v2u __attribute__((ext_vector_type(2)));
typedef float f32x4 __attribute__((ext_vector_type(4)));
typedef float f32x16 __attribute__((ext_vector_type(16)));
typedef short bf16x8 __attribute__((ext_vector_type(8)));
typedef __bf16 bf16x2v __attribute__((ext_vector_type(2)));
typedef GAS unsigned gu32;
#define RLX_AGENT __ATOMIC_RELAXED, __HIP_MEMORY_SCOPE_AGENT
__device__ __forceinline__ unsigned f2bf(float f) { unsigned u = __builtin_bit_cast(unsigned, f); return (u + 0x7fffu + ((u >> 16) & 1u)) >> 16; }
__device__ __forceinline__ unsigned pk2(float lo, float hi) { return f2bf(lo) | (f2bf(hi) << 16); }
__device__ __forceinline__ float bflo(unsigned u) { return __builtin_bit_cast(float, u << 16); }
__device__ __forceinline__ float bfhi(unsigned u) { return __builtin_bit_cast(float, u & 0xffff0000u); }
__device__ __forceinline__ float bf1(bf16 h) { return __builtin_bit_cast(float, (unsigned)h << 16); }
__device__ __forceinline__ float wave_sum(float v) {
#pragma unroll
    for (int o = 1; o < 64; o <<= 1) v += __shfl_xor(v, o);
    return v;
}
__device__ __forceinline__ float dot2bf(unsigned w, unsigned x, float acc) { return __builtin_amdgcn_fdot2_f32_bf16(__builtin_bit_cast(bf16x2v, w), __builtin_bit_cast(bf16x2v, x), acc, false); }
__device__ __forceinline__ float fast_exp2(float x) { return __builtin_amdgcn_exp2f(x); }
__device__ __forceinline__ float gelu_erf(float v) {
    const float av = fabsf(v), t = __builtin_amdgcn_rcpf(av * 0.2316418882f + 1.0f);
    float q = t * 0.5307027145f + (-0.7265760135f); q = q * t + 0.7107068705f; q = q * t + (-0.142248368f); q = q * t + 0.127414796f; q = q * t;
    const float e = __builtin_amdgcn_exp2f((v * v) * (-0.72134752044f));
    const float m = v * (q * e);
    return v < 0.f ? m : v - m;
}

#define XB_TMO      128
#define XB_XCNT(j)  (256  + 64 * (j))
#define XB_XSUB(j)  (1280 + 64 * (j))
#define XB_XGEN(j)  (2304 + 64 * (j))
#define XB_TOP      3328
#define XB_TOPGEN   3392
#define XCD_BAR_WORDS 3456
#define XB_SPIN_CAP (1u << 18)

__device__ __forceinline__ unsigned xb_ld(unsigned* p)              { return __hip_atomic_load(p, __ATOMIC_RELAXED, __HIP_MEMORY_SCOPE_AGENT); }
__device__ __forceinline__ unsigned xb_add(unsigned* p, unsigned v) { return __hip_atomic_fetch_add(p, v, __ATOMIC_RELAXED, __HIP_MEMORY_SCOPE_AGENT); }
__device__ __forceinline__ unsigned xb_xcc_id() { return (unsigned)__builtin_amdgcn_s_getreg((3 << 11) | 20) & 0xFu; }
#define XB_SPIN(cond, bar) do { unsigned _sp = 0; while (cond) { __builtin_amdgcn_s_sleep(1); \
    if ((++_sp & 255u) == 0u) { if (xb_ld(&(bar)[XB_TMO])) break; if (_sp > XB_SPIN_CAP) { atomicAdd(&(bar)[XB_TMO], 1u); break; } } } } while (0)

struct XcdBarrier {
    unsigned* bar; unsigned x;
    volatile LAS unsigned* st;
};

__device__ __forceinline__ XcdBarrier xcd_barrier_post(unsigned* bar, volatile LAS unsigned* st) {
    XcdBarrier b; b.bar = bar; b.x = xb_xcc_id(); b.st = st;
    if (threadIdx.x == 0) (void)xb_add(&bar[XB_XCNT(b.x)], 1u);
    return b;
}
__device__ __forceinline__ void xcd_barrier_complete(unsigned* bar, unsigned x, unsigned& nloc, unsigned& nx) {
    const unsigned G = gridDim.x * gridDim.y * gridDim.z;
    unsigned sum, cnt, mine, sp = 0u;
    for (;;) {
        sum = 0u; cnt = 0u; mine = 0u;
#pragma unroll
        for (unsigned j = 0; j < 16; ++j) { const unsigned c = xb_ld(&bar[XB_XCNT(j)]); sum += c; cnt += (c > 0u) ? 1u : 0u; mine = (j == x) ? c : mine; }
        if (sum == G) break;
        __builtin_amdgcn_s_sleep(1);
        if ((++sp & 255u) == 0u) { if (xb_ld(&bar[XB_TMO])) break; if (sp > XB_SPIN_CAP) { atomicAdd(&bar[XB_TMO], 1u); break; } }
    }
    nloc = mine > 0u ? mine : 1u; nx = cnt > 0u ? cnt : 1u;
}

__device__ __forceinline__ void xcd_barrier(const XcdBarrier& b) {
    asm volatile("s_waitcnt vmcnt(0)" ::: "memory");
    __syncthreads();
    if (threadIdx.x == 0) {
        unsigned* bar = b.bar;
        __builtin_amdgcn_s_waitcnt(0);
        unsigned nloc = b.st[0], nx = b.st[1];
        if (nloc == 0u) { xcd_barrier_complete(bar, b.x, nloc, nx); b.st[0] = nloc; b.st[1] = nx; }
        const unsigned old = xb_add(&bar[XB_XSUB(b.x)], 1u);
        const unsigned gen = old / nloc;
        if (old + 1u == (gen + 1u) * nloc) {
            __builtin_amdgcn_fence(__ATOMIC_RELEASE, "agent");
            asm volatile("s_waitcnt vmcnt(0)" ::: "memory");
            const unsigned og = xb_add(&bar[XB_TOP], 1u);
            const unsigned tg = og / nx;
            if (og + 1u == (tg + 1u) * nx) xb_add(&bar[XB_TOPGEN], 1u);
            else XB_SPIN(xb_ld(&bar[XB_TOPGEN]) == tg, bar);
            __builtin_amdgcn_fence(__ATOMIC_ACQUIRE, "agent");
            xb_add(&bar[XB_XGEN(b.x)], 1u);
            asm volatile("s_waitcnt vmcnt(0)" ::: "memory");
        } else {
            XB_SPIN(xb_ld(&bar[XB_XGEN(b.x)]) == gen, bar);
            __builtin_amdgcn_fence(__ATOMIC_ACQUIRE, "agent");
            asm volatile("s_waitcnt vmcnt(0)" ::: "memory");
        }
    }
    __syncthreads();
}


struct Frame {
    LAS unsigned char* lds;
    gu32* ctl;
    int tid, lane, wave, vcu, G, gw, NGW;
};

struct Args { const float* in[38]; float* out; unsigned char* ws; int ph_lo, ph_hi, li, pad; };

__device__ __forceinline__ void p0_transpose_item(const float* W, int K, int N, bf16* WT, LAS float* scr, int item, int lane) {
    const int nblk = N / 32, kb = item / nblk, nb = item % nblk, k0 = 64 * kb, n0 = 32 * nb;
#pragma unroll 8
    for (int i = 0; i < 32; ++i) { const int kk = 2 * i + (lane >> 5); scr[kk * 33 + (lane & 31)] = W[(size_t)(k0 + kk) * N + n0 + (lane & 31)]; }
    asm volatile("s_waitcnt lgkmcnt(0)" ::: "memory");
    const int c = lane & 7;
#pragma unroll
    for (int j = 0; j < 4; ++j) { const int n = (lane >> 3) + 8 * j; const LAS float* s = scr + (8 * c) * 33 + n;
        v4u o; o.x = pk2(s[0 * 33], s[1 * 33]); o.y = pk2(s[2 * 33], s[3 * 33]); o.z = pk2(s[4 * 33], s[5 * 33]); o.w = pk2(s[6 * 33], s[7 * 33]);
        *(v4u*)(WT + (size_t)(n0 + n) * K + k0 + 8 * c) = o; }
    asm volatile("s_waitcnt lgkmcnt(0)" ::: "memory");
}
__device__ __forceinline__ void cvt_bf16_stream(const float* src, bf16* dst, size_t n, int gtid, int nthr) {
    for (size_t i = (size_t)gtid * 8; i < n; i += (size_t)nthr * 8) {
        const f32x4 a = *(const f32x4*)(src + i), b = *(const f32x4*)(src + i + 4);
        v4u o; o.x = pk2(a.x, a.y); o.y = pk2(a.z, a.w); o.z = pk2(b.x, b.y); o.w = pk2(b.z, b.w);
        *(v4u*)(dst + i) = o; }
}
__device__ __forceinline__ unsigned enc8_fp4(const float* p, float sc) {
    const f32x4 a = *(const f32x4*)p, b = *(const f32x4*)(p + 4);
    unsigned r = 0;
    r = __builtin_amdgcn_cvt_scalef32_pk_fp4_f32(r, a.x * sc, a.y * sc, 1.0f, 0); r = __builtin_amdgcn_cvt_scalef32_pk_fp4_f32(r, a.z * sc, a.w * sc, 1.0f, 1);
    r = __builtin_amdgcn_cvt_scalef32_pk_fp4_f32(r, b.x * sc, b.y * sc, 1.0f, 2); r = __builtin_amdgcn_cvt_scalef32_pk_fp4_f32(r, b.z * sc, b.w * sc, 1.0f, 3);
    return r; }
__device__ __forceinline__ void cvt_fp4_uv(const float* u, const float* v, unsigned char* dst, int gtid, int nthr) {
#pragma unroll 4
    for (size_t i = (size_t)gtid * 8; i < (size_t)16384 * 1024; i += (size_t)nthr * 8) {
        unsigned char* rowp = dst + (i >> 10) * 1024 + ((i & 1023) >> 1);
        *(unsigned*)rowp = enc8_fp4(u + i, U_SCALE); *(unsigned*)(rowp + 512) = enc8_fp4(v + i, V_SCALE); }
}
__device__ __forceinline__ void sincos_small(double x, double& s, double& c) {
    const double n = __builtin_rint(x * 0.63661977236758134308);
    double r = __builtin_fma(-n, 1.57079632679489655800e+00, x); r = __builtin_fma(-n, 6.12323399573676603587e-17, r);
    const int q = (int)n & 3; const double r2 = r * r;
    const double sp = r * (1.0 + r2 * (-1.0 / 6 + r2 * (1.0 / 120 + r2 * (-1.0 / 5040 + r2 * (1.0 / 362880 + r2 * (-1.0 / 39916800 + r2 * (1.0 / 6227020800.0)))))));
    const double cp = 1.0 + r2 * (-0.5 + r2 * (1.0 / 24 + r2 * (-1.0 / 720 + r2 * (1.0 / 40320 + r2 * (-1.0 / 3628800 + r2 * (1.0 / 479001600 + r2 * (-1.0 / 87178291200.0)))))));
    s = (q == 0) ? sp : (q == 1) ? cp : (q == 2) ? -sp : -cp;
    c = (q == 0) ? cp : (q == 1) ? -sp : (q == 2) ? -cp : sp;
}
__device__ __forceinline__ float inv_freq(int i) {
    const float t[16] = {1.0f, 0.5623413251903491f, 0.31622776601683794f, 0.17782794100389228f, 0.1f, 0.05623413251903491f, 0.031622776601683794f, 0.017782794100389228f,
                         0.01f, 0.005623413251903491f, 0.0031622776601683794f, 0.0017782794100389228f, 0.001f, 0.0005623413251903491f, 0.00031622776601683794f, 0.00017782794100389228f};
    float r = t[0];
#pragma unroll
    for (int k = 1; k < 16; ++k) r = (i == k) ? t[k] : r;
    return r;
}
__device__ __forceinline__ void p0_prologue(const Frame& F, const Args& A) {
    unsigned char* ws = A.ws;
    LAS float* sil = (LAS float*)F.lds;
    for (int i = F.tid; i < 9 * 1024; i += NWAVES * 64) { const int r = i >> 10, k = i & 1023; const float cv = r < 8 ? A.in[1][r * 1024 + k] : A.in[3][k]; sil[i] = cv / (1.0f + fast_exp2(-cv * LOG2E)); }
    __syncthreads();
    LAS float* part = (LAS float*)(F.lds + 110592);
    if (F.vcu < 192) {
        const int layer = F.vcu / 96, col = (F.vcu % 96) * 64 + F.lane;
        const float* W = A.in[layer ? 23 : 4];
        float acc[9];
#pragma unroll
        for (int r = 0; r < 9; ++r) acc[r] = 0.f;
#pragma unroll 1
        for (int k = F.wave * 128; k < F.wave * 128 + 128; k += 16) {
            const float* wk = W + (size_t)k * 6144;
            float w[16];
#pragma unroll
            for (int i = 0; i < 16; ++i) w[i] = wk[(unsigned)(col + i * 6144)];
#pragma unroll
            for (int i = 0; i < 16; i += 4) {
#pragma unroll
                for (int r = 0; r < 9; ++r) { const f32x4 s4 = *(const LAS f32x4*)(sil + r * 1024 + k + i); acc[r] += (s4.x * w[i] + s4.y * w[i + 1]) + (s4.z * w[i + 2] + s4.w * w[i + 3]); }
                __builtin_amdgcn_sched_barrier(0); }
        }
#pragma unroll
        for (int r = 0; r < 9; ++r) part[(F.wave * 9 + r) * 64 + F.lane] = acc[r];
    }
    __syncthreads();
    if (F.vcu < 192 && F.wave == 0) {
        const int layer = F.vcu / 96, col = (F.vcu % 96) * 64 + F.lane;
        const float* bb = A.in[layer ? 24 : 5];
        float* MOD = (float*)(ws + WS_MOD);
#pragma unroll
        for (int r = 0; r < 9; ++r) { float t = bb[col];
#pragma unroll
            for (int w = 0; w < 8; ++w) t += part[(w * 9 + r) * 64 + F.lane];
            MOD[(size_t)(layer * 9 + r) * 6144 + col] = t; }
    }
    { const int g = F.vcu * (NWAVES * 64) + F.tid;
      if (g < 2048) { const int pos = g >> 4, i = g & 15; const float ang = (float)pos * inv_freq(i); double s, c; sincos_small((double)ang, s, c);
          float* RT = (float*)(ws + WS_ROPE); RT[g] = (float)c; RT[2048 + g] = (float)s; } }
    { const int g = F.vcu * (NWAVES * 64) + F.tid;
      if (g < 512) { const int layer = g >> 8, j = (g >> 6) & 3, i = g & 63; const int src = layer ? 29 + j : (j == 0 ? 12 : 13);
          ((float*)(ws + WS_ROPE))[4096 + g] = (layer == 0 && j >= 2) ? 1.0f : A.in[src][i]; } }
    { LAS float* scr = (LAS float*)(F.lds + 40960 + F.wave * 8704);
      constexpr int I0 = 16 * (N_IN0 / 32), I1 = 16 * 32, I2 = 16 * (N_WQ / 32), I3 = 16 * (N_IN1 / 32);
      constexpr int NIT = I0 + I1 + I2 + I3 + I1 + I2;
      for (int it = F.gw; it < NIT; it += F.NGW) {
          int r = it;
          if (r < I0) { p0_transpose_item(A.in[8], 1024, N_IN0, (bf16*)(ws + WS_WIN0), scr, r, F.lane); continue; } r -= I0;
          if (r < I1) { p0_transpose_item(A.in[9], 1024, 1024, (bf16*)(ws + WS_WOUT0), scr, r, F.lane); continue; } r -= I1;
          if (r < I2) { p0_transpose_item(A.in[19], 1024, N_WQ, (bf16*)(ws + WS_WQ0), scr, r, F.lane); continue; } r -= I2;
          if (r < I3) { p0_transpose_item(A.in[27], 1024, N_IN1, (bf16*)(ws + WS_WIN1), scr, r, F.lane); continue; } r -= I3;
          if (r < I1) { p0_transpose_item(A.in[28], 1024, 1024, (bf16*)(ws + WS_WOUT1), scr, r, F.lane); continue; } r -= I1;
          p0_transpose_item(A.in[34], 1024, N_WQ, (bf16*)(ws + WS_WQ1), scr, r, F.lane);
      } }
    { const int gt = F.vcu * (NWAVES * 64) + F.tid, nt = F.G * NWAVES * 64;
      cvt_bf16_stream(A.in[20], (bf16*)(ws + WS_KEYS0), (size_t)8 * 2 * 128 * 128, gt, nt);
      cvt_bf16_stream(A.in[35], (bf16*)(ws + WS_KEYS1), (size_t)8 * 2 * 128 * 128, gt, nt);
      cvt_fp4_uv(A.in[21], A.in[22], ws + WS_U0, gt, nt);
      cvt_fp4_uv(A.in[36], A.in[37], ws + WS_U1, gt, nt); }
}

template <bool FROM_INPUT> __device__ __forceinline__ void norm_mod_phase(const Frame& F, const float* x, const float* ctx, const bf16* XS, const float* gain, const float* sh, const float* sc, bf16* dst, bool lat_only) {
    const int NV = lat_only ? NB * TL : MT;
    int it = F.gw; if (it >= NV) return;
    int row = lat_only ? (it >> 13) * RPB + CL + (it & 8191) : it;
    f32x4 gq[4];
#pragma unroll
    for (int j = 0; j < 4; ++j) gq[j] = *(const f32x4*)(gain + 4 * F.lane + 256 * j);
    f32x4 vin[4]; v2u win[4];
    { const int b = row / RPB, r = row - b * RPB; const bool cr = r < CL;
      const float* xr = cr ? ctx + ((size_t)b * CL + r) * DM : x + ((size_t)b * TL + (r - CL)) * DM;
#pragma unroll
      for (int j = 0; j < 4; ++j) { if (FROM_INPUT) vin[j] = *(const f32x4*)(xr + 4 * F.lane + 256 * j); else win[j] = *(const v2u*)(XS + (size_t)row * DM + 4 * F.lane + 256 * j); } }
    for (;;) {
        const int itn = it + F.NGW; const bool hn = itn < NV; const int rown = hn ? (lat_only ? (itn >> 13) * RPB + CL + (itn & 8191) : itn) : row;
        const int b = row / RPB, r = row - b * RPB; const bool cr = r < CL; const int mr = cr ? 8 : b;
        f32x4 v[4];
#pragma unroll
        for (int j = 0; j < 4; ++j) v[j] = FROM_INPUT ? vin[j] : (f32x4){bflo(win[j].x), bfhi(win[j].x), bflo(win[j].y), bfhi(win[j].y)};
        { const int bn = rown / RPB, rn = rown - bn * RPB; const bool crn = rn < CL;
          const float* xr = crn ? ctx + ((size_t)bn * CL + rn) * DM : x + ((size_t)bn * TL + (rn - CL)) * DM;
#pragma unroll
          for (int j = 0; j < 4; ++j) { if (FROM_INPUT) vin[j] = *(const f32x4*)(xr + 4 * F.lane + 256 * j); else win[j] = *(const v2u*)(XS + (size_t)rown * DM + 4 * F.lane + 256 * j); } }
        f32x4 aq[4], hq[4];
#pragma unroll
        for (int j = 0; j < 4; ++j) { const int col = 4 * F.lane + 256 * j; aq[j] = *(const f32x4*)(sc + (size_t)mr * 6144 + col); hq[j] = *(const f32x4*)(sh + (size_t)mr * 6144 + col); }
        float s = 0.f;
#pragma unroll
        for (int j = 0; j < 4; ++j) s += (v[j].x * v[j].x + v[j].y * v[j].y) + (v[j].z * v[j].z + v[j].w * v[j].w);
        const float rs = __builtin_amdgcn_rsqf(wave_sum(s) * (1.f / DM) + EPS);
#pragma unroll
        for (int j = 0; j < 4; ++j) { const int col = 4 * F.lane + 256 * j;
            const f32x4 y = v[j] * rs * gq[j] * (aq[j] + 1.0f) + hq[j];
            v2u o; o.x = pk2(y.x, y.y); o.y = pk2(y.z, y.w);
            *(v2u*)(dst + (size_t)row * DM + col) = o; }
        if (!hn) break;
        it = itn; row = rown;
    }
}

__device__ __forceinline__ void l0_headnorm_pool_phase(const Frame& F, const Args& A, bf16* PB, bf16* Y, const float* RT) {
    LAS float* wl = (LAS float*)F.lds;
    for (int i = F.tid; i < 4 * 64 * 64; i += NWAVES * 64) wl[i] = A.in[10][i];
    __syncthreads();
    const float* pscale = A.in[11];
    {
        const int l = F.lane, g = l >> 4, hw = 1 << g, d0 = 4 * (l & 15);
        LAS float* ps = (LAS float*)(F.lds + 65536) + F.wave * 256;
        const f32x4 sc4 = *(const f32x4*)(pscale + 4 * l);
        for (int row = F.gw; row < MT; row += F.NGW) {
            const int b = row / RPB, r = row - b * RPB; const bool lat = r >= CL;
            const int pos = lat ? r - CL : r, L = lat ? TL : CL; const size_t segbase = (size_t)b * RPB + (lat ? CL : 0);
            v2u raw[16];
#pragma unroll
            for (int k = 0; k < 16; ++k) { const int p = pos + k - 8; const int pc = min(max(p, 0), L - 1); raw[k] = *(const v2u*)(PB + (segbase + pc) * N_IN0 + 4 * l); }
            f32x4 sum = {0.f, 0.f, 0.f, 0.f};
#pragma unroll
            for (int k = 0; k < 16; ++k) { const int dp = k - 8, p = pos + dp; const bool use = dp >= -hw && dp < hw && p >= 0 && p < L;
                const f32x4 v = {bflo(raw[k].x), bfhi(raw[k].x), bflo(raw[k].y), bfhi(raw[k].y)}; sum = use ? sum + v : sum; }
            const f32x4 self = {bflo(raw[8].x), bfhi(raw[8].x), bflo(raw[8].y), bfhi(raw[8].y)};
            const float rc = 1.0f / (float)(min(pos + hw, L) - max(pos - hw, 0));
            const f32x4 pv = sum * rc - self;
            *(LAS f32x4*)(ps + 4 * l) = pv;
            f32x4 y = {0.f, 0.f, 0.f, 0.f};
#pragma unroll 4
            for (int c = 0; c < 64; c += 4) { const f32x4 p4 = *(const LAS f32x4*)(ps + g * 64 + c);
                const LAS float* wp = wl + (g * 64 + c) * 64 + d0;
                y += p4.x * *(const LAS f32x4*)(wp) + p4.y * *(const LAS f32x4*)(wp + 64) + p4.z * *(const LAS f32x4*)(wp + 128) + p4.w * *(const LAS f32x4*)(wp + 192); }
            y = y * sc4;
            v2u o; o.x = pk2(y.x, y.y); o.y = pk2(y.z, y.w);
            if (DBGZ & 1) { o.x = 0u; o.y = 0u; }
            *(v2u*)(Y + (size_t)row * DM + 4 * l) = o;
        }
    }
    __syncthreads();
}

__device__ __forceinline__ void l0_diff_combine_phase(const Frame& F, const Args& A, const bf16* OD, bf16* Y) {
    const float s1 = wave_sum(A.in[14][F.lane] * A.in[15][F.lane]), s2 = wave_sum(A.in[16][F.lane] * A.in[17][F.lane]);
    const float lam = fast_exp2(s1 * LOG2E) - fast_exp2(s2 * LOG2E) + 0.2f;
    const int l32 = F.lane & 31;
    const f32x4 sub = *(const f32x4*)(A.in[18] + 4 * l32);
    for (int row = F.gw; row < MT; row += F.NGW) {
#pragma unroll
        for (int pass = 0; pass < 3; ++pass) { const int h = pass * 2 + (F.lane >> 5);
            const v2u a = *(const v2u*)(OD + (size_t)row * OD_P + (2 * h) * 128 + 4 * l32), c = *(const v2u*)(OD + (size_t)row * OD_P + (2 * h + 1) * 128 + 4 * l32);
            f32x4 o; o.x = bflo(a.x) - lam * bflo(c.x); o.y = bfhi(a.x) - lam * bfhi(c.x); o.z = bflo(a.y) - lam * bflo(c.y); o.w = bfhi(a.y) - lam * bfhi(c.y);
            float ss = (o.x * o.x + o.y * o.y) + (o.z * o.z + o.w * o.w);
            ss += __shfl_xor(ss, 1); ss += __shfl_xor(ss, 2); ss += __shfl_xor(ss, 4); ss += __shfl_xor(ss, 8); ss += __shfl_xor(ss, 16);
            const float rs = __builtin_amdgcn_rsqf(ss * (1.f / 128) + EPS) * 0.8f;
            v2u w; w.x = pk2(o.x * rs * sub.x, o.y * rs * sub.y); w.y = pk2(o.z * rs * sub.z, o.w * rs * sub.w);
            if (DBGZ & 2) { w.x = 0u; w.y = 0u; }
            *(v2u*)(Y + (size_t)row * DM + 256 + h * 128 + 4 * l32) = w; }
    }
}

__device__ __forceinline__ void l0_pool_combine_phase(const Frame& F, const Args& A, const bf16* PB, const bf16* OD, bf16* Y) {
    LAS float* wl = (LAS float*)F.lds;
    for (int i = F.tid; i < 4 * 64 * 64; i += NWAVES * 64) wl[i] = A.in[10][i];
    __syncthreads();
    const float* pscale = A.in[11];
    const float s1 = wave_sum(A.in[14][F.lane] * A.in[15][F.lane]), s2 = wave_sum(A.in[16][F.lane] * A.in[17][F.lane]);
    const float lam = fast_exp2(s1 * LOG2E) - fast_exp2(s2 * LOG2E) + 0.2f;
    const int l = F.lane, g = l >> 4, hw = 1 << g, d0 = 4 * (l & 15), l32 = l & 31;
    const f32x4 sub = *(const f32x4*)(A.in[18] + 4 * l32);
    LAS float* ps = (LAS float*)(F.lds + 65536) + F.wave * 256;
    const f32x4 sc4 = *(const f32x4*)(pscale + 4 * l);
    for (int row = F.gw; row < MT; row += F.NGW) {
        const int b = row / RPB, r = row - b * RPB; const bool lat = r >= CL;
        const int pos = lat ? r - CL : r, L = lat ? TL : CL; const size_t segbase = (size_t)b * RPB + (lat ? CL : 0);
        v2u raw[16], ca[3], cc[3];
#pragma unroll
        for (int k = 0; k < 16; ++k) { const int p = pos + k - 8; const int pc = min(max(p, 0), L - 1); raw[k] = *(const v2u*)(PB + (segbase + pc) * N_IN0 + 4 * l); }
#pragma unroll
        for (int pass = 0; pass < 3; ++pass) { const int h = pass * 2 + (l >> 5);
            ca[pass] = *(const v2u*)(OD + (size_t)row * OD_P + (2 * h) * 128 + 4 * l32); cc[pass] = *(const v2u*)(OD + (size_t)row * OD_P + (2 * h + 1) * 128 + 4 * l32); }
        f32x4 sum = {0.f, 0.f, 0.f, 0.f};
#pragma unroll
        for (int k = 0; k < 16; ++k) { const int dp = k - 8, p = pos + dp; const bool use = dp >= -hw && dp < hw && p >= 0 && p < L;
            const f32x4 v = {bflo(raw[k].x), bfhi(raw[k].x), bflo(raw[k].y), bfhi(raw[k].y)}; sum = use ? sum + v : sum; }
        const f32x4 self = {bflo(raw[8].x), bfhi(raw[8].x), bflo(raw[8].y), bfhi(raw[8].y)};
        const float rc = 1.0f / (float)(min(pos + hw, L) - max(pos - hw, 0));
        const f32x4 pv = sum * rc - self;
        *(LAS f32x4*)(ps + 4 * l) = pv;
        f32x4 y = {0.f, 0.f, 0.f, 0.f};
#pragma unroll 4
        for (int c = 0; c < 64; c += 4) { const f32x4 p4 = *(const LAS f32x4*)(ps + g * 64 + c);
            const LAS float* wp = wl + (g * 64 + c) * 64 + d0;
            y += p4.x * *(const LAS f32x4*)(wp) + p4.y * *(const LAS f32x4*)(wp + 64) + p4.z * *(const LAS f32x4*)(wp + 128) + p4.w * *(const LAS f32x4*)(wp + 192); }
        y = y * sc4;
        { v2u o; o.x = pk2(y.x, y.y); o.y = pk2(y.z, y.w);
          if (DBGZ & 1) { o.x = 0u; o.y = 0u; }
          *(v2u*)(Y + (size_t)row * DM + 4 * l) = o; }
#pragma unroll
        for (int pass = 0; pass < 3; ++pass) { const int h = pass * 2 + (l >> 5);
            const v2u a = ca[pass], c = cc[pass];
            f32x4 o; o.x = bflo(a.x) - lam * bflo(c.x); o.y = bfhi(a.x) - lam * bfhi(c.x); o.z = bflo(a.y) - lam * bflo(c.y); o.w = bfhi(a.y) - lam * bfhi(c.y);
            float ss = (o.x * o.x + o.y * o.y) + (o.z * o.z + o.w * o.w);
            ss += __shfl_xor(ss, 1); ss += __shfl_xor(ss, 2); ss += __shfl_xor(ss, 4); ss += __shfl_xor(ss, 8); ss += __shfl_xor(ss, 16);
            const float rs = __builtin_amdgcn_rsqf(ss * (1.f / 128) + EPS) * 0.8f;
            v2u w; w.x = pk2(o.x * rs * sub.x, o.y * rs * sub.y); w.y = pk2(o.z * rs * sub.z, o.w * rs * sub.w);
            if (DBGZ & 2) { w.x = 0u; w.y = 0u; }
            *(v2u*)(Y + (size_t)row * DM + 256 + h * 128 + 4 * l32) = w; }
    }
    __syncthreads();
}

constexpr int NCAND = 50;
__device__ __forceinline__ void ce_desc(float& a, float& b) {
    float hi_, lo_; asm("v_max_f32 %0, %2, %3\n\tv_min_f32 %1, %2, %3" : "=&v"(hi_), "=&v"(lo_) : "v"(a), "v"(b)); a = hi_; b = lo_; }
__device__ __forceinline__ float fmax_raw(float a, float b) { float r; asm("v_max_f32 %0, %1, %2" : "=v"(r) : "v"(a), "v"(b)); return r; }
template <int N, int OFF, int NTOT> __device__ __forceinline__ void bitonic_sort_desc(float (&v)[NTOT]) {
#pragma unroll
    for (int k = 2; k <= N; k <<= 1)
#pragma unroll
        for (int j = k >> 1; j > 0; j >>= 1)
#pragma unroll
            for (int i = 0; i < N; ++i) { const int l = i ^ j; if (l > i) { if ((i & k) == 0) ce_desc(v[OFF + i], v[OFF + l]); else ce_desc(v[OFF + l], v[OFF + i]); } }
}
template <int OFF, int NTOT> __device__ __forceinline__ void bitonic_merge16_desc(float (&v)[NTOT]) {
#pragma unroll
    for (int j = 8; j > 0; j >>= 1)
#pragma unroll
        for (int i = 0; i < 16; ++i) { const int l = i ^ j; if (l > i) ce_desc(v[OFF + i], v[OFF + l]); }
}
template <int A, int B, int NTOT> __device__ __forceinline__ void top16_merge(float (&v)[NTOT]) {
#pragma unroll
    for (int i = 0; i < 16; ++i) v[A + i] = fmax_raw(v[A + i], v[B + 15 - i]);
    bitonic_merge16_desc<A, NTOT>(v);
}
__device__ __forceinline__ void partner_top16(float (&t)[16], bool hi) {
    float a[16];
#pragma unroll
    for (int i = 0; i < 16; ++i) a[i] = hi ? t[15 - i] : t[i];
#pragma unroll
    for (int i = 0; i < 16; ++i) { const auto rr = __builtin_amdgcn_permlane32_swap(__builtin_bit_cast(unsigned, a[i]), __builtin_bit_cast(unsigned, a[i]), false, false);
        const unsigned r0_ = rr[0], r1_ = rr[1];
        t[i] = fmax_raw(__builtin_bit_cast(float, r0_), __builtin_bit_cast(float, r1_)); }
    bitonic_merge16_desc<0, 16>(t);
}
template <bool KL> __device__ __forceinline__ void topk_task(const Frame& F, const bf16* QP, const bf16* KEYS, const LAS unsigned char* klds, LAS unsigned short* kt, int* EI, float* EG, const int R0, const int h) {
    const int tk = F.lane & 31, hi = F.lane >> 5;
    const float neg_inf = -INFINITY;
    {
        float sv[2][16];
        unsigned koff = (unsigned)(tk * 128 + hi * 8), qoff = (unsigned)(tk * N_WQ + hi * 8);
        asm volatile("" : "+v"(koff), "+v"(qoff));
        const bf16* qp0 = QP + (size_t)R0 * N_WQ + (2 * h) * 128 + qoff;
        const bf16* kp0 = KEYS + ((size_t)(h * 2) * 128) * 128 + koff;
        const LAS unsigned char* kl0 = klds + tk * 272 + hi * 16;
        bf16x8 qf[8], kf[2][8];
#pragma unroll
        for (int ks = 0; ks < 8; ++ks) qf[ks] = *(const bf16x8*)(qp0 + ks * 16);
#pragma unroll
        for (int ks = 0; ks < 8; ++ks) kf[0][ks] = KL ? *(const LAS bf16x8*)(kl0 + ks * 32) : *(const bf16x8*)(kp0 + ks * 16);
        float v[64];
#pragma unroll
        for (int st = 0; st < 8; ++st) { const int p = st >> 2, kb = st & 3;
            if (st < 7) {
#pragma unroll
                for (int ks = 0; ks < 8; ++ks) kf[(st + 1) & 1][ks] = KL ? *(const LAS bf16x8*)(kl0 + (st + 1) * 32 * 272 + ks * 32) : *(const bf16x8*)(kp0 + (size_t)(st + 1) * 32 * 128 + ks * 16); }
            if (!KL) asm volatile("" ::: "memory");
            f32x16 acc = {};
#pragma unroll
            for (int ks = 0; ks < 8; ++ks) acc = __builtin_amdgcn_mfma_f32_32x32x16_bf16(kf[st & 1][ks], qf[ks], acc, 0, 0, 0);
#pragma unroll
            for (int rg = 0; rg < 16; ++rg) { const unsigned key = (unsigned)(kb * 32 + (rg & 3) + 8 * (rg >> 2)) + 4u * (unsigned)hi;
                const float av = acc[rg];
                v[kb * 16 + rg] = __builtin_bit_cast(float, (__builtin_bit_cast(unsigned, av) & ~127u) | key); }
            if (st == 3) {
#pragma unroll
                for (int ks = 0; ks < 8; ++ks) qf[ks] = *(const bf16x8*)(qp0 + 128 + ks * 16); }
            __builtin_amdgcn_sched_barrier(0);
            if (kb == 0) bitonic_sort_desc<16, 0, 64>(v); else if (kb == 1) bitonic_sort_desc<16, 16, 64>(v); else if (kb == 2) bitonic_sort_desc<16, 32, 64>(v); else bitonic_sort_desc<16, 48, 64>(v);
            if (kb == 3) {
                top16_merge<0, 16, 64>(v); top16_merge<32, 48, 64>(v); top16_merge<0, 32, 64>(v);
                float t[16];
#pragma unroll
                for (int i = 0; i < 16; ++i) t[i] = v[i];
                partner_top16(t, hi != 0);
#pragma unroll
                for (int i = 0; i < 16; ++i) sv[p][i] = t[i];
                __builtin_amdgcn_sched_barrier(0);
            }
        }
        float cv[32];
        {
            int n = 0;
#pragma unroll
            for (int i = 0; i < 16; ++i)
#pragma unroll
                for (int j = 0; j < 16; ++j) if ((i + 1) * (j + 1) <= 16) {
                    const float sum = sv[0][i] + sv[1][j];
                    const float c = __builtin_bit_cast(float, (__builtin_bit_cast(unsigned, sum) & ~255u) | (unsigned)(i * 16 + j));
                    if (n < 25) cv[n] = c; else cv[n - 25] = hi ? c : cv[n - 25];
                    ++n; }
#pragma unroll
            for (int k = 25; k < 32; ++k) cv[k] = neg_inf;
        }
#pragma unroll
        for (int p = 0; p < 2; ++p)
#pragma unroll
            for (int i = 0; i < 16; ++i) kt[(p * 16 + i) * 64 + F.lane] = (unsigned short)(__builtin_bit_cast(unsigned, sv[p][i]) & 127u);
        bitonic_sort_desc<16, 0, 32>(cv); bitonic_sort_desc<16, 16, 32>(cv); top16_merge<0, 16, 32>(cv);
        float tv[16]; int te[16];
#pragma unroll
        for (int i = 0; i < 16; ++i) tv[i] = cv[i];
        partner_top16(tv, hi != 0);
#pragma unroll
        for (int rd = 0; rd < 16; ++rd) { const unsigned id = __builtin_bit_cast(unsigned, tv[rd]) & 255u;
            te[rd] = (int)kt[(id >> 4) * 64 + F.lane] * 128 + (int)kt[(16 + (id & 15u)) * 64 + F.lane]; }
        float den = 0.f; const float tmax = tv[0];
#pragma unroll
        for (int rd = 0; rd < 16; ++rd) { tv[rd] = fast_exp2((tv[rd] - tmax) * LOG2E); den += tv[rd]; }
        const float rden = 1.0f / den;
        const size_t off = (size_t)(R0 + tk) * 128 + h * 16;
        if (hi == 0) {
#pragma unroll
            for (int q = 0; q < 4; ++q) { v4u o; o.x = (unsigned)te[4 * q]; o.y = (unsigned)te[4 * q + 1]; o.z = (unsigned)te[4 * q + 2]; o.w = (unsigned)te[4 * q + 3]; *(v4u*)(EI + off + 4 * q) = o; }
        } else {
#pragma unroll
            for (int q = 0; q < 4; ++q) { f32x4 o; o.x = tv[4 * q] * rden; o.y = tv[4 * q + 1] * rden; o.z = tv[4 * q + 2] * rden; o.w = tv[4 * q + 3] * rden; *(f32x4*)(EG + off + 4 * q) = o; }
        }
    }
}
__device__ __forceinline__ void peer_topk_phase(const Frame& F, const bf16* QP, const bf16* KEYS, int* EI, float* EG, bool lat_only) {
    LAS unsigned char* klds = F.lds;
    LAS unsigned short* kt = (LAS unsigned short*)(F.lds + 69632) + F.wave * 2048;
    for (int h = 0; h < 8; ++h) {
        __syncthreads();
#pragma unroll
        for (int i = 0; i < 8; ++i) { const int ch = F.tid + i * 512, row = ch >> 4, c16 = ch & 15;
            *(LAS v4u*)(klds + row * 272 + c16 * 16) = *(const v4u*)(KEYS + ((size_t)(h * 2) * 128 + row) * 128 + c16 * 8); }
        __syncthreads();
        for (int tgl = F.gw; tgl < NB * (TL / 32); tgl += F.NGW) { const int b = tgl >> 8, j = tgl & 255;
            topk_task<true>(F, QP, KEYS, klds, kt, EI, EG, b * RPB + CL + j * 32, h); }
    }
    __syncthreads();
    if (!lat_only) {
        for (int task = F.gw; task < NB * (CL / 32) * 8; task += F.NGW) { const int tgc = task >> 3, h = task & 7, b = tgc >> 3, j = tgc & 7;
            topk_task<false>(F, QP, KEYS, klds, kt, EI, EG, b * RPB + j * 32, h); }
    }
}

typedef float f32x2v __attribute__((ext_vector_type(2)));
typedef int v8i __attribute__((ext_vector_type(8)));
typedef int v2i_t __attribute__((ext_vector_type(2)));
template <int IMM> __device__ __forceinline__ void glds16_s(const unsigned char* sbase, unsigned voff, unsigned lds_dst) { unsigned keep;
    asm volatile("s_mov_b32 %0, m0\n\ts_mov_b32 m0, %3\n\ts_nop 0\n\tglobal_load_lds_dwordx4 %1, %2 offset:%4\n\ts_mov_b32 m0, %0" : "=&s"(keep) : "v"(voff), "s"(sbase), "s"(lds_dst), "n"(IMM) : "memory"); }
__device__ __forceinline__ v2i_t tr4(const LAS unsigned char* p) { return __builtin_amdgcn_ds_read_tr4_b64_v2i32((LAS v2i_t*)p); }
constexpr int G6_WF = 133120, G6_CF = 137216, G6_HB = 139264;
#define PG6_WAITV(n) do { if (GP == 6) asm volatile("s_waitcnt vmcnt(40)" ::: "memory"); else asm volatile("s_waitcnt vmcnt(" #n ")" ::: "memory"); } while (0)
#define PG6_WAITL() asm volatile("s_waitcnt lgkmcnt(0)" ::: "memory")
#define PG7_DMAU(VO, bt, slot) do { if (GP == 2 || GP == 3) break; _Pragma("unroll") for (int k_ = 0; k_ < 8; ++k_) glds16_s<0>(T + 64 * k_, VO[bt], (unsigned)__builtin_amdgcn_readfirstlane(vsm0 + (slot) * 8192 + k_ * 1024)); } while (0)
#define PG7_UREAD(slot) do { if (GP == 5 || GP == 6 || GP == 7 || GP == 8) break; _Pragma("unroll") for (int s_ = 0; s_ < 8; ++s_) ur[s_] = *(const LAS v4u*)(vsl + ua + ((slot) * 8192 + 1024 * s_)); } while (0)
#define PG7_UMFMA(bt) do { if (GP == 5 || GP == 6 || GP == 7 || GP == 8) break; f32x4 d_ = {0.f, 0.f, 0.f, 0.f}; \
    _Pragma("unroll") for (int s_ = 0; s_ < 8; ++s_) { v8i a_; a_[0] = (int)ur[s_].x; a_[1] = (int)ur[s_].y; a_[2] = (int)ur[s_].z; a_[3] = (int)ur[s_].w; a_[4] = 0; a_[5] = 0; a_[6] = 0; a_[7] = 0; \
        d_ = __builtin_amdgcn_mfma_scale_f32_16x16x128_f8f6f4(a_, bh[s_], d_, 4, 0, 0, 0, 0, 0); } \
    if (l15 == 0) *(LAS f32x4*)(wf + 4 * (16 * (bt) + 4 * q4)) = d_; } while (0)
#define PG7_DMAV2(c, h) do { if (GP == 1 || GP == 3 || GP == 8) break; _Pragma("unroll") for (int k_ = 0; k_ < 8; ++k_) \
    glds16_s<0>(T + 512 + 128 * (c) + 64 * (k_ & 1), voff[(k_ >> 1) + 4 * (h)], (unsigned)__builtin_amdgcn_readfirstlane(vsm0 + (h) * 8192 + k_ * 1024)); } while (0)
#define PG7_VREAD2() do { if (GP >= 5) break; _Pragma("unroll") for (int cg_ = 0; cg_ < 16; ++cg_) { const LAS unsigned char* ap_ = vsl + trp2[(cg_ >> 1) & 3] + (1024 * (cg_ >> 3) + 8 * (cg_ & 1)); vb0[cg_] = tr4(ap_); vb1[cg_] = tr4(ap_ + 2048); } } while (0)
#define PG7_SEL2(D, c, cg) do { const bool m_ = l15 == (cg); _Pragma("unroll") for (int i_ = 0; i_ < 4; ++i_) R[c][i_] = m_ ? D[i_] : R[c][i_]; \
    asm volatile("" : "+v"(R[c][0]), "+v"(R[c][1]), "+v"(R[c][2]), "+v"(R[c][3])); } while (0)
#define PG7_VMFMA2(c) do { if (GP >= 5) break; _Pragma("unroll") for (int cg_ = 0; cg_ < 16; ++cg_) { v8i a_; a_[0] = vb0[cg_].x; a_[1] = vb0[cg_].y; a_[2] = vb1[cg_].x; a_[3] = vb1[cg_].y; a_[4] = 0; a_[5] = 0; a_[6] = 0; a_[7] = 0; \
        f32x4 d_ = {0.f, 0.f, 0.f, 0.f}; \
        d_ = __builtin_amdgcn_mfma_scale_f32_16x16x128_f8f6f4(a_, bhi, d_, 4, 0, 0, 0, 0, 0); \
        PG7_SEL2(d_, c, cg_); } } while (0)
#define PG7_VCHUNK(c, ISSUE) do { PG7_VREAD2(); PG6_WAITL(); ISSUE; __builtin_amdgcn_sched_barrier(0); PG7_VMFMA2(c); } while (0)
#define PG7_USTEP(bt, slot, ISSUE) do { PG7_UREAD(slot); PG6_WAITL(); ISSUE; __builtin_amdgcn_sched_barrier(0); PG7_UMFMA(bt); } while (0)
#define PG7_VOFF(VO, EL, EH) do { _Pragma("unroll") for (int k_ = 0; k_ < 8; ++k_) VO[k_] = (unsigned)__shfl(k_ < 4 ? EL : EH, ((16 * k_) & 63) + (lane >> 2)) * 1024u + vlane; } while (0)
#define PG7_H8(HA, HC, O) do { int p_; \
    p_ = __builtin_amdgcn_cvt_pk_fp8_f32(bflo(HA.x), bfhi(HA.x), 0, false); p_ = __builtin_amdgcn_cvt_pk_fp8_f32(bflo(HA.y), bfhi(HA.y), p_, true); O.x = (unsigned)p_; \
    p_ = __builtin_amdgcn_cvt_pk_fp8_f32(bflo(HA.z), bfhi(HA.z), 0, false); p_ = __builtin_amdgcn_cvt_pk_fp8_f32(bflo(HA.w), bfhi(HA.w), p_, true); O.y = (unsigned)p_; \
    p_ = __builtin_amdgcn_cvt_pk_fp8_f32(bflo(HC.x), bfhi(HC.x), 0, false); p_ = __builtin_amdgcn_cvt_pk_fp8_f32(bflo(HC.y), bfhi(HC.y), p_, true); O.z = (unsigned)p_; \
    p_ = __builtin_amdgcn_cvt_pk_fp8_f32(bflo(HC.z), bfhi(HC.z), 0, false); p_ = __builtin_amdgcn_cvt_pk_fp8_f32(bflo(HC.w), bfhi(HC.w), p_, true); O.w = (unsigned)p_; } while (0)
template <bool FINAL, int GP = 0> __device__ __forceinline__ void peer_gather7_phase(const Frame& F, const bf16* HN, const unsigned char* T, const int* EI, const float* EG, const float* g2, bf16* XS, float* out, bool lat_only, const float* gain_n, const float* mod_n, bf16* XNn) {
    const int lane = F.lane, l15 = lane & 15, q4 = lane >> 4, half = lane >> 5, c32 = lane & 31;
    LAS unsigned char* hb = F.lds + G6_HB + F.wave * 1024;
    LAS unsigned char* wf = F.lds + G6_WF + F.wave * 512;
    LAS unsigned char* cf = F.lds + G6_CF + F.wave * 256;
    const LAS unsigned char* vsl = F.lds + F.wave * 16384;
    const unsigned vsm0 = (unsigned)(uintptr_t)F.lds + (unsigned)F.wave * 16384u;
    unsigned trp[4];
#pragma unroll
    for (int p = 0; p < 4; ++p) trp[p] = 2048u * q4 + 64u * l15 + 16u * ((p + (l15 >> 2)) & 3);
    unsigned trp2[4];
#pragma unroll
    for (int p = 0; p < 4; ++p) trp2[p] = 4096u * q4 + 64u * l15 + 16u * ((p + (l15 >> 2)) & 3);
    const unsigned ua = 64u * l15 + 16u * ((q4 + (l15 >> 2)) & 3);
    const unsigned hoff = (unsigned)(32 * c32 + 16 * half);
    const unsigned coff = (unsigned)(16 * l15 + 4 * q4);
    const unsigned vlane = 16u * (unsigned)(((lane & 3) - (lane >> 4)) & 3);
    const int NV = lat_only ? NB * TL : MT;
    int it = F.gw; if (it >= NV) return;
    int row = lat_only ? (it >> 13) * RPB + CL + (it & 8191) : it;
    int e_lo = EI[(size_t)row * 128 + lane], e_hi = EI[(size_t)row * 128 + 64 + lane];
    float g_lo = EG[(size_t)row * 128 + lane], g_hi = EG[(size_t)row * 128 + 64 + lane];
    unsigned voff[8];
    PG7_VOFF(voff, e_lo, e_hi);
    { const v4u ha = *(const v4u*)(HN + (size_t)row * DM + hoff), hc = *(const v4u*)(HN + (size_t)row * DM + hoff + 8); v4u o; PG7_H8(ha, hc, o); *(LAS v4u*)(hb + hoff) = o; }
    v2u xa[4]; f32x4 gv[4];
    { const int b0 = row / RPB, r0 = row - b0 * RPB; const int mr0 = r0 < CL ? 8 : b0;
      const float* gp = g2 + (size_t)mr0 * 6144 + coff; const bf16* xr = XS + (size_t)row * DM + coff;
#pragma unroll
      for (int ch = 0; ch < 4; ++ch) { xa[ch] = *(const v2u*)(xr + 256 * ch); gv[ch] = *(const f32x4*)(gp + 256 * ch); } }
    PG7_DMAU(voff, 0, 0); PG7_DMAU(voff, 1, 1);
    bool first = true;
    for (;;) {
        const int itn = it + F.NGW; const bool hn = itn < NV; const int rown = hn ? (lat_only ? (itn >> 13) * RPB + CL + (itn & 8191) : itn) : row;
        const int b = row / RPB, r = row - b * RPB; const bool cr = r < CL;
        const int mr = cr ? 8 : b;
        v8i bh[8];
#pragma unroll
        for (int s_ = 0; s_ < 8; ++s_) { const v4u b0 = *(const LAS v4u*)(hb + 128 * s_ + 16 * q4), b1 = *(const LAS v4u*)(hb + 128 * s_ + 64 + 16 * q4);
            bh[s_][0] = (int)b0.x; bh[s_][1] = (int)b0.y; bh[s_][2] = (int)b0.z; bh[s_][3] = (int)b0.w; bh[s_][4] = (int)b1.x; bh[s_][5] = (int)b1.y; bh[s_][6] = (int)b1.z; bh[s_][7] = (int)b1.w; }
        asm volatile("" : "+v"(bh[0]), "+v"(bh[1]), "+v"(bh[2]), "+v"(bh[3]), "+v"(bh[4]), "+v"(bh[5]), "+v"(bh[6]), "+v"(bh[7]));
        if (first) { PG6_WAITV(8); } else { PG6_WAITV(12); }
        v4u ur[8];
        PG7_USTEP(0, 0, PG7_DMAU(voff, 2, 0)); if (first) { PG6_WAITV(8); } else { PG6_WAITV(12); }
        first = false;
        PG7_USTEP(1, 1, PG7_DMAU(voff, 3, 1)); PG6_WAITV(8);
        PG7_USTEP(2, 0, PG7_DMAU(voff, 4, 0)); PG6_WAITV(8);
        PG7_USTEP(3, 1, PG7_DMAU(voff, 5, 1)); PG6_WAITV(8);
        PG7_USTEP(4, 0, PG7_DMAU(voff, 6, 0)); PG6_WAITV(8);
        PG7_USTEP(5, 1, PG7_DMAU(voff, 7, 1)); PG6_WAITV(8);
        int e_lo_n = __builtin_nontemporal_load(EI + (size_t)rown * 128 + lane), e_hi_n = __builtin_nontemporal_load(EI + (size_t)rown * 128 + 64 + lane);
        float g_lo_n = __builtin_nontemporal_load(EG + (size_t)rown * 128 + lane), g_hi_n = __builtin_nontemporal_load(EG + (size_t)rown * 128 + 64 + lane);
        v4u hna = __builtin_nontemporal_load((const v4u*)(HN + (size_t)rown * DM + hoff)), hnc = __builtin_nontemporal_load((const v4u*)(HN + (size_t)rown * DM + hoff + 8));
        v2u xan[4]; f32x4 gvn[4];
        { const int bn = rown / RPB, rn = rown - bn * RPB; const int mrn = rn < CL ? 8 : bn;
          const float* gp = g2 + (size_t)mrn * 6144 + coff; const bf16* xr = XS + (size_t)rown * DM + coff;
#pragma unroll
          for (int ch = 0; ch < 4; ++ch) { xan[ch] = __builtin_nontemporal_load((const v2u*)(xr + 256 * ch)); gvn[ch] = *(const f32x4*)(gp + 256 * ch); } }
        PG7_USTEP(6, 0, PG7_DMAV2(0, 0)); PG6_WAITV(8);
        PG7_USTEP(7, 1, PG7_DMAV2(0, 1)); PG6_WAITV(0);
        asm volatile("" : "+v"(e_lo_n), "+v"(e_hi_n), "+v"(g_lo_n), "+v"(g_hi_n), "+v"(hna), "+v"(hnc));
        asm volatile("" : "+v"(xan[0]), "+v"(xan[1]), "+v"(xan[2]), "+v"(xan[3]), "+v"(gvn[0]), "+v"(gvn[1]), "+v"(gvn[2]), "+v"(gvn[3]));
        { v4u o; PG7_H8(hna, hnc, o); *(LAS v4u*)(hb + hoff) = o; }
        unsigned voffn[8];
        PG7_VOFF(voffn, e_lo_n, e_hi_n);
        f32x2v w2; w2.x = gelu_erf(*(const LAS float*)(wf + 4 * lane) * (1.0f / U_SCALE)) * g_lo; w2.y = gelu_erf(*(const LAS float*)(wf + 256 + 4 * lane) * (1.0f / U_SCALE)) * g_hi;
        float mx = __builtin_fmaxf(__builtin_fabsf(w2.x), __builtin_fabsf(w2.y));
#pragma unroll
        for (int o = 1; o < 64; o <<= 1) mx = __builtin_fmaxf(mx, __shfl_xor(mx, o));
        const float csc = 384.0f / __builtin_fmaxf(mx, 1e-30f);
        { const int hi8 = __builtin_amdgcn_cvt_pk_fp8_f32(w2.x * csc, w2.y * csc, 0, false);
          cf[lane] = (unsigned char)(hi8 & 0xff); cf[64 + lane] = (unsigned char)((hi8 >> 8) & 0xff); }
        v8i bhi;
        { const v4u h0 = *(const LAS v4u*)(cf + 16 * q4), h1 = *(const LAS v4u*)(cf + 64 + 16 * q4);
          bhi[0] = (int)h0.x; bhi[1] = (int)h0.y; bhi[2] = (int)h0.z; bhi[3] = (int)h0.w; bhi[4] = (int)h1.x; bhi[5] = (int)h1.y; bhi[6] = (int)h1.z; bhi[7] = (int)h1.w; }
        float R[4][4];
#pragma unroll
        for (int i = 0; i < 4; ++i) { R[i][0] = 0.f; R[i][1] = 0.f; R[i][2] = 0.f; R[i][3] = 0.f; }
        v2i_t vb0[16], vb1[16];
        PG7_VCHUNK(0, PG7_DMAV2(1, 0); PG7_DMAV2(1, 1)); PG6_WAITV(0);
        PG7_VCHUNK(1, PG7_DMAV2(2, 0); PG7_DMAV2(2, 1)); PG6_WAITV(0);
        PG7_VCHUNK(2, PG7_DMAV2(3, 0); PG7_DMAV2(3, 1)); PG6_WAITV(0);
        PG7_VCHUNK(3, if (hn) { PG7_DMAU(voffn, 0, 0); PG7_DMAU(voffn, 1, 1); });
        const float osc = 1.0f / (V_SCALE * csc);
        float xn[16];
#pragma unroll
        for (int ch = 0; ch < 4; ++ch) {
            xn[4 * ch] = bflo(xa[ch].x) + gv[ch].x * (R[ch][0] * osc); xn[4 * ch + 1] = bfhi(xa[ch].x) + gv[ch].y * (R[ch][1] * osc); xn[4 * ch + 2] = bflo(xa[ch].y) + gv[ch].z * (R[ch][2] * osc); xn[4 * ch + 3] = bfhi(xa[ch].y) + gv[ch].w * (R[ch][3] * osc); }
        if (FINAL) {
            float* orow = out + ((size_t)b * TL + (r - CL)) * DM + coff;
#pragma unroll
            for (int ch = 0; ch < 4; ++ch) { f32x4 o; o.x = xn[4 * ch]; o.y = xn[4 * ch + 1]; o.z = xn[4 * ch + 2]; o.w = xn[4 * ch + 3]; __builtin_nontemporal_store(o, (f32x4*)(orow + 256 * ch)); }
        } else {
            bf16* orow = XS + (size_t)row * DM + coff;
#pragma unroll
            for (int ch = 0; ch < 4; ++ch) { v2u o; o.x = pk2(xn[4 * ch], xn[4 * ch + 1]); o.y = pk2(xn[4 * ch + 2], xn[4 * ch + 3]); *(v2u*)(orow + 256 * ch) = o; }
            float ss = 0.f;
#pragma unroll
            for (int i = 0; i < 16; ++i) ss += xn[i] * xn[i];
            const float rs = __builtin_amdgcn_rsqf(wave_sum(ss) * (1.f / DM) + EPS);
            const float* gn = gain_n + coff; const float* shp = mod_n + (size_t)mr * 6144 + coff; const float* scp = shp + 1024;
            bf16* nxp = XNn + (size_t)row * DM + coff;
#pragma unroll
            for (int ch = 0; ch < 4; ++ch) { const f32x4 g = *(const f32x4*)(gn + 256 * ch), sh = *(const f32x4*)(shp + 256 * ch), sc = *(const f32x4*)(scp + 256 * ch);
                const float y0 = xn[4 * ch] * rs * g.x * (sc.x + 1.0f) + sh.x, y1 = xn[4 * ch + 1] * rs * g.y * (sc.y + 1.0f) + sh.y, y2 = xn[4 * ch + 2] * rs * g.z * (sc.z + 1.0f) + sh.z, y3 = xn[4 * ch + 3] * rs * g.w * (sc.w + 1.0f) + sh.w;
                v2u o; o.x = pk2(y0, y1); o.y = pk2(y2, y3); *(v2u*)(nxp + 256 * ch) = o; }
        }
        if (!hn) break;
        it = itn; row = rown; e_lo = e_lo_n; e_hi = e_hi_n; g_lo = g_lo_n; g_hi = g_hi_n;
#pragma unroll
        for (int k = 0; k < 8; ++k) voff[k] = voffn[k];
#pragma unroll
        for (int ch = 0; ch < 4; ++ch) { xa[ch] = xan[ch]; gv[ch] = gvn[ch]; }
    }
}

#ifndef MK_MASK
#define MK_MASK 0x7ff
#endif
#define ENAB(r) (((MK_MASK) >> (r)) & 1)
#define IN(k) (lo <= (k) && (k) < hi)
#define SEAM(k) do { if ((k) + 1 < hi) { if (MK_PER_PHASE) { if (F.tid == 0) __hip_atomic_store(F.ctl + CW_TMO, 0xBADBA0u, RLX_AGENT); } else xcd_barrier(bar); } } while (0)

template <int layer> __device__ __forceinline__ void run_layer(const Frame& F, const Args& args, const XcdBarrier& bar, const int lo, const int hi, unsigned char* lds) {
    unsigned char* ws = args.ws;
    float* MOD = (float*)(ws + WS_MOD);
    const float* RT = (const float*)(ws + WS_ROPE);
    bf16* XS = (bf16*)(ws + WS_XS);
    bf16* OD = (bf16*)(ws + WS_XS);
    bf16* XN = (bf16*)(ws + WS_XN);
    bf16* PB = (bf16*)(ws + WS_PB);
    int* EI = (int*)(ws + WS_EI); float* EG = (float*)(ws + WS_EG);
        const int pb = 1 + layer * PH_PER_LAYER;
        const float* mod = MOD + (size_t)layer * 9 * 6144;
        const float* norm1 = args.in[layer ? 25 : 6]; const float* norm2 = args.in[layer ? 26 : 7];
        const bf16* W_in = (const bf16*)(ws + (layer ? WS_WIN1 : WS_WIN0)); const bf16* W_out = (const bf16*)(ws + (layer ? WS_WOUT1 : WS_WOUT0)); const bf16* W_q = (const bf16*)(ws + (layer ? WS_WQ1 : WS_WQ0));
        const bf16* KEYS = (const bf16*)(ws + (layer ? WS_KEYS1 : WS_KEYS0)); const unsigned char* PU = ws + (layer ? WS_U1 : WS_U0); const unsigned char* PV = PU;
        const int n_in = layer ? N_IN1 : N_IN0;
        const bool lat_only = layer == 1;

        if (ENAB(0) && IN(pb + 0)) {
            if (layer == 0) { norm_mod_phase<true>(F, args.in[0], args.in[2], XS, norm1, mod + 0, mod + 1024, XN, false); SEAM(pb + 0); }
        }
        if (ENAB(1) && IN(pb + 1)) {
            pg8::Gemm g{XN, W_in, MT, n_in, DM}; pg8::StaticOrder S; S.init(MT, n_in, F.G, (int)blockIdx.x);
            PG8_LAS float* xch = (PG8_LAS float*)(F.lds + 132096);
            pg8::EpiHeadNorm<layer> E{PB, n_in, RT + 4096 + layer * 256, RT, xch, QSCALE};
            pg8::gemm_phase<pg8::EpiHeadNorm<layer>, pg8::StaticOrder, true, true>(F.lds, g, S, E);
            SEAM(pb + 1);
        }
        if (ENAB(2) && IN(pb + 2)) {
        }
        if (ENAB(3) && IN(pb + 3)) {
            using abf = attn_body::bf16;
            if (layer == 0) {
                for (int u = F.vcu, first = 1; u < NB * 12 * 32; u += F.G, first = 0) {
                    const int combo = u >> 5, qb = u & 31, b = combo / 12, s = combo % 12;
                    const size_t kr0 = (size_t)b * RPB, qr0 = kr0 + CL + (size_t)qb * 256;
                    const int un = u + F.G; const bool hn = un < NB * 12 * 32; const int cn = (hn ? un : u) >> 5, bn = cn / 12, sn = cn % 12; const size_t krn = (size_t)bn * RPB;
                    attn_body::attn_unit2<2, N_IN0, OD_P, 0>((const abf*)(PB + qr0 * N_IN0 + 256 + s * 64), (const abf*)(PB + kr0 * N_IN0 + 1024 + s * 64), (const abf*)(PB + kr0 * N_IN0 + 1792 + (s >> 1) * 128),
                                                         (abf*)(OD + qr0 * OD_P + s * 128), (RPB / 64), (char*)lds, nullptr, 0,
                                                         !first, hn, (const abf*)(PB + krn * N_IN0 + 1024 + sn * 64), (const abf*)(PB + krn * N_IN0 + 1792 + (sn >> 1) * 128));
                }
                for (int u = F.vcu; u < NB * 12; u += F.G) {
                    const int b = u / 12, s = u % 12; const size_t kr0 = (size_t)b * RPB;
                    attn_body::attn_unit2<2, N_IN0, OD_P, 0>((const abf*)(PB + kr0 * N_IN0 + 256 + s * 64), (const abf*)(PB + kr0 * N_IN0 + 1024 + s * 64), (const abf*)(PB + kr0 * N_IN0 + 1792 + (s >> 1) * 128),
                                                         (abf*)(OD + kr0 * OD_P + s * 128), (CL / 64), (char*)lds, nullptr, 0, false, false, nullptr, nullptr);
                }
            } else {
                for (int u = F.vcu, first = 1; u < NB * 8 * 32; u += F.G, first = 0) {
                    const int combo = u >> 5, qb = u & 31, b = combo >> 3, h = combo & 7;
                    const size_t kr0 = (size_t)b * RPB, qr0 = kr0 + CL + (size_t)qb * 256;
                    const int un = u + F.G; const bool hn = un < NB * 8 * 32; const int cn = (hn ? un : u) >> 5, bn = cn >> 3, hn_ = cn & 7; const size_t krn = (size_t)bn * RPB;
                    attn_body::attn_unit2<1, N_IN1, DM, 0>((const abf*)(PB + qr0 * N_IN1 + h * 64), (const abf*)(PB + kr0 * N_IN1 + 512 + (h >> 2) * 64), (const abf*)(PB + kr0 * N_IN1 + 640 + (h >> 2) * 64),
                                                       (abf*)(XN + qr0 * DM + h * 64), (RPB / 64), (char*)lds, nullptr, 0,
                                                       !first, hn, (const abf*)(PB + krn * N_IN1 + 512 + (hn_ >> 2) * 64), (const abf*)(PB + krn * N_IN1 + 640 + (hn_ >> 2) * 64));
                }
            }
            if (layer == 0) SEAM(pb + 3);
        }
        if (ENAB(4) && IN(pb + 4)) {
            if (layer == 0) l0_pool_combine_phase(F, args, PB, OD, XN);
            else {
                if (!(DBGZ & 16)) {
                    using abf = attn_body::bf16;
                    for (int u = F.vcu, first = 1; u < NB * 8 * 32; u += F.G, first = 0) {
                        const int combo = u >> 5, qb = u & 31, b = combo >> 3, h = combo & 7;
                        const size_t kr0 = (size_t)b * RPB, qr0 = kr0 + CL + (size_t)qb * 256;
                        const int un = u + F.G; const bool hn = un < NB * 8 * 32; const int cn = (hn ? un : u) >> 5, bn = cn >> 3, hn_ = cn & 7; const size_t krn = (size_t)bn * RPB;
                        attn_body::attn_unit2<1, N_IN1, DM, 1>((const abf*)(PB + qr0 * N_IN1 + 768 + h * 64), (const abf*)(PB + kr0 * N_IN1 + 1280 + h * 64), (const abf*)(PB + kr0 * N_IN1 + 1792 + h * 64),
                                                              (abf*)(XN + qr0 * DM + 512 + h * 64), 16, (char*)lds, args.in[33] + h * 465, qb * 4,
                                                              !first, hn, (const abf*)(PB + krn * N_IN1 + 1280 + hn_ * 64), (const abf*)(PB + krn * N_IN1 + 1792 + hn_ * 64));
                    }
                }
                if (DBGZ & 24) { for (int row = F.gw; row < MT; row += F.NGW) { v4u z = {0u, 0u, 0u, 0u};
                    if (DBGZ & 8) *(v4u*)(XN + (size_t)row * DM + 8 * F.lane) = z;
                    if (DBGZ & 16) *(v4u*)(XN + (size_t)row * DM + 512 + 8 * F.lane) = z; } }
            }
            SEAM(pb + 4);
        }
        if (ENAB(5) && IN(pb + 5)) {
            pg8::Gemm g{XN, W_out, MT, DM, DM};
            pg8::EpiRes E{XS, args.in[0], args.in[2], mod + 2048, layer == 0 ? 1 : 0};
            if (layer == 0) { pg8::StaticOrder S; S.init(MT, DM, F.G, (int)blockIdx.x); pg8::gemm_phase<pg8::EpiRes, pg8::StaticOrder, true, true>(F.lds, g, S, E); }
            else { pg8::LatOrder S; S.init(DM, F.G, (int)blockIdx.x); pg8::gemm_phase<pg8::EpiRes, pg8::LatOrder, true, true>(F.lds, g, S, E); }
            SEAM(pb + 5);
        }
        if (ENAB(6) && IN(pb + 6)) { norm_mod_phase<false>(F, args.in[0], args.in[2], XS, norm2, mod + 3072, mod + 4096, XN, lat_only); SEAM(pb + 6); }
        if (ENAB(7) && IN(pb + 7)) {
            pg8::Gemm g{XN, W_q, MT, N_WQ, DM};
            pg8::EpiBf16<0> E{PB, N_WQ, nullptr, 0, 0, 1.f};
            if (layer == 0) { pg8::StaticOrder S; S.init(MT, N_WQ, F.G, (int)blockIdx.x); pg8::gemm_phase<pg8::EpiBf16<0>, pg8::StaticOrder, true, true>(F.lds, g, S, E); }
            else { pg8::LatOrder S; S.init(N_WQ, F.G, (int)blockIdx.x); pg8::gemm_phase<pg8::EpiBf16<0>, pg8::LatOrder, true, true>(F.lds, g, S, E); }
            SEAM(pb + 7);
        }
        if (ENAB(8) && IN(pb + 8)) { peer_topk_phase(F, PB, KEYS, EI, EG, lat_only); SEAM(pb + 8); }
        if (ENAB(9) && IN(pb + 9)) {
            if (layer == 0) peer_gather7_phase<false>(F, XN, PU, EI, EG, mod + 5120, XS, args.out, false, args.in[25], MOD + (size_t)9 * 6144, XN);
            else {
#if defined(PROBE_G6)
                if (args.pad) peer_gather7_phase<true, PROBE_G6>(F, XN, PU, EI, EG, mod + 5120, XS, (float*)(ws + WS_PB), true, nullptr, nullptr, nullptr); else
#endif
                peer_gather7_phase<true>(F, XN, PU, EI, EG, mod + 5120, XS, args.out, true, nullptr, nullptr, nullptr);
            }
            SEAM(pb + 9);
        }
}
__global__ void __launch_bounds__(NWAVES * 64, 2) mk_fwd(Args args) {
    extern __shared__ __attribute__((aligned(16))) unsigned char lds[];
    Frame F;
    F.lds = (LAS unsigned char*)lds;
    F.tid = threadIdx.x; F.lane = F.tid & 63; F.wave = __builtin_amdgcn_readfirstlane(F.tid >> 6);
    F.G = gridDim.x; { const int bx = blockIdx.x; F.vcu = (F.G % 8 == 0) ? (bx % 8) * (F.G / 8) + bx / 8 : bx; }
    F.gw = F.vcu * NWAVES + F.wave; F.NGW = F.G * NWAVES;
    unsigned char* ws = args.ws;
    F.ctl = (gu32*)(ws + WS_CTL);
    for (int u = F.tid; u < (LDS_BYTES - LDSCTL_OFF) / 4; u += NWAVES * 64) ((LAS unsigned*)(F.lds + LDSCTL_OFF))[u] = 0u;
    __syncthreads();
    XcdBarrier bar; bar.bar = (unsigned*)(F.ctl + CW_BAR) + args.li * XCD_BAR_WORDS; bar.x = 0; bar.st = nullptr;
    if (!MK_PER_PHASE) bar = xcd_barrier_post((unsigned*)(F.ctl + CW_BAR) + args.li * XCD_BAR_WORDS, (volatile LAS unsigned*)(F.lds + MISC_OFF) + 8);
    const int lo = args.ph_lo, hi = args.ph_hi;
    if (ENAB(10) && IN(0)) { p0_prologue(F, args); SEAM(0); }
    run_layer<0>(F, args, bar, lo, hi, lds);
    run_layer<1>(F, args, bar, lo, hi, lds);
#if defined(EXTRA_BARRIERS)
    if (hi == N_PHASES) { for (int i = 0; i < EXTRA_BARRIERS; ++i) xcd_barrier(bar); }
#endif
}


extern "C" void kernel_launch(void* const* d_in, const int* in_sizes, int n_in, void* d_out, int out_size, void* d_ws, size_t ws_size, hipStream_t stream) {
    static int grid = 0;
    if (grid == 0) {
        if (n_in != 38 || in_sizes[0] != NB * TL * DM || out_size != NB * TL * DM || ws_size < WS_END) {
            fprintf(stderr, "kernel_launch: unexpected problem shape (n_in %d, in0 %d, out %d, ws %zu; need ws >= %zu); nothing launched\n", n_in, n_in > 0 ? in_sizes[0] : -1, out_size, ws_size, (size_t)WS_END); grid = -1; return; }
        int dev = 0, cus = 0, per_cu = 0;
        if (hipGetDevice(&dev) != hipSuccess || hipDeviceGetAttribute(&cus, hipDeviceAttributeMultiprocessorCount, dev) != hipSuccess) { grid = -1; return; }
        if (hipFuncSetAttribute((const void*)mk_fwd, hipFuncAttributeMaxDynamicSharedMemorySize, LDS_BYTES) != hipSuccess) { fprintf(stderr, "kernel_launch: hipFuncSetAttribute failed\n"); grid = -1; return; }
        if (hipOccupancyMaxActiveBlocksPerMultiprocessor(&per_cu, (const void*)mk_fwd, NWAVES * 64, LDS_BYTES) != hipSuccess || per_cu < 1) { fprintf(stderr, "kernel_launch: occupancy query says %d blocks per CU\n", per_cu); }
        (void)hipGetLastError();
        grid = cus;
    }
    if (grid < 0) return;
    if (hipMemsetAsync((char*)d_ws + WS_CTL, 0, CTL_ZERO_BYTES, stream) != hipSuccess) return;
    Args a{};
    for (int i = 0; i < 38; ++i) a.in[i] = (const float*)d_in[i];
    a.out = (float*)d_out; a.ws = (unsigned char*)d_ws;
#if MK_PER_PHASE
    for (int p = 0; p < N_PHASES; ++p) { a.ph_lo = p; a.ph_hi = p + 1; hipLaunchKernelGGL(mk_fwd, dim3(grid), dim3(NWAVES * 64), LDS_BYTES, stream, a); }
#else
    a.ph_lo = 0; a.ph_hi = N_PHASES;
    hipLaunchKernelGGL(mk_fwd, dim3(grid), dim3(NWAVES * 64), LDS_BYTES, stream, a);
#if defined(EXTRA_PHASE)
#ifndef EXTRA_HI
#define EXTRA_HI (EXTRA_PHASE + 1)
#endif
    a.ph_lo = EXTRA_PHASE; a.ph_hi = EXTRA_HI; a.li = 1;
#if defined(PROBE_G6)
    a.pad = 1;
#endif
    hipLaunchKernelGGL(mk_fwd, dim3(grid), dim3(NWAVES * 64), LDS_BYTES, stream, a);
#endif
#endif
    const hipError_t le = hipPeekAtLastError();
    if (le != hipSuccess) fprintf(stderr, "kernel_launch: launch failed: %s\n", hipGetErrorName(le));
}
```
